# Optimizing an MI355X kernel written in HIP

```python
import math
import jax, jax.numpy as jnp
from jax import lax
import numpy as np

D_MODEL = 1024
BATCH = 8
SEQ = 4096
DEPTH = 2

N_HEADS = 8
HEAD_DIM = 64
ROPE_THETA = 10000.0
Q_BLOCK = 128
SSM_WIDTH = 512
SSM_GROUP = 16
SSM_GROUPS = SSM_WIDTH // SSM_GROUP
SSM_STATE = 64
DT_MIN = 1e-3
DT_MAX = 1e-1
D_FF = 2816
CONV_WIDTH = 3
EPS = 1e-6
SUBLN_EPS = 1e-5

QK_WIDTH = 2 * N_HEADS * HEAD_DIM
V_WIDTH = N_HEADS * 2 * HEAD_DIM
SPLIT_IDX = [QK_WIDTH, 2 * QK_WIDTH, 2 * QK_WIDTH + V_WIDTH,
             2 * QK_WIDTH + V_WIDTH + SSM_WIDTH, 2 * QK_WIDTH + V_WIDTH + SSM_WIDTH + D_MODEL]
IN_WIDTH = 2 * QK_WIDTH + V_WIDTH + SSM_WIDTH + 2 * D_MODEL

kernel_name = "hybrid_diffattn_s5_convffn_adaln_encoder"


def rmsnorm(x, w, eps=EPS):
    xf = x.astype(jnp.float32)
    y = xf * lax.rsqrt(jnp.mean(xf * xf, axis=-1, keepdims=True) + eps)
    return (y * w.astype(jnp.float32)).astype(x.dtype)


def rope_tables(seq):
    half = HEAD_DIM // 2
    inv_freq = ROPE_THETA ** (-jnp.arange(0, half, dtype=jnp.float32) / half)
    ang = jnp.arange(seq, dtype=jnp.float32)[:, None] * inv_freq[None, :]
    return jnp.cos(ang)[:, None, :], jnp.sin(ang)[:, None, :]


def apply_rope(x, cos, sin):
    half = HEAD_DIM // 2
    x1, x2 = x[..., :half], x[..., half:]
    out = jnp.concatenate([x1 * cos - x2 * sin, x2 * cos + x1 * sin], axis=-1)
    return out.astype(x.dtype)


def diff_attention(q, k, v, lam, sub_w, lambda_init):
    B, S = q.shape[0], q.shape[1]
    nb = S // Q_BLOCK
    scale = 1.0 / math.sqrt(HEAD_DIM)
    qb = q.reshape(B, nb, Q_BLOCK, 2 * N_HEADS, HEAD_DIM).transpose(1, 0, 2, 3, 4)

    def attend_block(qblk):
        s = jnp.einsum('bqhd,bkhd->bhqk', qblk, k).astype(jnp.float32) * scale
        p = jax.nn.softmax(s, axis=-1).reshape(B, N_HEADS, 2, Q_BLOCK, S)
        a = p[:, :, 0] - lam * p[:, :, 1]
        return jnp.einsum('bhqk,bkhe->bqhe', a.astype(v.dtype), v)

    o = lax.map(attend_block, qb)
    o = o.transpose(1, 0, 2, 3, 4).reshape(B, S, N_HEADS, 2 * HEAD_DIM)
    o = rmsnorm(o, sub_w, SUBLN_EPS) * (1.0 - lambda_init)
    return o.reshape(B, S, V_WIDTH)


def s5_direction(u, lam_re, lam_im, log_dt, b_re, b_im, c_re, c_im, reverse):
    S = u.shape[0]
    lam_re = lam_re.astype(jnp.float32)
    lam_im = lam_im.astype(jnp.float32)
    dt = jnp.exp(log_dt.astype(jnp.float32))[:, None]
    mag = jnp.exp(lam_re * dt)
    ang = lam_im * dt
    abar_re = mag * jnp.cos(ang)
    abar_im = mag * jnp.sin(ang)
    den = lam_re * lam_re + lam_im * lam_im
    nr = abar_re - 1.0
    ni = abar_im
    f_re = (nr * lam_re + ni * lam_im) / den
    f_im = (ni * lam_re - nr * lam_im) / den
    b_re = b_re.astype(jnp.float32)
    b_im = b_im.astype(jnp.float32)
    bb_re = f_re[..., None] * b_re - f_im[..., None] * b_im
    bb_im = f_re[..., None] * b_im + f_im[..., None] * b_re
    bu_re = jnp.einsum('sbgn,gpn->sbgp', u, bb_re)
    bu_im = jnp.einsum('sbgn,gpn->sbgp', u, bb_im)
    G, P = abar_re.shape
    a_re = jnp.broadcast_to(abar_re[None, None], (S, 1, G, P))
    a_im = jnp.broadcast_to(abar_im[None, None], (S, 1, G, P))

    def combine(e1, e2):
        a1r, a1i, b1r, b1i = e1
        a2r, a2i, b2r, b2i = e2
        return (a2r * a1r - a2i * a1i,
                a2r * a1i + a2i * a1r,
                a2r * b1r - a2i * b1i + b2r,
                a2r * b1i + a2i * b1r + b2i)

    _, _, xr, xi = lax.associative_scan(combine, (a_re, a_im, bu_re, bu_im), axis=0, reverse=reverse)
    return (jnp.einsum('sbgp,gnp->sbgn', xr, c_re.astype(jnp.float32))
            - jnp.einsum('sbgp,gnp->sbgn', xi, c_im.astype(jnp.float32)))


def bidirectional_s5(u, lam_re, lam_im, log_dt, b_re, b_im, c_re, c_im, d_skip):
    B, S, _ = u.shape
    us = u.astype(jnp.float32).transpose(1, 0, 2).reshape(S, B, SSM_GROUPS, SSM_GROUP)
    y_fwd = s5_direction(us, lam_re[0], lam_im[0], log_dt[0], b_re[0], b_im[0], c_re[0], c_im[0], False)
    y_bwd = s5_direction(us, lam_re[1], lam_im[1], log_dt[1], b_re[1], b_im[1], c_re[1], c_im[1], True)
    y = y_fwd + y_bwd + d_skip.astype(jnp.float32).reshape(SSM_GROUPS, SSM_GROUP) * us
    return y.reshape(S, B, SSM_WIDTH).transpose(1, 0, 2).astype(u.dtype)


def depthwise_conv_centred(x, w, b):
    xp = jnp.pad(x, ((0, 0), (1, 1), (0, 0)))
    return xp[:, :-2] * w[0] + xp[:, 1:-1] * w[1] + xp[:, 2:] * w[2] + b


def setup_inputs(seed: int = 0) -> dict:
    key = jax.random.key(seed)
    ks = jax.random.split(key, 32)
    f32 = jnp.float32
    L, G, P, N = DEPTH, SSM_GROUPS, SSM_STATE, SSM_GROUP

    def nrm(k, shape, scale):
        return jax.random.normal(k, shape, f32) * scale

    n_idx = jnp.arange(P, dtype=f32)
    lam_re = -0.5 + 0.01 * jax.random.normal(ks[14], (L, 2, G, P), f32)
    lam_im = math.pi * n_idx + 0.01 * jax.random.normal(ks[15], (L, 2, G, P), f32)
    log_dt = jax.random.uniform(ks[16], (L, 2, G), f32, math.log(DT_MIN), math.log(DT_MAX))
    inv_sqrt2 = 1.0 / math.sqrt(2.0)

    return {
        "x": nrm(ks[0], (BATCH, SEQ, D_MODEL), 1.0),
        "c": nrm(ks[1], (BATCH, D_MODEL), 1.0),
        "norm1_w": 1.0 + nrm(ks[2], (L, D_MODEL), 0.01),
        "norm2_w": 1.0 + nrm(ks[3], (L, D_MODEL), 0.01),
        "ada_w": nrm(ks[4], (L, D_MODEL, 6 * D_MODEL), D_MODEL ** -0.5),
        "ada_b": nrm(ks[5], (L, 6 * D_MODEL), 0.01),
        "w_in": nrm(ks[6], (L, D_MODEL, IN_WIDTH), D_MODEL ** -0.5),
        "lam_q1": nrm(ks[7], (L, HEAD_DIM), 0.1),
        "lam_k1": nrm(ks[8], (L, HEAD_DIM), 0.1),
        "lam_q2": nrm(ks[9], (L, HEAD_DIM), 0.1),
        "lam_k2": nrm(ks[10], (L, HEAD_DIM), 0.1),
        "subln_w": 1.0 + nrm(ks[11], (L, 2 * HEAD_DIM), 0.01),
        "w_attn_out": nrm(ks[12], (L, V_WIDTH, D_MODEL), V_WIDTH ** -0.5),
        "ssm_lam_re": lam_re,
        "ssm_lam_im": lam_im,
        "ssm_log_dt": log_dt,
        "ssm_b_re": nrm(ks[17], (L, 2, G, P, N), N ** -0.5 * inv_sqrt2),
        "ssm_b_im": nrm(ks[18], (L, 2, G, P, N), N ** -0.5 * inv_sqrt2),
        "ssm_c_re": nrm(ks[19], (L, 2, G, N, P), P ** -0.5 * inv_sqrt2),
        "ssm_c_im": nrm(ks[20], (L, 2, G, N, P), P ** -0.5 * inv_sqrt2),
        "ssm_d": nrm(ks[21], (L, SSM_WIDTH), 1.0),
        "w_glu_a": nrm(ks[22], (L, SSM_WIDTH, D_MODEL), SSM_WIDTH ** -0.5),
        "w_glu_b": nrm(ks[23], (L, SSM_WIDTH, D_MODEL), SSM_WIDTH ** -0.5),
        "w_out": nrm(ks[24], (L, D_MODEL, D_MODEL), D_MODEL ** -0.5),
        "w_up": nrm(ks[25], (L, D_MODEL, 2 * D_FF), D_MODEL ** -0.5),
        "conv_w": nrm(ks[26], (L, CONV_WIDTH, 2 * D_FF), CONV_WIDTH ** -0.5),
        "conv_b": nrm(ks[27], (L, 2 * D_FF), 0.01),
        "w_down": nrm(ks[28], (L, D_FF, D_MODEL), D_FF ** -0.5),
        "final_w": 1.0 + nrm(ks[29], (D_MODEL,), 0.01),
    }


def reference(x, c, norm1_w, norm2_w, ada_w, ada_b, w_in, lam_q1, lam_k1, lam_q2, lam_k2, subln_w,
              w_attn_out, ssm_lam_re, ssm_lam_im, ssm_log_dt, ssm_b_re, ssm_b_im, ssm_c_re, ssm_c_im,
              ssm_d, w_glu_a, w_glu_b, w_out, w_up, conv_w, conv_b, w_down, final_w):
    B, S, _ = x.shape
    cos, sin = rope_tables(S)
    c_act = jax.nn.silu(c)
    for l in range(DEPTH):
        lambda_init = 0.8 - 0.6 * math.exp(-0.3 * l)
        mod = c_act @ ada_w[l] + ada_b[l]
        shift1, scale1, gate1, shift2, scale2, gate2 = [m[:, None, :] for m in jnp.split(mod, 6, axis=-1)]

        h = rmsnorm(x, norm1_w[l]) * (1.0 + scale1) + shift1
        proj = h @ w_in[l]
        q, k, v, u, g_attn, g_ssm = jnp.split(proj, SPLIT_IDX, axis=-1)

        q = apply_rope(q.reshape(B, S, 2 * N_HEADS, HEAD_DIM), cos, sin)
        k = apply_rope(k.reshape(B, S, 2 * N_HEADS, HEAD_DIM), cos, sin)
        v = v.reshape(B, S, N_HEADS, 2 * HEAD_DIM)
        lam = (jnp.exp(jnp.sum(lam_q1[l] * lam_k1[l]).astype(jnp.float32))
               - jnp.exp(jnp.sum(lam_q2[l] * lam_k2[l]).astype(jnp.float32)) + lambda_init)
        o_attn = diff_attention(q, k, v, lam, subln_w[l], lambda_init) @ w_attn_out[l]

        y = bidirectional_s5(u, ssm_lam_re[l], ssm_lam_im[l], ssm_log_dt[l], ssm_b_re[l], ssm_b_im[l],
                             ssm_c_re[l], ssm_c_im[l], ssm_d[l])
        y = jax.nn.gelu(y)
        o_ssm = (y @ w_glu_a[l]) * jax.nn.sigmoid(y @ w_glu_b[l])

        merged = jax.nn.sigmoid(g_attn) * o_attn + jax.nn.sigmoid(g_ssm) * o_ssm
        x = x + gate1 * (merged @ w_out[l])

        h = rmsnorm(x, norm2_w[l]) * (1.0 + scale2) + shift2
        up = depthwise_conv_centred(h @ w_up[l], conv_w[l], conv_b[l])
        val, gt = jnp.split(up, 2, axis=-1)
        x = x + gate2 * ((jax.nn.silu(gt) * val) @ w_down[l])
    return rmsnorm(x, final_w)
```

```cpp
#include <hip/hip_runtime.h>
#include <hip/hip_cooperative_groups.h>
#include <cstdio>
#include <cstdint>
namespace cg = cooperative_groups;

#define LAS __attribute__((address_space(3)))
typedef unsigned short bf16_t;
typedef short bf16x8 __attribute__((ext_vector_type(8)));
typedef short s16x4 __attribute__((ext_vector_type(4)));
typedef float f32x2 __attribute__((ext_vector_type(2)));
typedef float f32x4 __attribute__((ext_vector_type(4)));
typedef float f32x16 __attribute__((ext_vector_type(16)));
typedef unsigned u32x2 __attribute__((ext_vector_type(2)));
typedef unsigned u32x4 __attribute__((ext_vector_type(4)));

constexpr int NB = 8, SEQ = 4096, DM = 1024, T = NB * SEQ, DFF = 2816, NUP = 2 * DFF, NWAVES = 8, NTHR = 512;
constexpr int CH = 32, NCH = SEQ / CH, KX = 768;
constexpr size_t MiB = 1u << 20;
constexpr size_t WS_MOD = 1 * MiB, WS_ROPE = 2 * MiB, WS_PW = 3 * MiB, WS_BB = 5 * MiB, WS_KM = 6 * MiB;
constexpr size_t WS_WQKVU = 8 * MiB, WS_WG = 15 * MiB, WS_WAO = 19 * MiB, WS_WGLU = 21 * MiB, WS_WOUT = 23 * MiB, WS_WUP = 25 * MiB, WS_WDOWN = 36 * MiB;
constexpr size_t WS_TMAT = 42 * MiB, WS_EMAT = 66 * MiB, WS_XN = 74 * MiB;
constexpr size_t WS_Q = 138 * MiB, WS_K = 202 * MiB, WS_V = 266 * MiB, WS_UEXT = 330 * MiB, WS_XLOC = 378 * MiB, WS_SCR = 410 * MiB;
constexpr size_t WS_UP = 138 * MiB, WS_ACT = 314 * MiB, WS_END = 490 * MiB;
constexpr int LDS_BYTES = 147456;

struct Params {
    const float* in[29];
    float* out;
    unsigned char* ws;
};
enum { I_X = 0, I_C, I_N1W, I_N2W, I_ADAW, I_ADAB, I_WIN, I_LQ1, I_LK1, I_LQ2, I_LK2, I_SUBW, I_WAO, I_SLRE, I_SLIM, I_SLDT, I_SBRE, I_SBIM, I_SCRE, I_SCIM, I_SD,
       I_WGA, I_WGB, I_WOUT, I_WUP, I_CONVW, I_CONVB, I_WDOWN, I_FINW };

__device__ __forceinline__ unsigned cvt_pk_bf16(float lo, float hi) { unsigned r; asm volatile("v_cvt_pk_bf16_f32 %0, %1, %2" : "=v"(r) : "v"(lo), "v"(hi)); return r; }
__device__ __forceinline__ float bf_lo(unsigned w) { return __uint_as_float(w << 16); }
__device__ __forceinline__ float bf_hi(unsigned w) { return __uint_as_float(w & 0xffff0000u); }
__device__ __forceinline__ float sigmoidf_(float x) { return 1.0f / (1.0f + __expf(-x)); }
__device__ __forceinline__ float gelu_tanh(float x) { const float z = 0.7978845608028654f * (x + 0.044715f * x * x * x); return x / (1.0f + __expf(-2.0f * z)); }
__device__ __forceinline__ float wave_sum(float v) {
#pragma unroll
    for (int o = 1; o < 64; o <<= 1) v += __shfl_xor(v, o);
    return v;
}

namespace pg8 {
constexpr int BM = 256, BK = 64, HALF = 128, HTB = HALF * BK * 2, NXCD = 8, WGM = 8;
__host__ __device__ __forceinline__ int lds_byte(int r, int c) { const int st = (r >> 4) * 2 + (c >> 5), rr = r & 15, cc = c & 31, ob = rr * 64 + cc * 2; return st * 1024 + (ob ^ (((ob >> 9) & 1) << 5)); }
__host__ __device__ __forceinline__ void stage_rc(int b, int& R, int& C) { const int st = b / 1024, sb = b % 1024, swz = sb ^ (((sb >> 9) & 1) << 5); R = (st >> 1) * 16 + swz / 64; C = (st & 1) * 32 + (swz % 64) / 2; }

struct Unit { int pm, pn, grp; };
struct Gemm { const bf16_t* A; const bf16_t* Bt; int lda, ldb, K, nM, nN, ngrp; };
struct Order {
    int nM, nN, ngrp, nwg, G, c;
    __device__ void init(const Gemm& g, int G_, int c_) { nM = g.nM; nN = g.nN; ngrp = g.ngrp; nwg = nM * nN * ngrp; G = G_; c = c_; }
    __device__ bool next(int i, Unit& u) const {
        const long L = (long)i * G + c; if (L >= nwg) return false;
        if (ngrp == 1) {
            int wgid = (int)L; { const int q = nwg / NXCD, r = nwg % NXCD, xcd = wgid % NXCD, off = wgid / NXCD; wgid = (xcd < r ? xcd * (q + 1) : r * (q + 1) + (xcd - r) * q) + off; }
            const int nig = WGM * nN, gid = wgid / nig, fm = gid * WGM, gsz = (nM - fm) < WGM ? (nM - fm) : WGM;
            u.pm = fm + ((wgid % nig) % gsz); u.pn = (wgid % nig) / gsz; u.grp = 0;
        } else {
            const int per = nM * nN; const int w = (int)(L % per); u.grp = (int)(L / per); u.pm = w % nM; u.pn = w / nM;
        }
        return true;
    }
};

struct Epi {
    int mode, layer;
    bf16_t *Q, *Kb, *Vb, *Uext, *Y, *UPh;
    float* xloc; const float* rope; const float* gate; const float* base; float* xout;
    __device__ __forceinline__ void operator()(const f32x4 (&acc)[2][2][4][2], const Unit& u, int wr, int wc, int fr, int fq) const {
        const int colt = u.pn * BM;
#pragma unroll
        for (int ai = 0; ai < 2; ++ai)
#pragma unroll
            for (int m = 0; m < 4; ++m) {
                const int rl = ai * HALF + wr * 64 + m * 16 + fr;
                const int row = u.pm * BM + rl;
#pragma unroll
                for (int bj = 0; bj < 2; ++bj)
#pragma unroll
                    for (int n = 0; n < 2; ++n) {
                        const int cl = bj * HALF + wc * 32 + n * 16 + fq * 4;
                        const f32x4 v = acc[ai][bj][m][n];
                        if (mode == 1) {
                            if (colt < 2048) {
                                bf16_t* dst = colt < 1024 ? Q : Kb; const int cc = (colt & 1023) + cl; const int s = row & (SEQ - 1); const int i = (cc & 63) >> 1;
                                const f32x4 cs = *(const f32x4*)(rope + ((size_t)s * 32 + i) * 2);
                                const float o0 = v[0] * cs[0] - v[1] * cs[1], o1 = v[1] * cs[0] + v[0] * cs[1], o2 = v[2] * cs[2] - v[3] * cs[3], o3 = v[3] * cs[2] + v[2] * cs[3];
                                u32x2 w; w.x = cvt_pk_bf16(o0, o1); w.y = cvt_pk_bf16(o2, o3); *(u32x2*)(dst + (size_t)row * DM + cc) = w;
                            } else if (colt < 3072) {
                                u32x2 w; w.x = cvt_pk_bf16(v[0], v[1]); w.y = cvt_pk_bf16(v[2], v[3]); *(u32x2*)(Vb + (size_t)row * DM + (colt - 2048) + cl) = w;
                            } else {
                                const int uc = colt - 3072 + cl, g = uc >> 4, ni = uc & 15; const int b = row >> 12, s = row & (SEQ - 1), ch = s >> 5, sl = s & 31;
                                u32x2 w; w.x = cvt_pk_bf16(v[0], v[1]); w.y = cvt_pk_bf16(v[2], v[3]);
                                *(u32x2*)(Uext + ((size_t)(g * (NB * NCH) + b * NCH + ch)) * KX + sl * 16 + ni) = w;
                            }
                        } else if (mode == 2) {
                            *(f32x4*)(xloc + ((size_t)(u.grp * (NB * NCH) + row)) * 256 + cl) = v;
                        } else if (mode == 3) {
                            const int b = row >> 7, ch = row & 127; const int nn = colt + cl, t = nn >> 4, no = nn & 15; const size_t tok = (size_t)b * SEQ + ch * CH + t;
                            u32x2 w; w.x = cvt_pk_bf16(gelu_tanh(v[0]), gelu_tanh(v[1])); w.y = cvt_pk_bf16(gelu_tanh(v[2]), gelu_tanh(v[3]));
                            *(u32x2*)(Y + tok * 512 + u.grp * 16 + no) = w;
                        } else if (mode == 4) {
                            bf16_t* dst = colt < 1024 ? Kb : Vb; const int cc = (colt & 1023) + cl;
                            u32x2 w; w.x = cvt_pk_bf16(sigmoidf_(v[0]), sigmoidf_(v[1])); w.y = cvt_pk_bf16(sigmoidf_(v[2]), sigmoidf_(v[3])); *(u32x2*)(dst + (size_t)row * DM + cc) = w;
                        } else if (mode == 5) {
                            if (n == 0) {
                                const f32x4 bv = acc[ai][bj][m][1]; const int cc = u.pn * 128 + bj * 64 + wc * 16 + fq * 4; bf16_t* p = Vb + (size_t)row * DM + cc;
                                const u32x2 sg = *(const u32x2*)p;
                                u32x2 w; w.x = cvt_pk_bf16(v[0] * sigmoidf_(bv[0]) * bf_lo(sg.x), v[1] * sigmoidf_(bv[1]) * bf_hi(sg.x));
                                w.y = cvt_pk_bf16(v[2] * sigmoidf_(bv[2]) * bf_lo(sg.y), v[3] * sigmoidf_(bv[3]) * bf_hi(sg.y)); *(u32x2*)p = w;
                            }
                        } else if (mode == 6) {
                            const int cc = colt + cl; bf16_t* p = Kb + (size_t)row * DM + cc; const u32x2 sg = *(const u32x2*)p; const u32x2 os = *(const u32x2*)(Vb + (size_t)row * DM + cc);
                            u32x2 w; w.x = cvt_pk_bf16(bf_lo(sg.x) * v[0] + bf_lo(os.x), bf_hi(sg.x) * v[1] + bf_hi(os.x)); w.y = cvt_pk_bf16(bf_lo(sg.y) * v[2] + bf_lo(os.y), bf_hi(sg.y) * v[3] + bf_hi(os.y));
                            *(u32x2*)p = w;
                        } else if (mode == 7) {
                            const int cc = colt + cl; const int b = row >> 12; const f32x4 gt = *(const f32x4*)(gate + (size_t)b * 6144 + cc); const size_t off = (size_t)row * DM + cc;
                            const f32x4 bs = *(const f32x4*)(base + off); *(f32x4*)(xout + off) = bs + gt * v;
                        } else {
                            u32x2 w; w.x = cvt_pk_bf16(v[0], v[1]); w.y = cvt_pk_bf16(v[2], v[3]); *(u32x2*)(UPh + (size_t)row * NUP + colt + cl) = w;
                        }
                    }
            }
    }
};

__device__ __forceinline__ void gemm_phase(LAS unsigned char* lds, const Gemm g, const Order& S, const Epi& E) {
    int tid = threadIdx.x; asm volatile("" : "+v"(tid));
    const int wid = __builtin_amdgcn_readfirstlane(tid >> 6), lane = tid & 63, wr = wid >> 2, wc = wid & 3, fr = lane & 15, fq = lane >> 4;
    const int K = g.K, nt = K / BK;
    unsigned voffA[2], voffB[2];
#pragma unroll
    for (int i = 0; i < 2; ++i) { int R, C; stage_rc(tid * 16 + i * 8192, R, C); voffA[i] = (unsigned)(R * g.lda + C) * 2u; voffB[i] = (unsigned)(R * g.ldb + C) * 2u; }
    const size_t kstep = (size_t)(BK * 2);
    const size_t hstepA = (size_t)HALF * g.lda * 2, hstepB = (size_t)HALF * g.ldb * 2;
    const size_t tstepA = 2 * hstepA, tstepB = 2 * hstepB;
    const unsigned ldsw = (unsigned)wid * 1024u;
    const int aoff = lds_byte(wr * 64 + fr, fq * 8), boff = lds_byte(wc * 32 + fr, fq * 8);
#define PG8_SA(b, h) (((b) * 2 + (h)) * HTB)
#define PG8_SB(b, h) ((4 + (b) * 2 + (h)) * HTB)
#define PG8_STAGE(bufoff, gbase, voff) do { _Pragma("unroll") for (int _i = 0; _i < 2; ++_i) \
        __builtin_amdgcn_global_load_lds((const unsigned*)((const char*)(gbase) + (voff)[_i]), (LAS unsigned*)(lds + (bufoff) + ldsw + _i * 8192), 16, 0, 0); } while (0)
#define PG8_LDA(dst, b, h) do { _Pragma("unroll") for (int m = 0; m < 4; ++m) _Pragma("unroll") for (int k = 0; k < 2; ++k) dst[m][k] = *(const LAS bf16x8*)(lds + PG8_SA(b, h) + aoff + m * 2048 + k * 1024); } while (0)
#define PG8_LDB(dst, b, h) do { _Pragma("unroll") for (int n = 0; n < 2; ++n) _Pragma("unroll") for (int k = 0; k < 2; ++k) dst[n][k] = *(const LAS bf16x8*)(lds + PG8_SB(b, h) + boff + n * 2048 + k * 1024); } while (0)
#define PG8_MMA(ai, bj, At, Bt) do { __builtin_amdgcn_s_setprio(1); _Pragma("unroll") for (int m = 0; m < 4; ++m) _Pragma("unroll") for (int n = 0; n < 2; ++n) _Pragma("unroll") for (int k = 0; k < 2; ++k) \
        acc[ai][bj][m][n] = __builtin_amdgcn_mfma_f32_16x16x32_bf16(Bt[n][k], At[m][k], acc[ai][bj][m][n], 0, 0, 0); __builtin_amdgcn_s_setprio(0); } while (0)
#define PG8_WAIT_V(n) asm volatile("s_waitcnt vmcnt(" #n ")" ::: "memory")
#define PG8_WAIT_L(n) asm volatile("s_waitcnt lgkmcnt(" #n ")" ::: "memory")
#define PG8_BAR __builtin_amdgcn_s_barrier()
#define PG8_SCHED __builtin_amdgcn_sched_barrier(0)
    Unit cur, nxt; int ui = 0;
    if (!S.next(0, cur)) return;
    f32x4 acc[2][2][4][2];
#pragma unroll
    for (int a = 0; a < 2; ++a)
#pragma unroll
        for (int b = 0; b < 2; ++b)
#pragma unroll
            for (int m = 0; m < 4; ++m)
#pragma unroll
                for (int n = 0; n < 2; ++n) acc[a][b][m][n] = (f32x4){0.f, 0.f, 0.f, 0.f};
    bf16x8 At[4][2], B0[2][2], B1[2][2];
    const char* cA = (const char*)g.A + (size_t)(cur.grp * g.nM + cur.pm) * tstepA; const char* cB = (const char*)g.Bt + (size_t)(cur.grp * g.nN + cur.pn) * tstepB;
    PG8_STAGE(PG8_SB(0, 0), cB, voffB); PG8_STAGE(PG8_SB(0, 1), cB + hstepB, voffB); PG8_STAGE(PG8_SA(0, 0), cA, voffA); PG8_STAGE(PG8_SA(0, 1), cA + hstepA, voffA);
    if (wr == 1) PG8_BAR;
    PG8_WAIT_V(2); PG8_BAR;
    PG8_STAGE(PG8_SB(1, 0), cB + kstep, voffB); PG8_STAGE(PG8_SA(1, 0), cA + kstep, voffA); PG8_STAGE(PG8_SB(1, 1), cB + hstepB + kstep, voffB);
    PG8_WAIT_V(6); PG8_BAR;
    for (;;) {
        const bool has_next = S.next(ui + 1, nxt);
        const char* nA = has_next ? (const char*)g.A + (size_t)(nxt.grp * g.nM + nxt.pm) * tstepA : cA; const char* nB = has_next ? (const char*)g.Bt + (size_t)(nxt.grp * g.nN + nxt.pn) * tstepB : cB;
        for (int t = 0; t < nt; t += 2) {
            const bool last = (t == nt - 2);
            const char* a1 = cA + (size_t)(t + 1) * kstep;
            const char* a2 = last ? nA : cA + (size_t)(t + 2) * kstep; const char* b2 = last ? nB : cB + (size_t)(t + 2) * kstep;
            const char* a3 = a2 + kstep; const char* b3 = b2 + kstep;
            PG8_LDB(B0, 0, 0); PG8_LDB(B1, 0, 1); PG8_SCHED; PG8_LDA(At, 0, 0); PG8_STAGE(PG8_SA(1, 1), a1 + hstepA, voffA);
            PG8_WAIT_V(8); PG8_WAIT_L(0); PG8_BAR; PG8_MMA(0, 0, At, B0); PG8_MMA(0, 1, At, B1); PG8_BAR; PG8_SCHED;
            PG8_LDA(At, 0, 1); PG8_STAGE(PG8_SB(0, 0), b2, voffB); PG8_STAGE(PG8_SB(0, 1), b2 + hstepB, voffB); PG8_STAGE(PG8_SA(0, 0), a2, voffA);
            PG8_WAIT_V(8); PG8_WAIT_L(0); PG8_BAR; PG8_MMA(1, 0, At, B0); PG8_MMA(1, 1, At, B1); PG8_BAR; PG8_SCHED;
            PG8_LDB(B0, 1, 0); PG8_LDB(B1, 1, 1); PG8_SCHED; PG8_LDA(At, 1, 0); PG8_STAGE(PG8_SA(0, 1), a2 + hstepA, voffA);
            PG8_WAIT_V(8); PG8_WAIT_L(0); PG8_BAR; PG8_MMA(0, 0, At, B0); PG8_MMA(0, 1, At, B1); PG8_BAR; PG8_SCHED;
            PG8_LDA(At, 1, 1); PG8_STAGE(PG8_SB(1, 0), b3, voffB); PG8_STAGE(PG8_SB(1, 1), b3 + hstepB, voffB); PG8_STAGE(PG8_SA(1, 0), a3, voffA);
            PG8_WAIT_V(8); PG8_WAIT_L(0); PG8_BAR; PG8_MMA(1, 0, At, B0); PG8_MMA(1, 1, At, B1); PG8_BAR; PG8_SCHED;
        }
        if (wr == 0) PG8_BAR;
        E(acc, cur, wr, wc, fr, fq);
        if (!has_next) break;
#pragma unroll
        for (int a = 0; a < 2; ++a)
#pragma unroll
            for (int b = 0; b < 2; ++b)
#pragma unroll
                for (int m = 0; m < 4; ++m)
#pragma unroll
                    for (int n = 0; n < 2; ++n) acc[a][b][m][n] = (f32x4){0.f, 0.f, 0.f, 0.f};
        cur = nxt; cA = nA; cB = nB; ++ui;
        if (wr == 1) PG8_BAR;
    }
    PG8_WAIT_V(0);
    PG8_BAR;
#undef PG8_SA
#undef PG8_SB
#undef PG8_STAGE
#undef PG8_LDA
#undef PG8_LDB
#undef PG8_MMA
#undef PG8_WAIT_V
#undef PG8_WAIT_L
#undef PG8_BAR
#undef PG8_SCHED
}
}

namespace att {
constexpr int D = 128, NW = 8, QBLK = 32, KVBLK = 64, LD = DM;
constexpr float SCALE = 0.125f, THR = 8.f;
constexpr size_t SHM_V = KVBLK * D * 2, SHM_K = KVBLK * 64 * 2;
#define KSWZ(row, colB) ((row) * 128 + ((colB) ^ ((((row) >> 1) & 7) << 4)))
#define SBAR() __builtin_amdgcn_sched_barrier(0)
__device__ __forceinline__ int crow(int r, int hi) { return (r & 3) + 8 * (r >> 2) + 4 * hi; }
__device__ __forceinline__ void partialSM(f32x16& p0, f32x16& p1, float& m_reg, float& mn, float& alpha) {
    constexpr float C = SCALE * 1.4426950408889634f;
    float pmax = p0[0];
#pragma unroll
    for (int r = 1; r < 16; ++r) pmax = fmaxf(pmax, p0[r]);
#pragma unroll
    for (int r = 0; r < 16; ++r) pmax = fmaxf(pmax, p1[r]);
    { auto rr = __builtin_amdgcn_permlane32_swap(__float_as_uint(pmax), __float_as_uint(pmax), false, false);
      pmax = fmaxf(__uint_as_float(rr[0]), __uint_as_float(rr[1])); }
    if (__builtin_expect(__all(pmax - m_reg <= THR / SCALE), 1)) { mn = m_reg; alpha = 1.f; }
    else { mn = fmaxf(m_reg, pmax); alpha = __builtin_amdgcn_exp2f((m_reg - mn) * C); m_reg = mn; }
    const float mnC = -mn * C;
#pragma unroll
    for (int r = 0; r < 16; ++r) p0[r] = fmaf(p0[r], C, mnC);
#pragma unroll
    for (int r = 0; r < 16; ++r) p1[r] = fmaf(p1[r], C, mnC);
#pragma unroll
    for (int r = 0; r < 16; ++r) p0[r] = __builtin_amdgcn_exp2f(p0[r]);
}
__device__ __forceinline__ void finishSM(f32x16& p0, f32x16& p1, float alpha, float& l_reg, bf16x8& pa0, bf16x8& pa1, bf16x8& pa2, bf16x8& pa3) {
#pragma unroll
    for (int r = 0; r < 16; ++r) p1[r] = __builtin_amdgcn_exp2f(p1[r]);
    float ps = 0;
#pragma unroll
    for (int r = 0; r < 16; ++r) ps += p0[r];
#pragma unroll
    for (int r = 0; r < 16; ++r) ps += p1[r];
    { auto rr = __builtin_amdgcn_permlane32_swap(__float_as_uint(ps), __float_as_uint(ps), false, false);
      ps = __uint_as_float(rr[0]) + __uint_as_float(rr[1]); }
    l_reg = l_reg * alpha + ps;
#define PK4(P, BASE, OUT) do { unsigned a0 = cvt_pk_bf16(P[BASE + 0], P[BASE + 1]), a1 = cvt_pk_bf16(P[BASE + 2], P[BASE + 3]);   \
    unsigned b0 = cvt_pk_bf16(P[BASE + 4], P[BASE + 5]), b1 = cvt_pk_bf16(P[BASE + 6], P[BASE + 7]);                              \
    auto r0 = __builtin_amdgcn_permlane32_swap(a0, b0, false, false); auto r1 = __builtin_amdgcn_permlane32_swap(a1, b1, false, false); \
    u32x4 w = {r0[0], r1[0], r0[1], r1[1]}; OUT = *reinterpret_cast<bf16x8*>(&w); } while (0)
    PK4(p0, 0, pa0); PK4(p0, 8, pa1); PK4(p1, 0, pa2); PK4(p1, 8, pa3);
#undef PK4
}
__device__ __forceinline__ void qkt(f32x16& p0, f32x16& p1, const char* Ks, const bf16x8* qr, int r32, int hi) {
    p0 = f32x16{}; p1 = f32x16{};
#pragma unroll
    for (int d0 = 0; d0 < 4; ++d0) { const int cb = (d0 * 16 + hi * 8) * 2;
        const bf16x8 b0 = *reinterpret_cast<const bf16x8*>(Ks + KSWZ(r32, cb));
        const bf16x8 b1 = *reinterpret_cast<const bf16x8*>(Ks + KSWZ(32 + r32, cb));
        p0 = __builtin_amdgcn_mfma_f32_32x32x16_bf16(b0, qr[d0], p0, 0, 0, 0);
        p1 = __builtin_amdgcn_mfma_f32_32x32x16_bf16(b1, qr[d0], p1, 0, 0, 0); }
}
__device__ __forceinline__ int v_st(int k, int c) { const int kk = (k & ~0xC) | ((k & 4) << 1) | ((k & 8) >> 1); return ((kk >> 3) * 4 + (c >> 5)) * 512 + ((kk & 7) * 32 + (c & 31)) * 2; }
__device__ __forceinline__ int v_rd_base(int lane) { return ((lane & 3) << 3) | (((lane >> 2) & 3) << 6) | (((lane >> 4) & 1) << 5) | (((lane >> 5) & 1) << 8); }
constexpr int v_rd_off(int d0, int ks, int half) { return d0 * 512 + ks * 4096 + half * 2048; }
template <int OFF> __device__ __forceinline__ s16x4 tr_read(int vb) {
    s16x4 r; asm volatile("ds_read_b64_tr_b16 %0, %1 offset:%2" : "=&v"(r) : "v"(vb), "i"(OFF) : "memory"); return r;
}
template <int D0> __device__ __forceinline__ void pv_one(f32x16& od, int vb, bf16x8 pa0, bf16x8 pa1, bf16x8 pa2, bf16x8 pa3) {
    const s16x4 l0 = tr_read<v_rd_off(D0, 0, 0)>(vb), h0 = tr_read<v_rd_off(D0, 0, 1)>(vb), l1 = tr_read<v_rd_off(D0, 1, 0)>(vb), h1 = tr_read<v_rd_off(D0, 1, 1)>(vb);
    const s16x4 l2 = tr_read<v_rd_off(D0, 2, 0)>(vb), h2 = tr_read<v_rd_off(D0, 2, 1)>(vb), l3 = tr_read<v_rd_off(D0, 3, 0)>(vb), h3 = tr_read<v_rd_off(D0, 3, 1)>(vb);
    asm volatile("s_waitcnt lgkmcnt(0)" ::: "memory"); SBAR();
#define PK(L, H) (bf16x8){L[0], L[1], L[2], L[3], H[0], H[1], H[2], H[3]}
    od = __builtin_amdgcn_mfma_f32_32x32x16_bf16(pa0, PK(l0, h0), od, 0, 0, 0);
    od = __builtin_amdgcn_mfma_f32_32x32x16_bf16(pa1, PK(l1, h1), od, 0, 0, 0);
    od = __builtin_amdgcn_mfma_f32_32x32x16_bf16(pa2, PK(l2, h2), od, 0, 0, 0);
    od = __builtin_amdgcn_mfma_f32_32x32x16_bf16(pa3, PK(l3, h3), od, 0, 0, 0);
#undef PK
}
__device__ __forceinline__ void pv_d0(f32x16* o, int vb, bf16x8 pa0, bf16x8 pa1, bf16x8 pa2, bf16x8 pa3) {
    pv_one<0>(o[0], vb, pa0, pa1, pa2, pa3); pv_one<1>(o[1], vb, pa0, pa1, pa2, pa3); pv_one<2>(o[2], vb, pa0, pa1, pa2, pa3); pv_one<3>(o[3], vb, pa0, pa1, pa2, pa3);
}

__device__ __forceinline__ void attn_pass(const bf16_t* __restrict__ Qb, const bf16_t* __restrict__ Kh, const bf16_t* __restrict__ Vh, f32x16 (&o)[4], float (&rli)[16], char* lds) {
    int tid = threadIdx.x; asm volatile("" : "+v"(tid));
    const int wid = tid >> 6, lane = tid & 63, r32 = lane & 31, hi = lane >> 5;
    char* V_lds = lds; char* K_lds = lds + 2 * SHM_V;
    float* ws = (float*)(lds + 2 * SHM_V + 2 * SHM_K) + wid * 64; float* li_l = ws; float* al_l = ws + 32;
    float m_reg = -1e30f, l_reg = 0; bf16x8 qr[4];
#pragma unroll
    for (int d = 0; d < 4; ++d) o[d] = f32x16{};
    const bf16_t* Qw = Qb + (long)(wid * QBLK + r32) * LD + hi * 8;
#pragma unroll
    for (int d0 = 0; d0 < 4; ++d0) qr[d0] = *reinterpret_cast<const bf16x8*>(Qw + d0 * 16);
    const int sr = tid >> 4, sc = (tid & 15) * 8, vst0 = v_st(sr, sc), vst1 = v_st(32 + sr, sc);
    const int kr = tid >> 3, kc = (tid & 7) * 8, kst = KSWZ(kr, kc * 2);
    const int vb0 = (int)(uintptr_t)V_lds + v_rd_base(lane);
    struct { bf16x8 vs0, vs1, ks0; } sr_[2];
#define SLOAD(i, k0) do { sr_[i].vs0 = *reinterpret_cast<const bf16x8*>(&Vh[(long)((k0) + sr) * LD + sc]); sr_[i].vs1 = *reinterpret_cast<const bf16x8*>(&Vh[(long)((k0) + 32 + sr) * LD + sc]); \
    sr_[i].ks0 = *reinterpret_cast<const bf16x8*>(&Kh[(long)((k0) + kr) * LD + kc]); } while (0)
#define SWRITE(b, i) do { *(bf16x8*)(V_lds + (b) * SHM_V + vst0) = sr_[i].vs0; *(bf16x8*)(V_lds + (b) * SHM_V + vst1) = sr_[i].vs1; *(bf16x8*)(K_lds + (b) * SHM_K + kst) = sr_[i].ks0; } while (0)
#define SWAIT() asm volatile("s_waitcnt vmcnt(3)" ::: "memory")
#define RESC(a) do { if (__any((a) < 1.f)) { if (hi == 0) al_l[r32] = (a); asm volatile("s_waitcnt lgkmcnt(0)" ::: "memory"); \
    _Pragma("unroll") for (int d = 0; d < 4; ++d) _Pragma("unroll") for (int r = 0; r < 16; ++r) o[d][r] *= al_l[crow(r, hi)]; } } while (0)
    f32x16 pA0, pA1, pB0, pB1; float mnA, mnB, alA, alB; bf16x8 pa0, pa1, pa2, pa3; const int NT = SEQ / KVBLK;
    constexpr int SE = 0, SO = 1;
    SLOAD(SE, 0); asm volatile("s_waitcnt vmcnt(0)" ::: "memory"); SWRITE(0, SE); __syncthreads();
    qkt(pA0, pA1, K_lds, qr, r32, hi); partialSM(pA0, pA1, m_reg, mnA, alA);
    SLOAD(SO, KVBLK); SLOAD(SE, 2 * KVBLK);
    SWAIT(); SWRITE(1, SO); __syncthreads();
    for (int j = 1; j + 1 < NT; j += 2) {
        SBAR(); qkt(pB0, pB1, K_lds + SHM_K, qr, r32, hi);
        finishSM(pA0, pA1, alA, l_reg, pa0, pa1, pa2, pa3); SBAR();
        SLOAD(SO, (j + 2) * KVBLK); SBAR();
        pv_d0(o, vb0, pa0, pa1, pa2, pa3); partialSM(pB0, pB1, m_reg, mnB, alB);
        __syncthreads(); SWAIT(); SWRITE(0, SE);
        RESC(alB); __syncthreads();
        SBAR(); qkt(pA0, pA1, K_lds, qr, r32, hi);
        finishSM(pB0, pB1, alB, l_reg, pa0, pa1, pa2, pa3); SBAR();
        if (j + 3 < NT) SLOAD(SE, (j + 3) * KVBLK); SBAR();
        pv_d0(o, vb0 + (int)SHM_V, pa0, pa1, pa2, pa3); partialSM(pA0, pA1, m_reg, mnA, alA);
        __syncthreads(); SWAIT(); SWRITE(1, SO);
        RESC(alA); __syncthreads();
    }
    SBAR(); qkt(pB0, pB1, K_lds + SHM_K, qr, r32, hi);
    finishSM(pA0, pA1, alA, l_reg, pa0, pa1, pa2, pa3); SBAR();
    pv_d0(o, vb0, pa0, pa1, pa2, pa3); partialSM(pB0, pB1, m_reg, mnB, alB);
    __syncthreads(); RESC(alB);
    finishSM(pB0, pB1, alB, l_reg, pa0, pa1, pa2, pa3); SBAR();
    pv_d0(o, vb0 + (int)SHM_V, pa0, pa1, pa2, pa3);
    if (hi == 0) li_l[r32] = l_reg; asm volatile("s_waitcnt lgkmcnt(0)" ::: "memory");
#pragma unroll
    for (int r = 0; r < 16; ++r) rli[r] = __builtin_amdgcn_rcpf(li_l[crow(r, hi)]);
    __syncthreads();
#undef SLOAD
#undef SWRITE
#undef SWAIT
#undef RESC
}

__device__ __forceinline__ void attn_unit(int b, int h, int qb, const bf16_t* Q, const bf16_t* K, const bf16_t* V, bf16_t* O, float* scr, float lam, float onem, const float* subw, char* lds) {
    int tid = threadIdx.x; asm volatile("" : "+v"(tid));
    const int wid = tid >> 6, lane = tid & 63, r32 = lane & 31, hi = lane >> 5;
    const size_t rowbase = (size_t)b * SEQ;
    f32x16 o[4]; float rli[16];
#pragma unroll 1
    for (int pass = 0; pass < 2; ++pass) {
        const int sub = 2 * h + pass;
        attn_pass(Q + (rowbase + (size_t)qb * 256) * LD + sub * 64, K + rowbase * LD + sub * 64, V + rowbase * LD + h * 128, o, rli, lds);
        int t2 = tid; asm volatile("" : "+v"(t2));
        const int lane2 = t2 & 63, r32b = lane2 & 31, hib = lane2 >> 5, wid2 = t2 >> 6;
        float* sp = scr + (size_t)t2 * 64;
        if (pass == 0) {
#pragma unroll
            for (int d0 = 0; d0 < 4; ++d0)
#pragma unroll
                for (int r4 = 0; r4 < 4; ++r4) *(f32x4*)(sp + d0 * 16 + r4 * 4) = (f32x4){o[d0][4 * r4] * rli[4 * r4], o[d0][4 * r4 + 1] * rli[4 * r4 + 1], o[d0][4 * r4 + 2] * rli[4 * r4 + 2], o[d0][4 * r4 + 3] * rli[4 * r4 + 3]};
        } else {
            float ss[16];
#pragma unroll
            for (int r = 0; r < 16; ++r) ss[r] = 0.f;
#pragma unroll
            for (int d0 = 0; d0 < 4; ++d0)
#pragma unroll
                for (int r4 = 0; r4 < 4; ++r4) { const f32x4 o1 = *(const f32x4*)(sp + d0 * 16 + r4 * 4);
#pragma unroll
                    for (int q = 0; q < 4; ++q) { const int r = 4 * r4 + q; const float v = o1[q] - lam * (o[d0][r] * rli[r]); o[d0][r] = v; ss[r] += v * v; } }
#pragma unroll
            for (int r = 0; r < 16; ++r) {
#pragma unroll
                for (int x = 1; x < 32; x <<= 1) ss[r] += __shfl_xor(ss[r], x);
                ss[r] = rsqrtf(ss[r] * (1.0f / 128.0f) + 1e-5f) * onem; }
            bf16_t* Ow = O + (rowbase + (size_t)qb * 256 + wid2 * QBLK + 4 * hib) * LD + h * 128 + r32b;
#pragma unroll
            for (int d0 = 0; d0 < 4; ++d0) { const float sw = subw[d0 * 32 + r32b];
#pragma unroll
                for (int r = 0; r < 16; ++r) { const unsigned w = cvt_pk_bf16(o[d0][r] * ss[r] * sw, 0.f); Ow[(size_t)((r & 3) + 8 * (r >> 2)) * LD + d0 * 32] = (bf16_t)(w & 0xffffu); } }
        }
    }
}
#undef SBAR
}

__device__ __forceinline__ void transpose_item(const float* W, const float* W2, int K, int ldw, int coff, int sel, int ndst, bf16_t* WT, LAS float* scr, int item, int lane) {
    const int nblk = ndst / 32, kb = item / nblk, nb = item % nblk, k0 = 64 * kb, n0 = 32 * nb;
    const int nd = n0 + (lane & 31); int sc = nd + coff; const float* Wp = W;
    if (sel == 1 && nd < 2048) { const int j = nd & 63; sc = (nd & ~63) + (j & 1) * 32 + (j >> 1); }
    if (sel == 2) { sc = (nd >> 5) * 16 + (nd & 15); if ((nd >> 4) & 1) Wp = W2; }
#pragma unroll 8
    for (int i = 0; i < 32; ++i) { const int kk = 2 * i + (lane >> 5); scr[kk * 33 + (lane & 31)] = Wp[(size_t)(k0 + kk) * ldw + sc]; }
    asm volatile("s_waitcnt lgkmcnt(0)" ::: "memory");
    const int c = lane & 7;
#pragma unroll
    for (int j = 0; j < 4; ++j) { const int n = (lane >> 3) + 8 * j; const LAS float* s = scr + (8 * c) * 33 + n;
        u32x4 o; o.x = cvt_pk_bf16(s[0 * 33], s[1 * 33]); o.y = cvt_pk_bf16(s[2 * 33], s[3 * 33]); o.z = cvt_pk_bf16(s[4 * 33], s[5 * 33]); o.w = cvt_pk_bf16(s[6 * 33], s[7 * 33]);
        *(u32x4*)(WT + (size_t)(n0 + n) * K + k0 + 8 * c) = o; }
    asm volatile("s_waitcnt lgkmcnt(0)" ::: "memory");
}

__global__ void __launch_bounds__(NTHR, 2) mega(Params P) {
    extern __shared__ __attribute__((aligned(16))) unsigned char lds_raw[];
    cg::grid_group grid = cg::this_grid();
    LAS unsigned char* lds = (LAS unsigned char*)lds_raw;
    const int G = gridDim.x, bx = blockIdx.x; const int vcu = (G % 8 == 0) ? (bx % 8) * (G / 8) + bx / 8 : bx;
    const int NGW = G * NWAVES; const long NGT = (long)G * NTHR;
    float* xo = P.out;
#define PH_INIT unsigned char* ws = P.ws; int tid = threadIdx.x; int L = l; asm volatile("" : "+s"(ws), "+v"(tid), "+s"(L)); \
    const int lane = tid & 63, wave = __builtin_amdgcn_readfirstlane(tid >> 6); const int gw = vcu * NWAVES + wave; const long gtid = (long)vcu * NTHR + tid; (void)lane; (void)gw; (void)gtid; \
    float* MOD = (float*)(ws + WS_MOD); float* ROPE = (float*)(ws + WS_ROPE); f32x2* PW = (f32x2*)(ws + WS_PW); f32x2* BB = (f32x2*)(ws + WS_BB); float* KM = (float*)(ws + WS_KM); \
    bf16_t* WQKVU = (bf16_t*)(ws + WS_WQKVU); bf16_t* WG = (bf16_t*)(ws + WS_WG); bf16_t* WAO = (bf16_t*)(ws + WS_WAO); bf16_t* WGLU = (bf16_t*)(ws + WS_WGLU); \
    bf16_t* WOUT = (bf16_t*)(ws + WS_WOUT); bf16_t* WUP = (bf16_t*)(ws + WS_WUP); bf16_t* WDOWN = (bf16_t*)(ws + WS_WDOWN); \
    bf16_t* TMAT = (bf16_t*)(ws + WS_TMAT); bf16_t* EMAT = (bf16_t*)(ws + WS_EMAT); bf16_t* XN = (bf16_t*)(ws + WS_XN); \
    bf16_t* QB = (bf16_t*)(ws + WS_Q); bf16_t* KB = (bf16_t*)(ws + WS_K); bf16_t* VB = (bf16_t*)(ws + WS_V); bf16_t* UEXT = (bf16_t*)(ws + WS_UEXT); \
    float* XLOC = (float*)(ws + WS_XLOC); bf16_t* YB = (bf16_t*)(ws + WS_XLOC); float* SCR = (float*)(ws + WS_SCR); \
    bf16_t* UPH = (bf16_t*)(ws + WS_UP); bf16_t* ACT = (bf16_t*)(ws + WS_ACT); \
    (void)MOD; (void)ROPE; (void)PW; (void)BB; (void)KM; (void)WQKVU; (void)WG; (void)WAO; (void)WGLU; (void)WOUT; (void)WUP; (void)WDOWN; (void)TMAT; (void)EMAT; (void)XN; (void)QB; (void)KB; (void)VB; (void)UEXT; (void)XLOC; (void)YB; (void)SCR; (void)UPH; (void)ACT
#define MAKE_E pg8::Epi E{}; E.layer = L; E.Q = QB; E.Kb = KB; E.Vb = VB; E.Uext = UEXT; E.Y = YB; E.UPh = UPH; E.xloc = XLOC; E.rope = ROPE; E.xout = xo

#define RUN_GEMM(A_, Bt_, lda_, ldb_, K_, nM_, nN_, ngrp_, epi_) do { pg8::Gemm g_{A_, Bt_, lda_, ldb_, K_, nM_, nN_, ngrp_}; pg8::Order S_; S_.init(g_, G, bx); pg8::gemm_phase(lds, g_, S_, epi_); } while (0)

#pragma unroll 1
    for (int l = 0; l < 2; ++l) {
        const float lambda_init = (l == 0) ? 0.2f : 0.35550906759f;
        {
            PH_INIT;
            LAS float* scr = (LAS float*)(lds + wave * 16384);
            const int I1 = 16 * 112, I2 = 16 * 64, I3 = 16 * 32, I4 = 8 * 64, I5 = 16 * 32, I6 = 16 * 176, I7 = 44 * 32, NI = I1 + I2 + I3 + I4 + I5 + I6 + I7;
            const float* win = P.in[I_WIN] + (size_t)L * DM * 5632;
            for (int it = gw; it < NI; it += NGW) {
                int r = it;
                if (r < I1) { transpose_item(win, nullptr, 1024, 5632, 0, 1, 3584, WQKVU, scr, r, lane); continue; } r -= I1;
                if (r < I2) { transpose_item(win, nullptr, 1024, 5632, 3584, 0, 2048, WG, scr, r, lane); continue; } r -= I2;
                if (r < I3) { transpose_item(P.in[I_WAO] + (size_t)L * DM * DM, nullptr, 1024, 1024, 0, 0, 1024, WAO, scr, r, lane); continue; } r -= I3;
                if (r < I4) { transpose_item(P.in[I_WGA] + (size_t)L * 512 * DM, P.in[I_WGB] + (size_t)L * 512 * DM, 512, 1024, 0, 2, 2048, WGLU, scr, r, lane); continue; } r -= I4;
                if (r < I5) { transpose_item(P.in[I_WOUT] + (size_t)L * DM * DM, nullptr, 1024, 1024, 0, 0, 1024, WOUT, scr, r, lane); continue; } r -= I5;
                if (r < I6) { transpose_item(P.in[I_WUP] + (size_t)L * DM * NUP, nullptr, 1024, NUP, 0, 0, NUP, WUP, scr, r, lane); continue; } r -= I6;
                transpose_item(P.in[I_WDOWN] + (size_t)L * DFF * DM, nullptr, DFF, 1024, 0, 0, 1024, WDOWN, scr, r, lane);
            }
            for (long i = gtid; i < 2 * 32 * 33 * 64; i += NGT) {
                const int p = (int)(i & 63); const int tau = (int)((i >> 6) % 33); const int dg = (int)(i / (64 * 33));
                const size_t li = ((size_t)L * 64 + dg) * 64 + p; const float lr = P.in[I_SLRE][li], lim = P.in[I_SLIM][li]; const float dt = expf(P.in[I_SLDT][L * 64 + dg]);
                const float mag = expf(lr * dt * (float)tau), ang = (lim * dt) * (float)tau;
                PW[i] = (f32x2){mag * cosf(ang), mag * sinf(ang)};
            }
            for (long i = gtid; i < 2 * 32 * 64 * 16; i += NGT) {
                const int p = (int)((i >> 4) & 63); const int dg = (int)(i >> 10);
                const size_t li = ((size_t)L * 64 + dg) * 64 + p; const float lr = P.in[I_SLRE][li], lim = P.in[I_SLIM][li]; const float dt = expf(P.in[I_SLDT][L * 64 + dg]);
                const float mag = expf(lr * dt), ang = lim * dt; const float ar = mag * cosf(ang), ai = mag * sinf(ang);
                const float den = lr * lr + lim * lim, nr = ar - 1.0f, ni_ = ai;
                const float fre = (nr * lr + ni_ * lim) / den, fim = (ni_ * lr - nr * lim) / den;
                const size_t bi = (size_t)L * 2 * 32 * 64 * 16 + i; const float br = P.in[I_SBRE][bi], bim = P.in[I_SBIM][bi];
                BB[i] = (f32x2){fre * br - fim * bim, fre * bim + fim * br};
            }
            if (L == 0) {
                for (long i = gtid; i < SEQ * 32; i += NGT) { const int s = (int)(i >> 5), f = (int)(i & 31);
                    const float inv = powf(10000.0f, -(float)f / 32.0f); const float ang = (float)s * inv; ROPE[2 * i] = cosf(ang); ROPE[2 * i + 1] = sinf(ang); }
                LAS float* cact = (LAS float*)lds; LAS float* red = (LAS float*)(lds + 32768);
                __syncthreads();
                for (int it = bx; it < 192; it += G) {
                    const int ll = it / 96, j0 = (it % 96) * 64;
                    for (int i = tid; i < NB * DM; i += NTHR) { const float cv = P.in[I_C][i]; cact[i] = cv / (1.0f + expf(-cv)); }
                    __syncthreads();
                    float a[NB];
#pragma unroll
                    for (int b = 0; b < NB; ++b) a[b] = 0.f;
                    const float* aw = P.in[I_ADAW] + (size_t)ll * DM * 6144 + j0 + lane;
                    for (int k = wave * 128; k < wave * 128 + 128; ++k) { const float wv = aw[(size_t)k * 6144];
#pragma unroll
                        for (int b = 0; b < NB; ++b) a[b] += cact[b * DM + k] * wv; }
#pragma unroll
                    for (int b = 0; b < NB; ++b) red[(wave * NB + b) * 64 + lane] = a[b];
                    __syncthreads();
                    { const int b = tid >> 6; float s = P.in[I_ADAB][ll * 6144 + j0 + lane];
#pragma unroll
                      for (int w = 0; w < NWAVES; ++w) s += red[(w * NB + b) * 64 + lane];
                      MOD[((size_t)ll * NB + b) * 6144 + j0 + lane] = s; }
                    __syncthreads();
                }
            }
        }
        grid.sync();
        {
            PH_INIT;
            const float* xin = (L == 0) ? P.in[I_X] : xo; const float* nw = P.in[I_N1W] + L * DM;
            for (int m = gw; m < T; m += NGW) {
                const int b = m >> 12; const f32x4* xr = (const f32x4*)(xin + (size_t)m * DM) + lane; f32x4 v[4]; float s = 0.f;
#pragma unroll
                for (int j = 0; j < 4; ++j) { v[j] = xr[64 * j]; s += (v[j][0] * v[j][0] + v[j][1] * v[j][1]) + (v[j][2] * v[j][2] + v[j][3] * v[j][3]); }
                const float r = rsqrtf(wave_sum(s) * (1.0f / DM) + 1e-6f);
                const float* md = MOD + ((size_t)L * NB + b) * 6144;
#pragma unroll
                for (int j = 0; j < 4; ++j) { const int col = lane * 4 + 256 * j; const f32x4 w4 = *(const f32x4*)(nw + col), sh = *(const f32x4*)(md + col), sc = *(const f32x4*)(md + 1024 + col);
                    const f32x4 hv = v[j] * r * w4 * (sc + 1.0f) + sh; u32x2 w; w.x = cvt_pk_bf16(hv[0], hv[1]); w.y = cvt_pk_bf16(hv[2], hv[3]); *(u32x2*)(XN + (size_t)m * DM + col) = w; }
            }
            for (long i = gtid; i < 2 * 32 * 32 * 256; i += NGT) {
                const int ni = (int)(i & 15), no = (int)((i >> 4) & 15), tau = (int)((i >> 8) & 31), dg = (int)(i >> 13);
                const float* cre = P.in[I_SCRE] + (((size_t)L * 64 + dg) * 16 + no) * 64; const float* cim = P.in[I_SCIM] + (((size_t)L * 64 + dg) * 16 + no) * 64;
                const f32x2* pw = PW + ((size_t)dg * 33 + tau) * 64; const f32x2* bb = BB + (size_t)dg * 1024 + ni; float acc = 0.f;
                for (int p = 0; p < 64; ++p) { const f32x2 w = pw[p], bv = bb[p * 16]; const float cr = cre[p], ci = cim[p]; const float zr = cr * w.x - ci * w.y, zi = cr * w.y + ci * w.x; acc += zr * bv.x - zi * bv.y; }
                KM[i] = acc;
            }
            for (long i = gtid; i < 32 * 256 * 64; i += NGT) {
                const int k8 = (int)(i & 63), n = (int)((i >> 6) & 255), g = (int)(i >> 14); const int dir = n >> 7, ri = (n >> 6) & 1, p = n & 63; const int s = k8 >> 1, ni0 = (k8 & 1) * 8;
                const int e = dir == 0 ? (CH - 1 - s) : s; const f32x2 w = PW[((size_t)(dir * 32 + g) * 33 + e) * 64 + p]; const f32x2* bb = BB + ((size_t)(dir * 32 + g) * 64 + p) * 16 + ni0;
                float o[8];
#pragma unroll
                for (int q = 0; q < 8; ++q) { const f32x2 bv = bb[q]; o[q] = ri == 0 ? (w.x * bv.x - w.y * bv.y) : (w.x * bv.y + w.y * bv.x); }
                u32x4 ov; ov.x = cvt_pk_bf16(o[0], o[1]); ov.y = cvt_pk_bf16(o[2], o[3]); ov.z = cvt_pk_bf16(o[4], o[5]); ov.w = cvt_pk_bf16(o[6], o[7]);
                *(u32x4*)(EMAT + ((size_t)g * 256 + n) * 512 + k8 * 8) = ov;
            }
            for (long i = gtid; i < 32 * 512 * 32; i += NGT) {
                const int c8 = (int)(i & 31), n = (int)((i >> 5) & 511), g = (int)(i >> 14); const int t = n >> 4, no = n & 15; const int dir = c8 >> 4, ri = (c8 >> 3) & 1, p0 = (c8 & 7) * 8;
                const int e = dir == 0 ? (t + 1) : (CH - t); const f32x2* pw = PW + ((size_t)(dir * 32 + g) * 33 + e) * 64 + p0;
                const float* cre = P.in[I_SCRE] + ((((size_t)L * 2 + dir) * 32 + g) * 16 + no) * 64 + p0; const float* cim = P.in[I_SCIM] + ((((size_t)L * 2 + dir) * 32 + g) * 16 + no) * 64 + p0;
                float o[8];
#pragma unroll
                for (int q = 0; q < 8; ++q) { const f32x2 w = pw[q]; const float cr = cre[q], ci = cim[q]; o[q] = ri == 0 ? (cr * w.x - ci * w.y) : -(cr * w.y + ci * w.x); }
                u32x4 ov; ov.x = cvt_pk_bf16(o[0], o[1]); ov.y = cvt_pk_bf16(o[2], o[3]); ov.z = cvt_pk_bf16(o[4], o[5]); ov.w = cvt_pk_bf16(o[6], o[7]);
                *(u32x4*)(TMAT + ((size_t)g * 512 + n) * KX + 512 + c8 * 8) = ov;
            }
        }
        grid.sync();
        { PH_INIT; MAKE_E; E.mode = 1; RUN_GEMM(XN, WQKVU, 1024, 1024, 1024, 128, 14, 1, E); }
        grid.sync();
        { PH_INIT; MAKE_E; E.mode = 2; RUN_GEMM(UEXT, EMAT, KX, 512, 512, 4, 1, 32, E); }
        {
            PH_INIT;
            const float* dsk = P.in[I_SD] + L * 512;
            for (long i = gtid; i < 32 * 512 * 64; i += NGT) {
                const int k8 = (int)(i & 63), n = (int)((i >> 6) & 511), g = (int)(i >> 15); const int t = n >> 4, no = n & 15, s = k8 >> 1, ni0 = (k8 & 1) * 8;
                float o[8];
                if (t != s) { const int dir = t > s ? 0 : 1, tau = t > s ? t - s : s - t; const float* km = KM + ((((size_t)(dir * 32 + g)) * 32 + tau) * 16 + no) * 16 + ni0;
#pragma unroll
                    for (int q = 0; q < 8; ++q) o[q] = km[q];
                } else { const float* k0 = KM + (((size_t)(g) * 32) * 16 + no) * 16 + ni0; const float* k1 = KM + (((size_t)(32 + g) * 32) * 16 + no) * 16 + ni0;
#pragma unroll
                    for (int q = 0; q < 8; ++q) o[q] = k0[q] + k1[q] + ((ni0 + q) == no ? dsk[g * 16 + no] : 0.f);
                }
                u32x4 ov; ov.x = cvt_pk_bf16(o[0], o[1]); ov.y = cvt_pk_bf16(o[2], o[3]); ov.z = cvt_pk_bf16(o[4], o[5]); ov.w = cvt_pk_bf16(o[6], o[7]);
                *(u32x4*)(TMAT + ((size_t)g * 512 + n) * KX + k8 * 8) = ov;
            }
        }
        grid.sync();
        {
            PH_INIT;
            const long i = gtid;
            if (i < 32 * NB * 2 * 64) {
                const int p = (int)(i & 63), dir = (int)((i >> 6) & 1), b = (int)((i >> 7) & 7), g = (int)(i >> 10);
                const f32x2 al = PW[((size_t)(dir * 32 + g) * 33 + CH) * 64 + p];
                float xr = 0.f, xi = 0.f;
                const float* xl = XLOC + ((size_t)g * (NB * NCH) + b * NCH) * 256 + dir * 128 + p;
                bf16_t* ue = UEXT + ((size_t)g * (NB * NCH) + b * NCH) * KX + 512 + dir * 128 + p;
#pragma unroll 4
                for (int cc = 0; cc < NCH; ++cc) {
                    const int c = dir == 0 ? cc : NCH - 1 - cc;
                    const float lr = xl[(size_t)c * 256], li = xl[(size_t)c * 256 + 64];
                    ue[(size_t)c * KX] = (bf16_t)(cvt_pk_bf16(xr, 0.f) & 0xffffu); ue[(size_t)c * KX + 64] = (bf16_t)(cvt_pk_bf16(xi, 0.f) & 0xffffu);
                    const float nr = al.x * xr - al.y * xi + lr, nim = al.x * xi + al.y * xr + li; xr = nr; xi = nim;
                }
            }
        }
        grid.sync();
        {
            PH_INIT;
            float s1 = wave_sum(P.in[I_LQ1][L * 64 + lane] * P.in[I_LK1][L * 64 + lane]), s2 = wave_sum(P.in[I_LQ2][L * 64 + lane] * P.in[I_LK2][L * 64 + lane]);
            const float lam = expf(s1) - expf(s2) + lambda_init;
            for (int i = 0; i < 4; ++i) { const int u = i * G + vcu; if (u >= 1024) break; const int bh = u >> 4, qb = u & 15;
                att::attn_unit(bh >> 3, bh & 7, qb, QB, KB, VB, QB, SCR + (size_t)bx * 32768, lam, 1.0f - lambda_init, P.in[I_SUBW] + L * 128, (char*)lds_raw); }
            __syncthreads();
        }
        { PH_INIT; MAKE_E; E.mode = 3; RUN_GEMM(UEXT, TMAT, KX, KX, KX, 4, 2, 32, E); }
        grid.sync();
        { PH_INIT; MAKE_E; E.mode = 4; RUN_GEMM(XN, WG, 1024, 1024, 1024, 128, 8, 1, E); }
        grid.sync();
        { PH_INIT; MAKE_E; E.mode = 5; RUN_GEMM(YB, WGLU, 512, 512, 512, 128, 8, 1, E); }
        grid.sync();
        { PH_INIT; MAKE_E; E.mode = 6; RUN_GEMM(QB, WAO, 1024, 1024, 1024, 128, 4, 1, E); }
        grid.sync();
        { PH_INIT; MAKE_E; E.mode = 7; E.gate = MOD + (size_t)L * NB * 6144 + 2048; E.base = (L == 0) ? P.in[I_X] : xo; RUN_GEMM(KB, WOUT, 1024, 1024, 1024, 128, 4, 1, E); }
        grid.sync();
        {
            PH_INIT;
            const float* nw = P.in[I_N2W] + L * DM;
            for (int m = gw; m < T; m += NGW) {
                const int b = m >> 12; const f32x4* xr = (const f32x4*)(xo + (size_t)m * DM) + lane; f32x4 v[4]; float s = 0.f;
#pragma unroll
                for (int j = 0; j < 4; ++j) { v[j] = xr[64 * j]; s += (v[j][0] * v[j][0] + v[j][1] * v[j][1]) + (v[j][2] * v[j][2] + v[j][3] * v[j][3]); }
                const float r = rsqrtf(wave_sum(s) * (1.0f / DM) + 1e-6f);
                const float* md = MOD + ((size_t)L * NB + b) * 6144 + 3072;
#pragma unroll
                for (int j = 0; j < 4; ++j) { const int col = lane * 4 + 256 * j; const f32x4 w4 = *(const f32x4*)(nw + col), sh = *(const f32x4*)(md + col), sc = *(const f32x4*)(md + 1024 + col);
                    const f32x4 hv = v[j] * r * w4 * (sc + 1.0f) + sh; u32x2 w; w.x = cvt_pk_bf16(hv[0], hv[1]); w.y = cvt_pk_bf16(hv[2], hv[3]); *(u32x2*)(XN + (size_t)m * DM + col) = w; }
            }
        }
        grid.sync();
#pragma unroll 1
        for (int hf = 0; hf < 2; ++hf) {
            { PH_INIT; MAKE_E; E.mode = 8; RUN_GEMM(XN + (size_t)hf * 16384 * DM, WUP, 1024, 1024, 1024, 64, 22, 1, E); }
            grid.sync();
            {
                PH_INIT;
                const float* cw = P.in[I_CONVW] + (size_t)L * 3 * NUP; const float* cb = P.in[I_CONVB] + (size_t)L * NUP;
                for (long it = gtid; it < 1024L * 352; it += NGT) {
                    const int rb = (int)(it / 352), jc = (int)(it % 352), j = jc * 8, r0 = rb * 16;
                    float wv[3][8], wg[3][8], bv[8], bg[8];
#pragma unroll
                    for (int k = 0; k < 3; ++k)
#pragma unroll
                        for (int q = 0; q < 8; ++q) { wv[k][q] = cw[k * NUP + j + q]; wg[k][q] = cw[k * NUP + DFF + j + q]; }
#pragma unroll
                    for (int q = 0; q < 8; ++q) { bv[q] = cb[j + q]; bg[q] = cb[DFF + j + q]; }
                    u32x4 pv_, pg_, cv_, cg_, nv_, ng_;
                    const u32x4 z4 = (u32x4){0u, 0u, 0u, 0u};
                    if ((r0 & (SEQ - 1)) != 0) { pv_ = *(const u32x4*)(UPH + (size_t)(r0 - 1) * NUP + j); pg_ = *(const u32x4*)(UPH + (size_t)(r0 - 1) * NUP + DFF + j); } else { pv_ = z4; pg_ = z4; }
                    cv_ = *(const u32x4*)(UPH + (size_t)r0 * NUP + j); cg_ = *(const u32x4*)(UPH + (size_t)r0 * NUP + DFF + j);
#pragma unroll 1
                    for (int r = r0; r < r0 + 16; ++r) {
                        if (((r + 1) & (SEQ - 1)) != 0) { nv_ = *(const u32x4*)(UPH + (size_t)(r + 1) * NUP + j); ng_ = *(const u32x4*)(UPH + (size_t)(r + 1) * NUP + DFF + j); } else { nv_ = z4; ng_ = z4; }
                        float o[8];
#pragma unroll
                        for (int q2 = 0; q2 < 4; ++q2) {
                            const float v0 = wv[0][2 * q2] * bf_lo(pv_[q2]) + wv[1][2 * q2] * bf_lo(cv_[q2]) + wv[2][2 * q2] * bf_lo(nv_[q2]) + bv[2 * q2];
                            const float v1 = wv[0][2 * q2 + 1] * bf_hi(pv_[q2]) + wv[1][2 * q2 + 1] * bf_hi(cv_[q2]) + wv[2][2 * q2 + 1] * bf_hi(nv_[q2]) + bv[2 * q2 + 1];
                            const float g0 = wg[0][2 * q2] * bf_lo(pg_[q2]) + wg[1][2 * q2] * bf_lo(cg_[q2]) + wg[2][2 * q2] * bf_lo(ng_[q2]) + bg[2 * q2];
                            const float g1 = wg[0][2 * q2 + 1] * bf_hi(pg_[q2]) + wg[1][2 * q2 + 1] * bf_hi(cg_[q2]) + wg[2][2 * q2 + 1] * bf_hi(ng_[q2]) + bg[2 * q2 + 1];
                            o[2 * q2] = g0 * sigmoidf_(g0) * v0; o[2 * q2 + 1] = g1 * sigmoidf_(g1) * v1;
                        }
                        u32x4 ov; ov.x = cvt_pk_bf16(o[0], o[1]); ov.y = cvt_pk_bf16(o[2], o[3]); ov.z = cvt_pk_bf16(o[4], o[5]); ov.w = cvt_pk_bf16(o[6], o[7]);
                        *(u32x4*)(ACT + ((size_t)hf * 16384 + r) * DFF + j) = ov;
                        pv_ = cv_; pg_ = cg_; cv_ = nv_; cg_ = ng_;
                    }
                }
            }
            grid.sync();
        }
        { PH_INIT; MAKE_E; E.mode = 7; E.gate = MOD + (size_t)L * NB * 6144 + 5120; E.base = xo; RUN_GEMM(ACT, WDOWN, DFF, DFF, DFF, 128, 4, 1, E); }
        grid.sync();
    }
    {
        const int l = 2;
        PH_INIT;
        const float* nw = P.in[I_FINW];
        for (int m = gw; m < T; m += NGW) {
            f32x4* xr = (f32x4*)(xo + (size_t)m * DM) + lane; f32x4 v[4]; float s = 0.f;
#pragma unroll
            for (int j = 0; j < 4; ++j) { v[j] = xr[64 * j]; s += (v[j][0] * v[j][0] + v[j][1] * v[j][1]) + (v[j][2] * v[j][2] + v[j][3] * v[j][3]); }
            const float r = rsqrtf(wave_sum(s) * (1.0f / DM) + 1e-6f);
#pragma unroll
            for (int j = 0; j < 4; ++j) { const f32x4 w4 = *(const f32x4*)(nw + lane * 4 + 256 * j); xr[64 * j] = v[j] * r * w4; }
        }
    }
}

extern "C" void kernel_launch(void* const* d_in, const int* in_sizes, int n_in, void* d_out, int out_size, void* d_ws, size_t ws_size, hipStream_t stream) {
    static int grid = 0;
    if (grid == 0) {
        if (n_in != 29 || out_size != T * DM || ws_size < WS_END) { fprintf(stderr, "kernel_launch: unexpected shapes n_in %d out %d ws %zu (need %zu)\n", n_in, out_size, ws_size, (size_t)WS_END); grid = -1; return; }
        int dev = 0, cus = 0, per_cu = 0;
        (void)hipGetDevice(&dev); (void)hipDeviceGetAttribute(&cus, hipDeviceAttributeMultiprocessorCount, dev);
        if (hipFuncSetAttribute((const void*)mega, hipFuncAttributeMaxDynamicSharedMemorySize, LDS_BYTES) != hipSuccess) { fprintf(stderr, "kernel_launch: hipFuncSetAttribute failed\n"); grid = -1; return; }
        (void)hipOccupancyMaxActiveBlocksPerMultiprocessor(&per_cu, (const void*)mega, NTHR, LDS_BYTES);
        if (per_cu < 1) { fprintf(stderr, "kernel_launch: occupancy query says %d blocks per CU\n", per_cu); per_cu = 1; }
        (void)hipGetLastError();
        grid = cus;
    }
    if (grid < 0) return;
    Params p{};
    for (int i = 0; i < 29; ++i) p.in[i] = (const float*)d_in[i];
    p.out = (float*)d_out; p.ws = (unsigned char*)d_ws;
    void* args[] = {&p};
    hipError_t e = hipLaunchCooperativeKernel((const void*)mega, dim3(grid), dim3(NTHR), args, LDS_BYTES, stream);
    if (e != hipSuccess) fprintf(stderr, "cooperative launch failed: %s (grid %d)\n", hipGetErrorString(e), grid);
}
```

```cpp
#include <hip/hip_runtime.h>
#include <hip/hip_cooperative_groups.h>
#include <cstdio>
#include <cstdint>
namespace cg = cooperative_groups;

#define LAS __attribute__((address_space(3)))
typedef unsigned short bf16_t;
typedef short bf16x8 __attribute__((ext_vector_type(8)));
typedef short s16x4 __attribute__((ext_vector_type(4)));
typedef float f32x2 __attribute__((ext_vector_type(2)));
typedef float f32x4 __attribute__((ext_vector_type(4)));
typedef float f32x16 __attribute__((ext_vector_type(16)));
typedef unsigned u32x2 __attribute__((ext_vector_type(2)));
typedef unsigned u32x4 __attribute__((ext_vector_type(4)));

constexpr int NB = 8, SEQ = 4096, DM = 1024, T = NB * SEQ, DFF = 2816, NUP = 2 * DFF, NWAVES = 8, NTHR = 512;
constexpr int CH = 32, NCH = SEQ / CH, KX = 768;
constexpr size_t MiB = 1u << 20;
constexpr size_t WS_MOD = 1 * MiB, WS_ROPE = 2 * MiB, WS_PW = 3 * MiB, WS_BB = 5 * MiB, WS_KM = 6 * MiB;
constexpr size_t WS_WQKVU = 8 * MiB, WS_WG = 15 * MiB, WS_WAO = 19 * MiB, WS_WGLU = 21 * MiB, WS_WOUT = 23 * MiB, WS_WUP = 25 * MiB, WS_WDOWN = 36 * MiB;
constexpr size_t WS_TMAT = 42 * MiB, WS_EMAT = 66 * MiB, WS_XN = 74 * MiB;
constexpr size_t WS_Q = 138 * MiB, WS_K = 202 * MiB, WS_V = 266 * MiB, WS_UEXT = 330 * MiB, WS_XLOC = 378 * MiB, WS_SCR = 410 * MiB;
constexpr size_t WS_UP = 138 * MiB, WS_ACT = 314 * MiB, WS_END = 490 * MiB;
constexpr int LDS_BYTES = 147456;

struct Params {
    const float* in[29];
    float* out;
    unsigned char* ws;
};
enum { I_X = 0, I_C, I_N1W, I_N2W, I_ADAW, I_ADAB, I_WIN, I_LQ1, I_LK1, I_LQ2, I_LK2, I_SUBW, I_WAO, I_SLRE, I_SLIM, I_SLDT, I_SBRE, I_SBIM, I_SCRE, I_SCIM, I_SD,
       I_WGA, I_WGB, I_WOUT, I_WUP, I_CONVW, I_CONVB, I_WDOWN, I_FINW };

__device__ __forceinline__ unsigned cvt_pk_bf16(float lo, float hi) { unsigned r; asm volatile("v_cvt_pk_bf16_f32 %0, %1, %2" : "=v"(r) : "v"(lo), "v"(hi)); return r; }
__device__ __forceinline__ float bf_lo(unsigned w) { return __uint_as_float(w << 16); }
__device__ __forceinline__ float bf_hi(unsigned w) { return __uint_as_float(w & 0xffff0000u); }
__device__ __forceinline__ float sigmoidf_(float x) { return 1.0f / (1.0f + __expf(-x)); }
__device__ __forceinline__ float gelu_tanh(float x) { const float z = 0.7978845608028654f * (x + 0.044715f * x * x * x); return x / (1.0f + __expf(-2.0f * z)); }
__device__ __forceinline__ float wave_sum(float v) {
#pragma unroll
    for (int o = 1; o < 64; o <<= 1) v += __shfl_xor(v, o);
    return v;
}

namespace pg8 {
constexpr int BM = 256, BK = 64, HALF = 128, HTB = HALF * BK * 2, NXCD = 8, WGM = 8;
__host__ __device__ __forceinline__ int lds_byte(int r, int c) { const int st = (r >> 4) * 2 + (c >> 5), rr = r & 15, cc = c & 31, ob = rr * 64 + cc * 2; return st * 1024 + (ob ^ (((ob >> 9) & 1) << 5)); }
__host__ __device__ __forceinline__ void stage_rc(int b, int& R, int& C) { const int st = b / 1024, sb = b % 1024, swz = sb ^ (((sb >> 9) & 1) << 5); R = (st >> 1) * 16 + swz / 64; C = (st & 1) * 32 + (swz % 64) / 2; }

struct Unit { int pm, pn, grp; };
struct Gemm { const bf16_t* A; const bf16_t* Bt; int lda, ldb, K, nM, nN, ngrp; };
struct Order {
    int nM, nN, ngrp, nwg, G, c;
    __device__ void init(const Gemm& g, int G_, int c_) { nM = g.nM; nN = g.nN; ngrp = g.ngrp; nwg = nM * nN * ngrp; G = G_; c = c_; }
    __device__ bool next(int i, Unit& u) const {
        const long L = (long)i * G + c; if (L >= nwg) return false;
        if (ngrp == 1) {
            int wgid = (int)L; { const int q = nwg / NXCD, r = nwg % NXCD, xcd = wgid % NXCD, off = wgid / NXCD; wgid = (xcd < r ? xcd * (q + 1) : r * (q + 1) + (xcd - r) * q) + off; }
            const int nig = WGM * nN, gid = wgid / nig, fm = gid * WGM, gsz = (nM - fm) < WGM ? (nM - fm) : WGM;
            u.pm = fm + ((wgid % nig) % gsz); u.pn = (wgid % nig) / gsz; u.grp = 0;
        } else {
            const int per = nM * nN; const int w = (int)(L % per); u.grp = (int)(L / per); u.pm = w % nM; u.pn = w / nM;
        }
        return true;
    }
};

struct Epi {
    int mode, layer;
    bf16_t *Q, *Kb, *Vb, *Uext, *Y, *UPh;
    float* xloc; const float* rope; const float* gate; const float* base; float* xout;
    __device__ __forceinline__ void operator()(const f32x4 (&acc)[2][2][4][2], const Unit& u, int wr, int wc, int fr, int fq) const {
        const int colt = u.pn * BM;
#pragma unroll
        for (int ai = 0; ai < 2; ++ai)
#pragma unroll
            for (int m = 0; m < 4; ++m) {
                const int rl = ai * HALF + wr * 64 + m * 16 + fr;
                const int row = u.pm * BM + rl;
#pragma unroll
                for (int bj = 0; bj < 2; ++bj)
#pragma unroll
                    for (int n = 0; n < 2; ++n) {
                        const int cl = bj * HALF + wc * 32 + n * 16 + fq * 4;
                        const f32x4 v = acc[ai][bj][m][n];
                        if (mode == 1) {
                            if (colt < 2048) {
                                bf16_t* dst = colt < 1024 ? Q : Kb; const int cc = (colt & 1023) + cl; const int s = row & (SEQ - 1); const int i = (cc & 63) >> 1;
                                const f32x4 cs = *(const f32x4*)(rope + ((size_t)s * 32 + i) * 2);
                                const float o0 = v[0] * cs[0] - v[1] * cs[1], o1 = v[1] * cs[0] + v[0] * cs[1], o2 = v[2] * cs[2] - v[3] * cs[3], o3 = v[3] * cs[2] + v[2] * cs[3];
                                u32x2 w; w.x = cvt_pk_bf16(o0, o1); w.y = cvt_pk_bf16(o2, o3); *(u32x2*)(dst + (size_t)row * DM + cc) = w;
                            } else if (colt < 3072) {
                                u32x2 w; w.x = cvt_pk_bf16(v[0], v[1]); w.y = cvt_pk_bf16(v[2], v[3]); *(u32x2*)(Vb + (size_t)row * DM + (colt - 2048) + cl) = w;
                            } else {
                                const int uc = colt - 3072 + cl, g = uc >> 4, ni = uc & 15; const int b = row >> 12, s = row & (SEQ - 1), ch = s >> 5, sl = s & 31;
                                u32x2 w; w.x = cvt_pk_bf16(v[0], v[1]); w.y = cvt_pk_bf16(v[2], v[3]);
                                *(u32x2*)(Uext + ((size_t)(g * (NB * NCH) + b * NCH + ch)) * KX + sl * 16 + ni) = w;
                            }
                        } else if (mode == 2) {
                            *(f32x4*)(xloc + ((size_t)(u.grp * (NB * NCH) + row)) * 256 + cl) = v;
                        } else if (mode == 3) {
                            const int b = row >> 7, ch = row & 127; const int nn = colt + cl, t = nn >> 4, no = nn & 15; const size_t tok = (size_t)b * SEQ + ch * CH + t;
                            u32x2 w; w.x = cvt_pk_bf16(gelu_tanh(v[0]), gelu_tanh(v[1])); w.y = cvt_pk_bf16(gelu_tanh(v[2]), gelu_tanh(v[3]));
                            *(u32x2*)(Y + tok * 512 + u.grp * 16 + no) = w;
                        } else if (mode == 4) {
                            bf16_t* dst = colt < 1024 ? Kb : Vb; const int cc = (colt & 1023) + cl;
                            u32x2 w; w.x = cvt_pk_bf16(sigmoidf_(v[0]), sigmoidf_(v[1])); w.y = cvt_pk_bf16(sigmoidf_(v[2]), sigmoidf_(v[3])); *(u32x2*)(dst + (size_t)row * DM + cc) = w;
                        } else if (mode == 5) {
                            if (n == 0) {
                                const f32x4 bv = acc[ai][bj][m][1]; const int cc = u.pn * 128 + bj * 64 + wc * 16 + fq * 4; bf16_t* p = Vb + (size_t)row * DM + cc;
                                const u32x2 sg = *(const u32x2*)p;
                                u32x2 w; w.x = cvt_pk_bf16(v[0] * sigmoidf_(bv[0]) * bf_lo(sg.x), v[1] * sigmoidf_(bv[1]) * bf_hi(sg.x));
                                w.y = cvt_pk_bf16(v[2] * sigmoidf_(bv[2]) * bf_lo(sg.y), v[3] * sigmoidf_(bv[3]) * bf_hi(sg.y)); *(u32x2*)p = w;
                            }
                        } else if (mode == 6) {
                            const int cc = colt + cl; bf16_t* p = Kb + (size_t)row * DM + cc; const u32x2 sg = *(const u32x2*)p; const u32x2 os = *(const u32x2*)(Vb + (size_t)row * DM + cc);
                            u32x2 w; w.x = cvt_pk_bf16(bf_lo(sg.x) * v[0] + bf_lo(os.x), bf_hi(sg.x) * v[1] + bf_hi(os.x)); w.y = cvt_pk_bf16(bf_lo(sg.y) * v[2] + bf_lo(os.y), bf_hi(sg.y) * v[3] + bf_hi(os.y));
                            *(u32x2*)p = w;
                        } else if (mode == 7) {
                            const int cc = colt + cl; const int b = row >> 12; const f32x4 gt = *(const f32x4*)(gate + (size_t)b * 6144 + cc); const size_t off = (size_t)row * DM + cc;
                            const f32x4 bs = *(const f32x4*)(base + off); *(f32x4*)(xout + off) = bs + gt * v;
                        } else {
                            u32x2 w; w.x = cvt_pk_bf16(v[0], v[1]); w.y = cvt_pk_bf16(v[2], v[3]); *(u32x2*)(UPh + (size_t)row * NUP + colt + cl) = w;
                        }
                    }
            }
    }
};

__device__ __forceinline__ void gemm_phase(LAS unsigned char* lds, const Gemm g, const Order& S, const Epi& E) {
    int tid = threadIdx.x; asm volatile("" : "+v"(tid));
    const int wid = __builtin_amdgcn_readfirstlane(tid >> 6), lane = tid & 63, wr = wid >> 2, wc = wid & 3, fr = lane & 15, fq = lane >> 4;
    const int K = g.K, nt = K / BK;
    unsigned voffA[2], voffB[2];
#pragma unroll
    for (int i = 0; i < 2; ++i) { int R, C; stage_rc(tid * 16 + i * 8192, R, C); voffA[i] = (unsigned)(R * g.lda + C) * 2u; voffB[i] = (unsigned)(R * g.ldb + C) * 2u; }
    const size_t kstep = (size_t)(BK * 2);
    const size_t hstepA = (size_t)HALF * g.lda * 2, hstepB = (size_t)HALF * g.ldb * 2;
    const size_t tstepA = 2 * hstepA, tstepB = 2 * hstepB;
    const unsigned ldsw = (unsigned)wid * 1024u;
    const int aoff = lds_byte(wr * 64 + fr, fq * 8), boff = lds_byte(wc * 32 + fr, fq * 8);
#define PG8_SA(b, h) (((b) * 2 + (h)) * HTB)
#define PG8_SB(b, h) ((4 + (b) * 2 + (h)) * HTB)
#define PG8_STAGE(bufoff, gbase, voff) do { _Pragma("unroll") for (int _i = 0; _i < 2; ++_i) \
        __builtin_amdgcn_global_load_lds((const unsigned*)((const char*)(gbase) + (voff)[_i]), (LAS unsigned*)(lds + (bufoff) + ldsw + _i * 8192), 16, 0, 0); } while (0)
#define PG8_LDA(dst, b, h) do { _Pragma("unroll") for (int m = 0; m < 4; ++m) _Pragma("unroll") for (int k = 0; k < 2; ++k) dst[m][k] = *(const LAS bf16x8*)(lds + PG8_SA(b, h) + aoff + m * 2048 + k * 1024); } while (0)
#define PG8_LDB(dst, b, h) do { _Pragma("unroll") for (int n = 0; n < 2; ++n) _Pragma("unroll") for (int k = 0; k < 2; ++k) dst[n][k] = *(const LAS bf16x8*)(lds + PG8_SB(b, h) + boff + n * 2048 + k * 1024); } while (0)
#define PG8_MMA(ai, bj, At, Bt) do { __builtin_amdgcn_s_setprio(1); _Pragma("unroll") for (int m = 0; m < 4; ++m) _Pragma("unroll") for (int n = 0; n < 2; ++n) _Pragma("unroll") for (int k = 0; k < 2; ++k) \
        acc[ai][bj][m][n] = __builtin_amdgcn_mfma_f32_16x16x32_bf16(Bt[n][k], At[m][k], acc[ai][bj][m][n], 0, 0, 0); __builtin_amdgcn_s_setprio(0); } while (0)
#define PG8_WAIT_V(n) asm volatile("s_waitcnt vmcnt(" #n ")" ::: "memory")
#define PG8_WAIT_L(n) asm volatile("s_waitcnt lgkmcnt(" #n ")" ::: "memory")
#define PG8_BAR __builtin_amdgcn_s_barrier()
#define PG8_SCHED __builtin_amdgcn_sched_barrier(0)
    Unit cur, nxt; int ui = 0;
    if (!S.next(0, cur)) return;
    f32x4 acc[2][2][4][2];
#pragma unroll
    for (int a = 0; a < 2; ++a)
#pragma unroll
        for (int b = 0; b < 2; ++b)
#pragma unroll
            for (int m = 0; m < 4; ++m)
#pragma unroll
                for (int n = 0; n < 2; ++n) acc[a][b][m][n] = (f32x4){0.f, 0.f, 0.f, 0.f};
    bf16x8 At[4][2], B0[2][2], B1[2][2];
    const char* cA = (const char*)g.A + (size_t)(cur.grp * g.nM + cur.pm) * tstepA; const char* cB = (const char*)g.Bt + (size_t)(cur.grp * g.nN + cur.pn) * tstepB;
    PG8_STAGE(PG8_SB(0, 0), cB, voffB); PG8_STAGE(PG8_SB(0, 1), cB + hstepB, voffB); PG8_STAGE(PG8_SA(0, 0), cA, voffA); PG8_STAGE(PG8_SA(0, 1), cA + hstepA, voffA);
    if (wr == 1) PG8_BAR;
    PG8_WAIT_V(2); PG8_BAR;
    PG8_STAGE(PG8_SB(1, 0), cB + kstep, voffB); PG8_STAGE(PG8_SA(1, 0), cA + kstep, voffA); PG8_STAGE(PG8_SB(1, 1), cB + hstepB + kstep, voffB);
    PG8_WAIT_V(6); PG8_BAR;
    for (;;) {
        const bool has_next = S.next(ui + 1, nxt);
        const char* nA = has_next ? (const char*)g.A + (size_t)(nxt.grp * g.nM + nxt.pm) * tstepA : cA; const char* nB = has_next ? (const char*)g.Bt + (size_t)(nxt.grp * g.nN + nxt.pn) * tstepB : cB;
        for (int t = 0; t < nt; t += 2) {
            const bool last = (t == nt - 2);
            const char* a1 = cA + (size_t)(t + 1) * kstep;
            const char* a2 = last ? nA : cA + (size_t)(t + 2) * kstep; const char* b2 = last ? nB : cB + (size_t)(t + 2) * kstep;
            const char* a3 = a2 + kstep; const char* b3 = b2 + kstep;
            PG8_LDB(B0, 0, 0); PG8_LDB(B1, 0, 1); PG8_SCHED; PG8_LDA(At, 0, 0); PG8_STAGE(PG8_SA(1, 1), a1 + hstepA, voffA);
            PG8_WAIT_V(8); PG8_WAIT_L(0); PG8_BAR; PG8_MMA(0, 0, At, B0); PG8_MMA(0, 1, At, B1); PG8_BAR; PG8_SCHED;
            PG8_LDA(At, 0, 1); PG8_STAGE(PG8_SB(0, 0), b2, voffB); PG8_STAGE(PG8_SB(0, 1), b2 + hstepB, voffB); PG8_STAGE(PG8_SA(0, 0), a2, voffA);
            PG8_WAIT_V(8); PG8_WAIT_L(0); PG8_BAR; PG8_MMA(1, 0, At, B0); PG8_MMA(1, 1, At, B1); PG8_BAR; PG8_SCHED;
            PG8_LDB(B0, 1, 0); PG8_LDB(B1, 1, 1); PG8_SCHED; PG8_LDA(At, 1, 0); PG8_STAGE(PG8_SA(0, 1), a2 + hstepA, voffA);
            PG8_WAIT_V(8); PG8_WAIT_L(0); PG8_BAR; PG8_MMA(0, 0, At, B0); PG8_MMA(0, 1, At, B1); PG8_BAR; PG8_SCHED;
            PG8_LDA(At, 1, 1); PG8_STAGE(PG8_SB(1, 0), b3, voffB); PG8_STAGE(PG8_SB(1, 1), b3 + hstepB, voffB); PG8_STAGE(PG8_SA(1, 0), a3, voffA);
            PG8_WAIT_V(8); PG8_WAIT_L(0); PG8_BAR; PG8_MMA(1, 0, At, B0); PG8_MMA(1, 1, At, B1); PG8_BAR; PG8_SCHED;
        }
        if (wr == 0) PG8_BAR;
        E(acc, cur, wr, wc, fr, fq);
        if (!has_next) break;
#pragma unroll
        for (int a = 0; a < 2; ++a)
#pragma unroll
            for (int b = 0; b < 2; ++b)
#pragma unroll
                for (int m = 0; m < 4; ++m)
#pragma unroll
                    for (int n = 0; n < 2; ++n) acc[a][b][m][n] = (f32x4){0.f, 0.f, 0.f, 0.f};
        cur = nxt; cA = nA; cB = nB; ++ui;
        if (wr == 1) PG8_BAR;
    }
    PG8_WAIT_V(0);
    PG8_BAR;
#undef PG8_SA
#undef PG8_SB
#undef PG8_STAGE
#undef PG8_LDA
#undef PG8_LDB
#undef PG8_MMA
#undef PG8_WAIT_V
#undef PG8_WAIT_L
#undef PG8_BAR
#undef PG8_SCHED
}
}

namespace att {
constexpr int D = 128, NW = 8, QBLK = 32, KVBLK = 64, LD = DM;
constexpr float SCALE = 0.125f, THR = 8.f;
constexpr size_t SHM_V = KVBLK * D * 2, SHM_K = KVBLK * 64 * 2;
#define KSWZ(row, colB) ((row) * 128 + ((colB) ^ ((((row) >> 1) & 7) << 4)))
#define SBAR() __builtin_amdgcn_sched_barrier(0)
__device__ __forceinline__ int crow(int r, int hi) { return (r & 3) + 8 * (r >> 2) + 4 * hi; }
__device__ __forceinline__ void partialSM(f32x16& p0, f32x16& p1, float& m_reg, float& mn, float& alpha) {
    constexpr float C = SCALE * 1.4426950408889634f;
    float pmax = p0[0];
#pragma unroll
    for (int r = 1; r < 16; ++r) pmax = fmaxf(pmax, p0[r]);
#pragma unroll
    for (int r = 0; r < 16; ++r) pmax = fmaxf(pmax, p1[r]);
    { auto rr = __builtin_amdgcn_permlane32_swap(__float_as_uint(pmax), __float_as_uint(pmax), false, false);
      pmax = fmaxf(__uint_as_float(rr[0]), __uint_as_float(rr[1])); }
    if (__builtin_expect(__all(pmax - m_reg <= THR / SCALE), 1)) { mn = m_reg; alpha = 1.f; }
    else { mn = fmaxf(m_reg, pmax); alpha = __builtin_amdgcn_exp2f((m_reg - mn) * C); m_reg = mn; }
    const float mnC = -mn * C;
#pragma unroll
    for (int r = 0; r < 16; ++r) p0[r] = fmaf(p0[r], C, mnC);
#pragma unroll
    for (int r = 0; r < 16; ++r) p1[r] = fmaf(p1[r], C, mnC);
#pragma unroll
    for (int r = 0; r < 16; ++r) p0[r] = __builtin_amdgcn_exp2f(p0[r]);
}
__device__ __forceinline__ void finishSM(f32x16& p0, f32x16& p1, float alpha, float& l_reg, bf16x8& pa0, bf16x8& pa1, bf16x8& pa2, bf16x8& pa3) {
#pragma unroll
    for (int r = 0; r < 16; ++r) p1[r] = __builtin_amdgcn_exp2f(p1[r]);
    float ps = 0;
#pragma unroll
    for (int r = 0; r < 16; ++r) ps += p0[r];
#pragma unroll
    for (int r = 0; r < 16; ++r) ps += p1[r];
    { auto rr = __builtin_amdgcn_permlane32_swap(__float_as_uint(ps), __float_as_uint(ps), false, false);
      ps = __uint_as_float(rr[0]) + __uint_as_float(rr[1]); }
    l_reg = l_reg * alpha + ps;
#define PK4(P, BASE, OUT) do { unsigned a0 = cvt_pk_bf16(P[BASE + 0], P[BASE + 1]), a1 = cvt_pk_bf16(P[BASE + 2], P[BASE + 3]);   \
    unsigned b0 = cvt_pk_bf16(P[BASE + 4], P[BASE + 5]), b1 = cvt_pk_bf16(P[BASE + 6], P[BASE + 7]);                              \
    auto r0 = __builtin_amdgcn_permlane32_swap(a0, b0, false, false); auto r1 = __builtin_amdgcn_permlane32_swap(a1, b1, false, false); \
    u32x4 w = {r0[0], r1[0], r0[1], r1[1]}; OUT = *reinterpret_cast<bf16x8*>(&w); } while (0)
    PK4(p0, 0, pa0); PK4(p0, 8, pa1); PK4(p1, 0, pa2); PK4(p1, 8, pa3);
#undef PK4
}
__device__ __forceinline__ void qkt(f32x16& p0, f32x16& p1, const char* Ks, const bf16x8* qr, int r32, int hi) {
    p0 = f32x16{}; p1 = f32x16{};
#pragma unroll
    for (int d0 = 0; d0 < 4; ++d0) { const int cb = (d0 * 16 + hi * 8) * 2;
        const bf16x8 b0 = *reinterpret_cast<const bf16x8*>(Ks + KSWZ(r32, cb));
        const bf16x8 b1 = *reinterpret_cast<const bf16x8*>(Ks + KSWZ(32 + r32, cb));
        p0 = __builtin_amdgcn_mfma_f32_32x32x16_bf16(b0, qr[d0], p0, 0, 0, 0);
        p1 = __builtin_amdgcn_mfma_f32_32x32x16_bf16(b1, qr[d0], p1, 0, 0, 0); }
}
__device__ __forceinline__ int v_st(int k, int c) { const int kk = (k & ~0xC) | ((k & 4) << 1) | ((k & 8) >> 1); return ((kk >> 3) * 4 + (c >> 5)) * 512 + ((kk & 7) * 32 + (c & 31)) * 2; }
__device__ __forceinline__ int v_rd_base(int lane) { return ((lane & 3) << 3) | (((lane >> 2) & 3) << 6) | (((lane >> 4) & 1) << 5) | (((lane >> 5) & 1) << 8); }
constexpr int v_rd_off(int d0, int ks, int half) { return d0 * 512 + ks * 4096 + half * 2048; }
template <int OFF> __device__ __forceinline__ s16x4 tr_read(int vb) {
    s16x4 r; asm volatile("ds_read_b64_tr_b16 %0, %1 offset:%2" : "=&v"(r) : "v"(vb), "i"(OFF) : "memory"); return r;
}
template <int D0> __device__ __forceinline__ void pv_one(f32x16& od, int vb, bf16x8 pa0, bf16x8 pa1, bf16x8 pa2, bf16x8 pa3) {
    const s16x4 l0 = tr_read<v_rd_off(D0, 0, 0)>(vb), h0 = tr_read<v_rd_off(D0, 0, 1)>(vb), l1 = tr_read<v_rd_off(D0, 1, 0)>(vb), h1 = tr_read<v_rd_off(D0, 1, 1)>(vb);
    const s16x4 l2 = tr_read<v_rd_off(D0, 2, 0)>(vb), h2 = tr_read<v_rd_off(D0, 2, 1)>(vb), l3 = tr_read<v_rd_off(D0, 3, 0)>(vb), h3 = tr_read<v_rd_off(D0, 3, 1)>(vb);
    asm volatile("s_waitcnt lgkmcnt(0)" ::: "memory"); SBAR();
#define PK(L, H) (bf16x8){L[0], L[1], L[2], L[3], H[0], H[1], H[2], H[3]}
    od = __builtin_amdgcn_mfma_f32_32x32x16_bf16(pa0, PK(l0, h0), od, 0, 0, 0);
    od = __builtin_amdgcn_mfma_f32_32x32x16_bf16(pa1, PK(l1, h1), od, 0, 0, 0);
    od = __builtin_amdgcn_mfma_f32_32x32x16_bf16(pa2, PK(l2, h2), od, 0, 0, 0);
    od = __builtin_amdgcn_mfma_f32_32x32x16_bf16(pa3, PK(l3, h3), od, 0, 0, 0);
#undef PK
}
__device__ __forceinline__ void pv_d0(f32x16* o, int vb, bf16x8 pa0, bf16x8 pa1, bf16x8 pa2, bf16x8 pa3) {
    pv_one<0>(o[0], vb, pa0, pa1, pa2, pa3); pv_one<1>(o[1], vb, pa0, pa1, pa2, pa3); pv_one<2>(o[2], vb, pa0, pa1, pa2, pa3); pv_one<3>(o[3], vb, pa0, pa1, pa2, pa3);
}

__device__ __forceinline__ void attn_pass(const bf16_t* __restrict__ Qb, const bf16_t* __restrict__ Kh, const bf16_t* __restrict__ Vh, f32x16 (&o)[4], float (&rli)[16], char* lds) {
    int tid = threadIdx.x; asm volatile("" : "+v"(tid));
    const int wid = tid >> 6, lane = tid & 63, r32 = lane & 31, hi = lane >> 5;
    char* V_lds = lds; char* K_lds = lds + 2 * SHM_V;
    float* ws = (float*)(lds + 2 * SHM_V + 2 * SHM_K) + wid * 64; float* li_l = ws; float* al_l = ws + 32;
    float m_reg = -1e30f, l_reg = 0; bf16x8 qr[4];
#pragma unroll
    for (int d = 0; d < 4; ++d) o[d] = f32x16{};
    const bf16_t* Qw = Qb + (long)(wid * QBLK + r32) * LD + hi * 8;
#pragma unroll
    for (int d0 = 0; d0 < 4; ++d0) qr[d0] = *reinterpret_cast<const bf16x8*>(Qw + d0 * 16);
    const int sr = tid >> 4, sc = (tid & 15) * 8, vst0 = v_st(sr, sc), vst1 = v_st(32 + sr, sc);
    const int kr = tid >> 3, kc = (tid & 7) * 8, kst = KSWZ(kr, kc * 2);
    const int vb0 = (int)(uintptr_t)V_lds + v_rd_base(lane);
    struct { bf16x8 vs0, vs1, ks0; } sr_[2];
#define SLOAD(i, k0) do { sr_[i].vs0 = *reinterpret_cast<const bf16x8*>(&Vh[(long)((k0) + sr) * LD + sc]); sr_[i].vs1 = *reinterpret_cast<const bf16x8*>(&Vh[(long)((k0) + 32 + sr) * LD + sc]); \
    sr_[i].ks0 = *reinterpret_cast<const bf16x8*>(&Kh[(long)((k0) + kr) * LD + kc]); } while (0)
#define SWRITE(b, i) do { *(bf16x8*)(V_lds + (b) * SHM_V + vst0) = sr_[i].vs0; *(bf16x8*)(V_lds + (b) * SHM_V + vst1) = sr_[i].vs1; *(bf16x8*)(K_lds + (b) * SHM_K + kst) = sr_[i].ks0; } while (0)
#define SWAIT() asm volatile("s_waitcnt vmcnt(3)" ::: "memory")
#define RESC(a) do { if (__any((a) < 1.f)) { if (hi == 0) al_l[r32] = (a); asm volatile("s_waitcnt lgkmcnt(0)" ::: "memory"); \
    _Pragma("unroll") for (int d = 0; d < 4; ++d) _Pragma("unroll") for (int r = 0; r < 16; ++r) o[d][r] *= al_l[crow(r, hi)]; } } while (0)
    f32x16 pA0, pA1, pB0, pB1; float mnA, mnB, alA, alB; bf16x8 pa0, pa1, pa2, pa3; const int NT = SEQ / KVBLK;
    constexpr int SE = 0, SO = 1;
    SLOAD(SE, 0); asm volatile("s_waitcnt vmcnt(0)" ::: "memory"); SWRITE(0, SE); __syncthreads();
    qkt(pA0, pA1, K_lds, qr, r32, hi); partialSM(pA0, pA1, m_reg, mnA, alA);
    SLOAD(SO, KVBLK); SLOAD(SE, 2 * KVBLK);
    SWAIT(); SWRITE(1, SO); __syncthreads();
    for (int j = 1; j + 1 < NT; j += 2) {
        SBAR(); qkt(pB0, pB1, K_lds + SHM_K, qr, r32, hi);
        finishSM(pA0, pA1, alA, l_reg, pa0, pa1, pa2, pa3); SBAR();
        SLOAD(SO, (j + 2) * KVBLK); SBAR();
        pv_d0(o, vb0, pa0, pa1, pa2, pa3); partialSM(pB0, pB1, m_reg, mnB, alB);
        __syncthreads(); SWAIT(); SWRITE(0, SE);
        RESC(alB); __syncthreads();
        SBAR(); qkt(pA0, pA1, K_lds, qr, r32, hi);
        finishSM(pB0, pB1, alB, l_reg, pa0, pa1, pa2, pa3); SBAR();
        if (j + 3 < NT) SLOAD(SE, (j + 3) * KVBLK); SBAR();
        pv_d0(o, vb0 + (int)SHM_V, pa0, pa1, pa2, pa3); partialSM(pA0, pA1, m_reg, mnA, alA);
        __syncthreads(); SWAIT(); SWRITE(1, SO);
        RESC(alA); __syncthreads();
    }
    SBAR(); qkt(pB0, pB1, K_lds + SHM_K, qr, r32, hi);
    finishSM(pA0, pA1, alA, l_reg, pa0, pa1, pa2, pa3); SBAR();
    pv_d0(o, vb0, pa0, pa1, pa2, pa3); partialSM(pB0, pB1, m_reg, mnB, alB);
    __syncthreads(); RESC(alB);
    finishSM(pB0, pB1, alB, l_reg, pa0, pa1, pa2, pa3); SBAR();
    pv_d0(o, vb0 + (int)SHM_V, pa0, pa1, pa2, pa3);
    if (hi == 0) li_l[r32] = l_reg; asm volatile("s_waitcnt lgkmcnt(0)" ::: "memory");
#pragma unroll
    for (int r = 0; r < 16; ++r) rli[r] = __builtin_amdgcn_rcpf(li_l[crow(r, hi)]);
    __syncthreads();
#undef SLOAD
#undef SWRITE
#undef SWAIT
#undef RESC
}

__device__ __forceinline__ void attn_unit(int b, int h, int qb, const bf16_t* Q, const bf16_t* K, const bf16_t* V, bf16_t* O, float* scr, float lam, float onem, const float* subw, char* lds) {
    int tid = threadIdx.x; asm volatile("" : "+v"(tid));
    const int wid = tid >> 6, lane = tid & 63, r32 = lane & 31, hi = lane >> 5;
    const size_t rowbase = (size_t)b * SEQ;
    f32x16 o[4]; float rli[16];
#pragma unroll 1
    for (int pass = 0; pass < 2; ++pass) {
        const int sub = 2 * h + pass;
        attn_pass(Q + (rowbase + (size_t)qb * 256) * LD + sub * 64, K + rowbase * LD + sub * 64, V + rowbase * LD + h * 128, o, rli, lds);
        int t2 = tid; asm volatile("" : "+v"(t2));
        const int lane2 = t2 & 63, r32b = lane2 & 31, hib = lane2 >> 5, wid2 = t2 >> 6;
        float* sp = scr + (size_t)t2 * 64;
        if (pass == 0) {
#pragma unroll
            for (int d0 = 0; d0 < 4; ++d0)
#pragma unroll
                for (int r4 = 0; r4 < 4; ++r4) *(f32x4*)(sp + d0 * 16 + r4 * 4) = (f32x4){o[d0][4 * r4] * rli[4 * r4], o[d0][4 * r4 + 1] * rli[4 * r4 + 1], o[d0][4 * r4 + 2] * rli[4 * r4 + 2], o[d0][4 * r4 + 3] * rli[4 * r4 + 3]};
        } else {
            float ss[16];
#pragma unroll
            for (int r = 0; r < 16; ++r) ss[r] = 0.f;
#pragma unroll
            for (int d0 = 0; d0 < 4; ++d0)
#pragma unroll
                for (int r4 = 0; r4 < 4; ++r4) { const f32x4 o1 = *(const f32x4*)(sp + d0 * 16 + r4 * 4);
#pragma unroll
                    for (int q = 0; q < 4; ++q) { const int r = 4 * r4 + q; const float v = o1[q] - lam * (o[d0][r] * rli[r]); o[d0][r] = v; ss[r] += v * v; } }
#pragma unroll
            for (int r = 0; r < 16; ++r) {
#pragma unroll
                for (int x = 1; x < 32; x <<= 1) ss[r] += __shfl_xor(ss[r], x);
                ss[r] = rsqrtf(ss[r] * (1.0f / 128.0f) + 1e-5f) * onem; }
            bf16_t* Ow = O + (rowbase + (size_t)qb * 256 + wid2 * QBLK + 4 * hib) * LD + h * 128 + r32b;
#pragma unroll
            for (int d0 = 0; d0 < 4; ++d0) { const float sw = subw[d0 * 32 + r32b];
#pragma unroll
                for (int r = 0; r < 16; ++r) { const unsigned w = cvt_pk_bf16(o[d0][r] * ss[r] * sw, 0.f); Ow[(size_t)((r & 3) + 8 * (r >> 2)) * LD + d0 * 32] = (bf16_t)(w & 0xffffu); } }
        }
    }
}
#undef SBAR
}

__device__ __forceinline__ void transpose_item(const float* W, const float* W2, int K, int ldw, int coff, int sel, int ndst, bf16_t* WT, LAS float* scr, int item, int lane) {
    const int nblk = ndst / 32, kb = item / nblk, nb = item % nblk, k0 = 64 * kb, n0 = 32 * nb;
    const int nd = n0 + (lane & 31); int sc = nd + coff; const float* Wp = W;
    if (sel == 1 && nd < 2048) { const int j = nd & 63; sc = (nd & ~63) + (j & 1) * 32 + (j >> 1); }
    if (sel == 2) { sc = (nd >> 5) * 16 + (nd & 15); if ((nd >> 4) & 1) Wp = W2; }
#pragma unroll 8
    for (int i = 0; i < 32; ++i) { const int kk = 2 * i + (lane >> 5); scr[kk * 33 + (lane & 31)] = Wp[(size_t)(k0 + kk) * ldw + sc]; }
    asm volatile("s_waitcnt lgkmcnt(0)" ::: "memory");
    const int c = lane & 7;
#pragma unroll
    for (int j = 0; j < 4; ++j) { const int n = (lane >> 3) + 8 * j; const LAS float* s = scr + (8 * c) * 33 + n;
        u32x4 o; o.x = cvt_pk_bf16(s[0 * 33], s[1 * 33]); o.y = cvt_pk_bf16(s[2 * 33], s[3 * 33]); o.z = cvt_pk_bf16(s[4 * 33], s[5 * 33]); o.w = cvt_pk_bf16(s[6 * 33], s[7 * 33]);
        *(u32x4*)(WT + (size_t)(n0 + n) * K + k0 + 8 * c) = o; }
    asm volatile("s_waitcnt lgkmcnt(0)" ::: "memory");
}

#define XB_TMO      128
#define XB_XCNT(j)  (256  + 64 * (j))
#define XB_XSUB(j)  (1280 + 64 * (j))
#define XB_XGEN(j)  (2304 + 64 * (j))
#define XB_TOP      3328
#define XB_TOPGEN   3392
#define XCD_BAR_WORDS 3456
#define XB_SPIN_CAP (1u << 22)
__device__ __forceinline__ unsigned xb_ld(unsigned* p)              { return __hip_atomic_load(p, __ATOMIC_RELAXED, __HIP_MEMORY_SCOPE_AGENT); }
__device__ __forceinline__ unsigned xb_add(unsigned* p, unsigned v) { return __hip_atomic_fetch_add(p, v, __ATOMIC_RELAXED, __HIP_MEMORY_SCOPE_AGENT); }
__device__ __forceinline__ unsigned xb_xcc_id() { return (unsigned)__builtin_amdgcn_s_getreg((3 << 11) | 20) & 0xFu; }
#define XB_SPIN(cond, bar) do { unsigned _sp = 0; while (cond) { __builtin_amdgcn_s_sleep(1); \
    if ((++_sp & 255u) == 0u) { if (xb_ld(&(bar)[XB_TMO])) break; if (_sp > XB_SPIN_CAP) { atomicAdd(&(bar)[XB_TMO], 1u); break; } } } } while (0)
struct XcdBarrier { unsigned* bar; unsigned x; volatile LAS unsigned* st; };
__device__ __forceinline__ void xcd_barrier_complete(unsigned* bar, unsigned x, unsigned& nloc, unsigned& nx) {
    const unsigned G = gridDim.x * gridDim.y * gridDim.z;
    unsigned sum, cnt, mine, sp = 0u;
    for (;;) {
        sum = 0u; cnt = 0u; mine = 0u;
#pragma unroll
        for (unsigned j = 0; j < 16; ++j) { const unsigned c = xb_ld(&bar[XB_XCNT(j)]); sum += c; cnt += (c > 0u) ? 1u : 0u; mine = (j == x) ? c : mine; }
        if (sum == G) break;
        __builtin_amdgcn_s_sleep(1);
        if ((++sp & 255u) == 0u) { if (xb_ld(&bar[XB_TMO])) break; if (sp > XB_SPIN_CAP) { atomicAdd(&bar[XB_TMO], 1u); break; } }
    }
    nloc = mine > 0u ? mine : 1u; nx = cnt > 0u ? cnt : 1u;
}
__device__ __forceinline__ void xcd_barrier(const XcdBarrier& b) {
    asm volatile("s_waitcnt vmcnt(0)" ::: "memory");
    __syncthreads();
    if (threadIdx.x == 0) {
        unsigned* bar = b.bar;
        __builtin_amdgcn_s_waitcnt(0);
        unsigned nloc = b.st[0], nx = b.st[1];
        if (nloc == 0u) { xcd_barrier_complete(bar, b.x, nloc, nx); b.st[0] = nloc; b.st[1] = nx; }
        const unsigned old = xb_add(&bar[XB_XSUB(b.x)], 1u);
        const unsigned gen = old / nloc;
        if (old + 1u == (gen + 1u) * nloc) {
            __builtin_amdgcn_fence(__ATOMIC_RELEASE, "agent");
            asm volatile("s_waitcnt vmcnt(0)" ::: "memory");
            const unsigned og = xb_add(&bar[XB_TOP], 1u);
            const unsigned tg = og / nx;
            if (og + 1u == (tg + 1u) * nx) xb_add(&bar[XB_TOPGEN], 1u);
            else XB_SPIN(xb_ld(&bar[XB_TOPGEN]) == tg, bar);
            __builtin_amdgcn_fence(__ATOMIC_ACQUIRE, "agent");
            xb_add(&bar[XB_XGEN(b.x)], 1u);
            asm volatile("s_waitcnt vmcnt(0)" ::: "memory");
        } else {
            XB_SPIN(xb_ld(&bar[XB_XGEN(b.x)]) == gen, bar);
            __builtin_amdgcn_fence(__ATOMIC_ACQUIRE, "agent");
            asm volatile("s_waitcnt vmcnt(0)" ::: "memory");
        }
    }
    __syncthreads();
}

__global__ void __launch_bounds__(NTHR, 2) mega(Params P) {
    extern __shared__ __attribute__((aligned(16))) unsigned char lds_raw[];
    cg::grid_group grid = cg::this_grid();
    LAS unsigned char* lds = (LAS unsigned char*)lds_raw;
    const int G = gridDim.x, bx = blockIdx.x; const int vcu = (G % 8 == 0) ? (bx % 8) * (G / 8) + bx / 8 : bx;
    const int NGW = G * NWAVES; const long NGT = (long)G * NTHR;
    float* xo = P.out;
    { unsigned* bw = (unsigned*)P.ws; if (bx == 0) for (int i = threadIdx.x; i < XCD_BAR_WORDS; i += NTHR) __hip_atomic_store(bw + i, 0u, __ATOMIC_RELAXED, __HIP_MEMORY_SCOPE_AGENT);
      if (threadIdx.x < 2) ((volatile LAS unsigned*)(lds + LDS_BYTES - 64))[threadIdx.x] = 0u; }
    __threadfence();
    grid.sync();
    XcdBarrier xbar; xbar.bar = (unsigned*)P.ws; xbar.x = xb_xcc_id(); xbar.st = (volatile LAS unsigned*)(lds + LDS_BYTES - 64);
    if (threadIdx.x == 0) (void)xb_add(&xbar.bar[XB_XCNT(xbar.x)], 1u);
#define GRID_BAR() xcd_barrier(xbar)
#define PH_INIT unsigned char* ws = P.ws; int tid = threadIdx.x; int L = l; asm volatile("" : "+s"(ws), "+v"(tid), "+s"(L)); \
    const int lane = tid & 63, wave = __builtin_amdgcn_readfirstlane(tid >> 6); const int gw = vcu * NWAVES + wave; const long gtid = (long)vcu * NTHR + tid; (void)lane; (void)gw; (void)gtid; \
    float* MOD = (float*)(ws + WS_MOD); float* ROPE = (float*)(ws + WS_ROPE); f32x2* PW = (f32x2*)(ws + WS_PW); f32x2* BB = (f32x2*)(ws + WS_BB); float* KM = (float*)(ws + WS_KM); \
    bf16_t* WQKVU = (bf16_t*)(ws + WS_WQKVU); bf16_t* WG = (bf16_t*)(ws + WS_WG); bf16_t* WAO = (bf16_t*)(ws + WS_WAO); bf16_t* WGLU = (bf16_t*)(ws + WS_WGLU); \
    bf16_t* WOUT = (bf16_t*)(ws + WS_WOUT); bf16_t* WUP = (bf16_t*)(ws + WS_WUP); bf16_t* WDOWN = (bf16_t*)(ws + WS_WDOWN); \
    bf16_t* TMAT = (bf16_t*)(ws + WS_TMAT); bf16_t* EMAT = (bf16_t*)(ws + WS_EMAT); bf16_t* XN = (bf16_t*)(ws + WS_XN); \
    bf16_t* QB = (bf16_t*)(ws + WS_Q); bf16_t* KB = (bf16_t*)(ws + WS_K); bf16_t* VB = (bf16_t*)(ws + WS_V); bf16_t* UEXT = (bf16_t*)(ws + WS_UEXT); \
    float* XLOC = (float*)(ws + WS_XLOC); bf16_t* YB = (bf16_t*)(ws + WS_XLOC); float* SCR = (float*)(ws + WS_SCR); \
    bf16_t* UPH = (bf16_t*)(ws + WS_UP); bf16_t* ACT = (bf16_t*)(ws + WS_ACT); \
    (void)MOD; (void)ROPE; (void)PW; (void)BB; (void)KM; (void)WQKVU; (void)WG; (void)WAO; (void)WGLU; (void)WOUT; (void)WUP; (void)WDOWN; (void)TMAT; (void)EMAT; (void)XN; (void)QB; (void)KB; (void)VB; (void)UEXT; (void)XLOC; (void)YB; (void)SCR; (void)UPH; (void)ACT
#define MAKE_E pg8::Epi E{}; E.layer = L; E.Q = QB; E.Kb = KB; E.Vb = VB; E.Uext = UEXT; E.Y = YB; E.UPh = UPH; E.xloc = XLOC; E.rope = ROPE; E.xout = xo

#define RUN_GEMM(A_, Bt_, lda_, ldb_, K_, nM_, nN_, ngrp_, epi_) do { pg8::Gemm g_{A_, Bt_, lda_, ldb_, K_, nM_, nN_, ngrp_}; pg8::Order S_; S_.init(g_, G, bx); pg8::gemm_phase(lds, g_, S_, epi_); } while (0)

#pragma unroll 1
    for (int l = 0; l < 2; ++l) {
        const float lambda_init = (l == 0) ? 0.2f : 0.35550906759f;
        {
            PH_INIT;
            LAS float* scr = (LAS float*)(lds + wave * 16384);
            const int I1 = 16 * 112, I2 = 16 * 64, I3 = 16 * 32, I4 = 8 * 64, I5 = 16 * 32, I6 = 16 * 176, I7 = 44 * 32, NI = I1 + I2 + I3 + I4 + I5 + I6 + I7;
            const float* win = P.in[I_WIN] + (size_t)L * DM * 5632;
            for (int it = gw; it < NI; it += NGW) {
                int r = it;
                if (r < I1) { transpose_item(win, nullptr, 1024, 5632, 0, 1, 3584, WQKVU, scr, r, lane); continue; } r -= I1;
                if (r < I2) { transpose_item(win, nullptr, 1024, 5632, 3584, 0, 2048, WG, scr, r, lane); continue; } r -= I2;
                if (r < I3) { transpose_item(P.in[I_WAO] + (size_t)L * DM * DM, nullptr, 1024, 1024, 0, 0, 1024, WAO, scr, r, lane); continue; } r -= I3;
                if (r < I4) { transpose_item(P.in[I_WGA] + (size_t)L * 512 * DM, P.in[I_WGB] + (size_t)L * 512 * DM, 512, 1024, 0, 2, 2048, WGLU, scr, r, lane); continue; } r -= I4;
                if (r < I5) { transpose_item(P.in[I_WOUT] + (size_t)L * DM * DM, nullptr, 1024, 1024, 0, 0, 1024, WOUT, scr, r, lane); continue; } r -= I5;
                if (r < I6) { transpose_item(P.in[I_WUP] + (size_t)L * DM * NUP, nullptr, 1024, NUP, 0, 0, NUP, WUP, scr, r, lane); continue; } r -= I6;
                transpose_item(P.in[I_WDOWN] + (size_t)L * DFF * DM, nullptr, DFF, 1024, 0, 0, 1024, WDOWN, scr, r, lane);
            }
            for (long i = gtid; i < 2 * 32 * 33 * 64; i += NGT) {
                const int p = (int)(i & 63); const int tau = (int)((i >> 6) % 33); const int dg = (int)(i / (64 * 33));
                const size_t li = ((size_t)L * 64 + dg) * 64 + p; const float lr = P.in[I_SLRE][li], lim = P.in[I_SLIM][li]; const float dt = expf(P.in[I_SLDT][L * 64 + dg]);
                const float mag = expf(lr * dt * (float)tau), ang = (lim * dt) * (float)tau;
                PW[i] = (f32x2){mag * cosf(ang), mag * sinf(ang)};
            }
            for (long i = gtid; i < 2 * 32 * 64 * 16; i += NGT) {
                const int p = (int)((i >> 4) & 63); const int dg = (int)(i >> 10);
                const size_t li = ((size_t)L * 64 + dg) * 64 + p; const float lr = P.in[I_SLRE][li], lim = P.in[I_SLIM][li]; const float dt = expf(P.in[I_SLDT][L * 64 + dg]);
                const float mag = expf(lr * dt), ang = lim * dt; const float ar = mag * cosf(ang), ai = mag * sinf(ang);
                const float den = lr * lr + lim * lim, nr = ar - 1.0f, ni_ = ai;
                const float fre = (nr * lr + ni_ * lim) / den, fim = (ni_ * lr - nr * lim) / den;
                const size_t bi = (size_t)L * 2 * 32 * 64 * 16 + i; const float br = P.in[I_SBRE][bi], bim = P.in[I_SBIM][bi];
                BB[i] = (f32x2){fre * br - fim * bim, fre * bim + fim * br};
            }
            if (L == 0) {
                for (long i = gtid; i < SEQ * 32; i += NGT) { const int s = (int)(i >> 5), f = (int)(i & 31);
                    const float inv = powf(10000.0f, -(float)f / 32.0f); const float ang = (float)s * inv; ROPE[2 * i] = cosf(ang); ROPE[2 * i + 1] = sinf(ang); }
                LAS float* cact = (LAS float*)lds; LAS float* red = (LAS float*)(lds + 32768);
                __syncthreads();
                for (int it = bx; it < 192; it += G) {
                    const int ll = it / 96, j0 = (it % 96) * 64;
                    for (int i = tid; i < NB * DM; i += NTHR) { const float cv = P.in[I_C][i]; cact[i] = cv / (1.0f + expf(-cv)); }
                    __syncthreads();
                    float a[NB];
#pragma unroll
                    for (int b = 0; b < NB; ++b) a[b] = 0.f;
                    const float* aw = P.in[I_ADAW] + (size_t)ll * DM * 6144 + j0 + lane;
                    for (int k = wave * 128; k < wave * 128 + 128; ++k) { const float wv = aw[(size_t)k * 6144];
#pragma unroll
                        for (int b = 0; b < NB; ++b) a[b] += cact[b * DM + k] * wv; }
#pragma unroll
                    for (int b = 0; b < NB; ++b) red[(wave * NB + b) * 64 + lane] = a[b];
                    __syncthreads();
                    { const int b = tid >> 6; float s = P.in[I_ADAB][ll * 6144 + j0 + lane];
#pragma unroll
                      for (int w = 0; w < NWAVES; ++w) s += red[(w * NB + b) * 64 + lane];
                      MOD[((size_t)ll * NB + b) * 6144 + j0 + lane] = s; }
                    __syncthreads();
                }
            }
        }
        GRID_BAR();
        {
            PH_INIT;
            const float* xin = (L == 0) ? P.in[I_X] : xo; const float* nw = P.in[I_N1W] + L * DM;
            for (int m = gw; m < T; m += NGW) {
                const int b = m >> 12; const f32x4* xr = (const f32x4*)(xin + (size_t)m * DM) + lane; f32x4 v[4]; float s = 0.f;
#pragma unroll
                for (int j = 0; j < 4; ++j) { v[j] = xr[64 * j]; s += (v[j][0] * v[j][0] + v[j][1] * v[j][1]) + (v[j][2] * v[j][2] + v[j][3] * v[j][3]); }
                const float r = rsqrtf(wave_sum(s) * (1.0f / DM) + 1e-6f);
                const float* md = MOD + ((size_t)L * NB + b) * 6144;
#pragma unroll
                for (int j = 0; j < 4; ++j) { const int col = lane * 4 + 256 * j; const f32x4 w4 = *(const f32x4*)(nw + col), sh = *(const f32x4*)(md + col), sc = *(const f32x4*)(md + 1024 + col);
                    const f32x4 hv = v[j] * r * w4 * (sc + 1.0f) + sh; u32x2 w; w.x = cvt_pk_bf16(hv[0], hv[1]); w.y = cvt_pk_bf16(hv[2], hv[3]); *(u32x2*)(XN + (size_t)m * DM + col) = w; }
            }
            for (long i = gtid; i < 2 * 32 * 32 * 256; i += NGT) {
                const int ni = (int)(i & 15), no = (int)((i >> 4) & 15), tau = (int)((i >> 8) & 31), dg = (int)(i >> 13);
                const float* cre = P.in[I_SCRE] + (((size_t)L * 64 + dg) * 16 + no) * 64; const float* cim = P.in[I_SCIM] + (((size_t)L * 64 + dg) * 16 + no) * 64;
                const f32x2* pw = PW + ((size_t)dg * 33 + tau) * 64; const f32x2* bb = BB + (size_t)dg * 1024 + ni; float acc = 0.f;
                for (int p = 0; p < 64; ++p) { const f32x2 w = pw[p], bv = bb[p * 16]; const float cr = cre[p], ci = cim[p]; const float zr = cr * w.x - ci * w.y, zi = cr * w.y + ci * w.x; acc += zr * bv.x - zi * bv.y; }
                KM[i] = acc;
            }
            for (long i = gtid; i < 32 * 256 * 64; i += NGT) {
                const int k8 = (int)(i & 63), n = (int)((i >> 6) & 255), g = (int)(i >> 14); const int dir = n >> 7, ri = (n >> 6) & 1, p = n & 63; const int s = k8 >> 1, ni0 = (k8 & 1) * 8;
                const int e = dir == 0 ? (CH - 1 - s) : s; const f32x2 w = PW[((size_t)(dir * 32 + g) * 33 + e) * 64 + p]; const f32x2* bb = BB + ((size_t)(dir * 32 + g) * 64 + p) * 16 + ni0;
                float o[8];
#pragma unroll
                for (int q = 0; q < 8; ++q) { const f32x2 bv = bb[q]; o[q] = ri == 0 ? (w.x * bv.x - w.y * bv.y) : (w.x * bv.y + w.y * bv.x); }
                u32x4 ov; ov.x = cvt_pk_bf16(o[0], o[1]); ov.y = cvt_pk_bf16(o[2], o[3]); ov.z = cvt_pk_bf16(o[4], o[5]); ov.w = cvt_pk_bf16(o[6], o[7]);
                *(u32x4*)(EMAT + ((size_t)g * 256 + n) * 512 + k8 * 8) = ov;
            }
            for (long i = gtid; i < 32 * 512 * 32; i += NGT) {
                const int c8 = (int)(i & 31), n = (int)((i >> 5) & 511), g = (int)(i >> 14); const int t = n >> 4, no = n & 15; const int dir = c8 >> 4, ri = (c8 >> 3) & 1, p0 = (c8 & 7) * 8;
                const int e = dir == 0 ? (t + 1) : (CH - t); const f32x2* pw = PW + ((size_t)(dir * 32 + g) * 33 + e) * 64 + p0;
                const float* cre = P.in[I_SCRE] + ((((size_t)L * 2 + dir) * 32 + g) * 16 + no) * 64 + p0; const float* cim = P.in[I_SCIM] + ((((size_t)L * 2 + dir) * 32 + g) * 16 + no) * 64 + p0;
                float o[8];
#pragma unroll
                for (int q = 0; q < 8; ++q) { const f32x2 w = pw[q]; const float cr = cre[q], ci = cim[q]; o[q] = ri == 0 ? (cr * w.x - ci * w.y) : -(cr * w.y + ci * w.x); }
                u32x4 ov; ov.x = cvt_pk_bf16(o[0], o[1]); ov.y = cvt_pk_bf16(o[2], o[3]); ov.z = cvt_pk_bf16(o[4], o[5]); ov.w = cvt_pk_bf16(o[6], o[7]);
                *(u32x4*)(TMAT + ((size_t)g * 512 + n) * KX + 512 + c8 * 8) = ov;
            }
        }
        GRID_BAR();
        { PH_INIT; MAKE_E; E.mode = 1; RUN_GEMM(XN, WQKVU, 1024, 1024, 1024, 128, 14, 1, E); }
        GRID_BAR();
        { PH_INIT; MAKE_E; E.mode = 2; RUN_GEMM(UEXT, EMAT, KX, 512, 512, 4, 1, 32, E); }
        {
            PH_INIT;
            const float* dsk = P.in[I_SD] + L * 512;
            for (long i = gtid; i < 32 * 512 * 64; i += NGT) {
                const int k8 = (int)(i & 63), n = (int)((i >> 6) & 511), g = (int)(i >> 15); const int t = n >> 4, no = n & 15, s = k8 >> 1, ni0 = (k8 & 1) * 8;
                float o[8];
                if (t != s) { const int dir = t > s ? 0 : 1, tau = t > s ? t - s : s - t; const float* km = KM + ((((size_t)(dir * 32 + g)) * 32 + tau) * 16 + no) * 16 + ni0;
#pragma unroll
                    for (int q = 0; q < 8; ++q) o[q] = km[q];
                } else { const float* k0 = KM + (((size_t)(g) * 32) * 16 + no) * 16 + ni0; const float* k1 = KM + (((size_t)(32 + g) * 32) * 16 + no) * 16 + ni0;
#pragma unroll
                    for (int q = 0; q < 8; ++q) o[q] = k0[q] + k1[q] + ((ni0 + q) == no ? dsk[g * 16 + no] : 0.f);
                }
                u32x4 ov; ov.x = cvt_pk_bf16(o[0], o[1]); ov.y = cvt_pk_bf16(o[2], o[3]); ov.z = cvt_pk_bf16(o[4], o[5]); ov.w = cvt_pk_bf16(o[6], o[7]);
                *(u32x4*)(TMAT + ((size_t)g * 512 + n) * KX + k8 * 8) = ov;
            }
        }
        GRID_BAR();
        {
            PH_INIT;
            const long i = gtid;
            if (i < 32 * NB * 2 * 64) {
                const int p = (int)(i & 63), dir = (int)((i >> 6) & 1), b = (int)((i >> 7) & 7), g = (int)(i >> 10);
                const f32x2 al = PW[((size_t)(dir * 32 + g) * 33 + CH) * 64 + p];
                float xr = 0.f, xi = 0.f;
                const float* xl = XLOC + ((size_t)g * (NB * NCH) + b * NCH) * 256 + dir * 128 + p;
                bf16_t* ue = UEXT + ((size_t)g * (NB * NCH) + b * NCH) * KX + 512 + dir * 128 + p;
#pragma unroll 4
                for (int cc = 0; cc < NCH; ++cc) {
                    const int c = dir == 0 ? cc : NCH - 1 - cc;
                    const float lr = xl[(size_t)c * 256], li = xl[(size_t)c * 256 + 64];
                    ue[(size_t)c * KX] = (bf16_t)(cvt_pk_bf16(xr, 0.f) & 0xffffu); ue[(size_t)c * KX + 64] = (bf16_t)(cvt_pk_bf16(xi, 0.f) & 0xffffu);
                    const float nr = al.x * xr - al.y * xi + lr, nim = al.x * xi + al.y * xr + li; xr = nr; xi = nim;
                }
            }
        }
        GRID_BAR();
        {
            PH_INIT;
            float s1 = wave_sum(P.in[I_LQ1][L * 64 + lane] * P.in[I_LK1][L * 64 + lane]), s2 = wave_sum(P.in[I_LQ2][L * 64 + lane] * P.in[I_LK2][L * 64 + lane]);
            const float lam = expf(s1) - expf(s2) + lambda_init;
            for (int i = 0; i < 4; ++i) { const int u = i * G + vcu; if (u >= 1024) break; const int bh = u >> 4, qb = u & 15;
                att::attn_unit(bh >> 3, bh & 7, qb, QB, KB, VB, QB, SCR + (size_t)bx * 32768, lam, 1.0f - lambda_init, P.in[I_SUBW] + L * 128, (char*)lds_raw); }
            __syncthreads();
        }
        { PH_INIT; MAKE_E; E.mode = 3; RUN_GEMM(UEXT, TMAT, KX, KX, KX, 4, 2, 32, E); }
        GRID_BAR();
        { PH_INIT; MAKE_E; E.mode = 4; RUN_GEMM(XN, WG, 1024, 1024, 1024, 128, 8, 1, E); }
        GRID_BAR();
        { PH_INIT; MAKE_E; E.mode = 5; RUN_GEMM(YB, WGLU, 512, 512, 512, 128, 8, 1, E); }
        GRID_BAR();
        { PH_INIT; MAKE_E; E.mode = 6; RUN_GEMM(QB, WAO, 1024, 1024, 1024, 128, 4, 1, E); }
        GRID_BAR();
        { PH_INIT; MAKE_E; E.mode = 7; E.gate = MOD + (size_t)L * NB * 6144 + 2048; E.base = (L == 0) ? P.in[I_X] : xo; RUN_GEMM(KB, WOUT, 1024, 1024, 1024, 128, 4, 1, E); }
        GRID_BAR();
        {
            PH_INIT;
            const float* nw = P.in[I_N2W] + L * DM;
            for (int m = gw; m < T; m += NGW) {
                const int b = m >> 12; const f32x4* xr = (const f32x4*)(xo + (size_t)m * DM) + lane; f32x4 v[4]; float s = 0.f;
#pragma unroll
                for (int j = 0; j < 4; ++j) { v[j] = xr[64 * j]; s += (v[j][0] * v[j][0] + v[j][1] * v[j][1]) + (v[j][2] * v[j][2] + v[j][3] * v[j][3]); }
                const float r = rsqrtf(wave_sum(s) * (1.0f / DM) + 1e-6f);
                const float* md = MOD + ((size_t)L * NB + b) * 6144 + 3072;
#pragma unroll
                for (int j = 0; j < 4; ++j) { const int col = lane * 4 + 256 * j; const f32x4 w4 = *(const f32x4*)(nw + col), sh = *(const f32x4*)(md + col), sc = *(const f32x4*)(md + 1024 + col);
                    const f32x4 hv = v[j] * r * w4 * (sc + 1.0f) + sh; u32x2 w; w.x = cvt_pk_bf16(hv[0], hv[1]); w.y = cvt_pk_bf16(hv[2], hv[3]); *(u32x2*)(XN + (size_t)m * DM + col) = w; }
            }
        }
        GRID_BAR();
#pragma unroll 1
        for (int hf = 0; hf < 2; ++hf) {
            { PH_INIT; MAKE_E; E.mode = 8; RUN_GEMM(XN + (size_t)hf * 16384 * DM, WUP, 1024, 1024, 1024, 64, 22, 1, E); }
            GRID_BAR();
            {
                PH_INIT;
                const float* cw = P.in[I_CONVW] + (size_t)L * 3 * NUP; const float* cb = P.in[I_CONVB] + (size_t)L * NUP;
                for (long it = gtid; it < 1024L * 352; it += NGT) {
                    const int rb = (int)(it / 352), jc = (int)(it % 352), j = jc * 8, r0 = rb * 16;
                    float wv[3][8], wg[3][8], bv[8], bg[8];
#pragma unroll
                    for (int k = 0; k < 3; ++k)
#pragma unroll
                        for (int q = 0; q < 8; ++q) { wv[k][q] = cw[k * NUP + j + q]; wg[k][q] = cw[k * NUP + DFF + j + q]; }
#pragma unroll
                    for (int q = 0; q < 8; ++q) { bv[q] = cb[j + q]; bg[q] = cb[DFF + j + q]; }
                    u32x4 pv_, pg_, cv_, cg_, nv_, ng_;
                    const u32x4 z4 = (u32x4){0u, 0u, 0u, 0u};
                    if ((r0 & (SEQ - 1)) != 0) { pv_ = *(const u32x4*)(UPH + (size_t)(r0 - 1) * NUP + j); pg_ = *(const u32x4*)(UPH + (size_t)(r0 - 1) * NUP + DFF + j); } else { pv_ = z4; pg_ = z4; }
                    cv_ = *(const u32x4*)(UPH + (size_t)r0 * NUP + j); cg_ = *(const u32x4*)(UPH + (size_t)r0 * NUP + DFF + j);
#pragma unroll 1
                    for (int r = r0; r < r0 + 16; ++r) {
                        if (((r + 1) & (SEQ - 1)) != 0) { nv_ = *(const u32x4*)(UPH + (size_t)(r + 1) * NUP + j); ng_ = *(const u32x4*)(UPH + (size_t)(r + 1) * NUP + DFF + j); } else { nv_ = z4; ng_ = z4; }
                        float o[8];
#pragma unroll
                        for (int q2 = 0; q2 < 4; ++q2) {
                            const float v0 = wv[0][2 * q2] * bf_lo(pv_[q2]) + wv[1][2 * q2] * bf_lo(cv_[q2]) + wv[2][2 * q2] * bf_lo(nv_[q2]) + bv[2 * q2];
                            const float v1 = wv[0][2 * q2 + 1] * bf_hi(pv_[q2]) + wv[1][2 * q2 + 1] * bf_hi(cv_[q2]) + wv[2][2 * q2 + 1] * bf_hi(nv_[q2]) + bv[2 * q2 + 1];
                            const float g0 = wg[0][2 * q2] * bf_lo(pg_[q2]) + wg[1][2 * q2] * bf_lo(cg_[q2]) + wg[2][2 * q2] * bf_lo(ng_[q2]) + bg[2 * q2];
                            const float g1 = wg[0][2 * q2 + 1] * bf_hi(pg_[q2]) + wg[1][2 * q2 + 1] * bf_hi(cg_[q2]) + wg[2][2 * q2 + 1] * bf_hi(ng_[q2]) + bg[2 * q2 + 1];
                            o[2 * q2] = g0 * sigmoidf_(g0) * v0; o[2 * q2 + 1] = g1 * sigmoidf_(g1) * v1;
                        }
                        u32x4 ov; ov.x = cvt_pk_bf16(o[0], o[1]); ov.y = cvt_pk_bf16(o[2], o[3]); ov.z = cvt_pk_bf16(o[4], o[5]); ov.w = cvt_pk_bf16(o[6], o[7]);
                        *(u32x4*)(ACT + ((size_t)hf * 16384 + r) * DFF + j) = ov;
                        pv_ = cv_; pg_ = cg_; cv_ = nv_; cg_ = ng_;
                    }
                }
            }
            GRID_BAR();
        }
        { PH_INIT; MAKE_E; E.mode = 7; E.gate = MOD + (size_t)L * NB * 6144 + 5120; E.base = xo; RUN_GEMM(ACT, WDOWN, DFF, DFF, DFF, 128, 4, 1, E); }
        GRID_BAR();
    }
    {
        const int l = 2;
        PH_INIT;
        const float* nw = P.in[I_FINW];
        for (int m = gw; m < T; m += NGW) {
            f32x4* xr = (f32x4*)(xo + (size_t)m * DM) + lane; f32x4 v[4]; float s = 0.f;
#pragma unroll
            for (int j = 0; j < 4; ++j) { v[j] = xr[64 * j]; s += (v[j][0] * v[j][0] + v[j][1] * v[j][1]) + (v[j][2] * v[j][2] + v[j][3] * v[j][3]); }
            const float r = rsqrtf(wave_sum(s) * (1.0f / DM) + 1e-6f);
#pragma unroll
            for (int j = 0; j < 4; ++j) { const f32x4 w4 = *(const f32x4*)(nw + lane * 4 + 256 * j); xr[64 * j] = v[j] * r * w4; }
        }
    }
}

extern "C" void kernel_launch(void* const* d_in, const int* in_sizes, int n_in, void* d_out, int out_size, void* d_ws, size_t ws_size, hipStream_t stream) {
    static int grid = 0;
    if (grid == 0) {
        if (n_in != 29 || out_size != T * DM || ws_size < WS_END) { fprintf(stderr, "kernel_launch: unexpected shapes n_in %d out %d ws %zu (need %zu)\n", n_in, out_size, ws_size, (size_t)WS_END); grid = -1; return; }
        int dev = 0, cus = 0, per_cu = 0;
        (void)hipGetDevice(&dev); (void)hipDeviceGetAttribute(&cus, hipDeviceAttributeMultiprocessorCount, dev);
        if (hipFuncSetAttribute((const void*)mega, hipFuncAttributeMaxDynamicSharedMemorySize, LDS_BYTES) != hipSuccess) { fprintf(stderr, "kernel_launch: hipFuncSetAttribute failed\n"); grid = -1; return; }
        (void)hipOccupancyMaxActiveBlocksPerMultiprocessor(&per_cu, (const void*)mega, NTHR, LDS_BYTES);
        if (per_cu < 1) { fprintf(stderr, "kernel_launch: occupancy query says %d blocks per CU\n", per_cu); per_cu = 1; }
        (void)hipGetLastError();
        grid = cus;
    }
    if (grid < 0) return;
    Params p{};
    for (int i = 0; i < 29; ++i) p.in[i] = (const float*)d_in[i];
    p.out = (float*)d_out; p.ws = (unsigned char*)d_ws;
    void* args[] = {&p};
    hipError_t e = hipLaunchCooperativeKernel((const void*)mega, dim3(grid), dim3(NTHR), args, LDS_BYTES, stream);
    if (e != hipSuccess) fprintf(stderr, "cooperative launch failed: %s (grid %d)\n", hipGetErrorString(e), grid);
}
```

```cpp
#include <hip/hip_runtime.h>
#include <hip/hip_cooperative_groups.h>
#include <cstdio>
#include <cstdint>
namespace cg = cooperative_groups;

#define LAS __attribute__((address_space(3)))
typedef unsigned short bf16_t;
typedef short bf16x8 __attribute__((ext_vector_type(8)));
typedef short s16x4 __attribute__((ext_vector_type(4)));
typedef float f32x2 __attribute__((ext_vector_type(2)));
typedef float f32x4 __attribute__((ext_vector_type(4)));
typedef float f32x16 __attribute__((ext_vector_type(16)));
typedef unsigned u32x2 __attribute__((ext_vector_type(2)));
typedef unsigned u32x4 __attribute__((ext_vector_type(4)));

constexpr int NB = 8, SEQ = 4096, DM = 1024, T = NB * SEQ, DFF = 2816, NUP = 2 * DFF, NWAVES = 8, NTHR = 512;
constexpr int CH = 32, NCH = SEQ / CH, KX = 768;
constexpr size_t MiB = 1u << 20;
constexpr size_t WS_KMAX = 64 * 1024, WS_MOD = 1 * MiB, WS_ROPE = 2 * MiB, WS_PW = 3 * MiB, WS_BB = 5 * MiB, WS_KM = 6 * MiB;
constexpr size_t WS_WQKVU = 8 * MiB, WS_WG = 15 * MiB, WS_WAO = 19 * MiB, WS_WGLU = 21 * MiB, WS_WOUT = 23 * MiB, WS_WUP = 25 * MiB, WS_WDOWN = 36 * MiB;
constexpr size_t WS_TMAT = 42 * MiB, WS_EMAT = 66 * MiB, WS_XN = 74 * MiB;
constexpr size_t WS_Q = 138 * MiB, WS_K = 202 * MiB, WS_V = 266 * MiB, WS_UEXT = 330 * MiB, WS_XLOC = 378 * MiB, WS_SCR = 410 * MiB;
constexpr size_t WS_UP = 138 * MiB, WS_ACT = 314 * MiB, WS_END = 490 * MiB;
constexpr int LDS_BYTES = 147456;

struct Params {
    const float* in[29];
    float* out;
    unsigned char* ws;
};
enum { I_X = 0, I_C, I_N1W, I_N2W, I_ADAW, I_ADAB, I_WIN, I_LQ1, I_LK1, I_LQ2, I_LK2, I_SUBW, I_WAO, I_SLRE, I_SLIM, I_SLDT, I_SBRE, I_SBIM, I_SCRE, I_SCIM, I_SD,
       I_WGA, I_WGB, I_WOUT, I_WUP, I_CONVW, I_CONVB, I_WDOWN, I_FINW };

__device__ __forceinline__ unsigned cvt_pk_bf16(float lo, float hi) { unsigned r; asm volatile("v_cvt_pk_bf16_f32 %0, %1, %2" : "=v"(r) : "v"(lo), "v"(hi)); return r; }
__device__ __forceinline__ float bf_lo(unsigned w) { return __uint_as_float(w << 16); }
__device__ __forceinline__ float bf_hi(unsigned w) { return __uint_as_float(w & 0xffff0000u); }
__device__ __forceinline__ float sigmoidf_(float x) { return 1.0f / (1.0f + __expf(-x)); }
__device__ __forceinline__ float gelu_tanh(float x) { const float z = 0.7978845608028654f * (x + 0.044715f * x * x * x); return x / (1.0f + __expf(-2.0f * z)); }
__device__ __forceinline__ float shfl_xor_l(float v, int x, int lane) { return __uint_as_float((unsigned)__builtin_amdgcn_ds_bpermute((lane ^ x) << 2, (int)__float_as_uint(v))); }
__device__ __forceinline__ float wave_sum(float v, int lane) {
#pragma unroll
    for (int o = 1; o < 64; o <<= 1) v += shfl_xor_l(v, o, lane);
    return v;
}

namespace pg8 {
constexpr int BM = 256, BK = 64, HALF = 128, HTB = HALF * BK * 2, NXCD = 8, WGM = 8;
__host__ __device__ __forceinline__ int lds_byte(int r, int c) { const int st = (r >> 4) * 2 + (c >> 5), rr = r & 15, cc = c & 31, ob = rr * 64 + cc * 2; return st * 1024 + (ob ^ (((ob >> 9) & 1) << 5)); }
__host__ __device__ __forceinline__ void stage_rc(int b, int& R, int& C) { const int st = b / 1024, sb = b % 1024, swz = sb ^ (((sb >> 9) & 1) << 5); R = (st >> 1) * 16 + swz / 64; C = (st & 1) * 32 + (swz % 64) / 2; }

struct Unit { int pm, pn, grp; };
struct Gemm { const bf16_t* A; const bf16_t* Bt; int lda, ldb, K, nM, nN, ngrp; };
struct Order {
    int nM, nN, ngrp, nwg, G, c;
    __device__ void init(const Gemm& g, int G_, int c_) { nM = g.nM; nN = g.nN; ngrp = g.ngrp; nwg = nM * nN * ngrp; G = G_; c = c_; }
    __device__ bool next(int i, Unit& u) const {
        const long L = (long)i * G + c; if (L >= nwg) return false;
        if (ngrp == 1) {
            int wgid = (int)L; { const int q = nwg / NXCD, r = nwg % NXCD, xcd = wgid % NXCD, off = wgid / NXCD; wgid = (xcd < r ? xcd * (q + 1) : r * (q + 1) + (xcd - r) * q) + off; }
            const int nig = WGM * nN, gid = wgid / nig, fm = gid * WGM, gsz = (nM - fm) < WGM ? (nM - fm) : WGM;
            u.pm = fm + ((wgid % nig) % gsz); u.pn = (wgid % nig) / gsz; u.grp = 0;
        } else {
            const int per = nM * nN; const int w = (int)(L % per); u.grp = (int)(L / per); u.pm = w % nM; u.pn = w / nM;
        }
        return true;
    }
};

struct Epi {
    int mode, layer;
    bf16_t *Q, *Kb, *Vb, *Uext, *Y, *UPh;
    float* xloc; const float* rope; const float* gate; const float* base; float* xout;
    __device__ __forceinline__ void operator()(const f32x4 (&acc)[2][2][4][2], const Unit& u, int wr, int wc, int fr, int fq) const {
        const int colt = u.pn * BM;
#pragma unroll
        for (int ai = 0; ai < 2; ++ai)
#pragma unroll
            for (int m = 0; m < 4; ++m) {
                const int rl = ai * HALF + wr * 64 + m * 16 + fr;
                const int row = u.pm * BM + rl;
#pragma unroll
                for (int bj = 0; bj < 2; ++bj)
#pragma unroll
                    for (int n = 0; n < 2; ++n) {
                        const int cl = bj * HALF + wc * 32 + n * 16 + fq * 4;
                        const f32x4 v = acc[ai][bj][m][n];
                        if (mode == 1) {
                            if (colt < 2048) {
                                bf16_t* dst = colt < 1024 ? Q : Kb; const int cc = (colt & 1023) + cl; const int s = row & (SEQ - 1); const int i = (cc & 63) >> 1;
                                const f32x4 cs = *(const f32x4*)(rope + ((size_t)s * 32 + i) * 2);
                                const float o0 = v[0] * cs[0] - v[1] * cs[1], o1 = v[1] * cs[0] + v[0] * cs[1], o2 = v[2] * cs[2] - v[3] * cs[3], o3 = v[3] * cs[2] + v[2] * cs[3];
                                u32x2 w; w.x = cvt_pk_bf16(o0, o1); w.y = cvt_pk_bf16(o2, o3); *(u32x2*)(dst + (size_t)row * DM + cc) = w;
                            } else if (colt < 3072) {
                                u32x2 w; w.x = cvt_pk_bf16(v[0], v[1]); w.y = cvt_pk_bf16(v[2], v[3]); *(u32x2*)(Vb + (size_t)row * DM + (colt - 2048) + cl) = w;
                            } else {
                                const int uc = colt - 3072 + cl, g = uc >> 4, ni = uc & 15; const int b = row >> 12, s = row & (SEQ - 1), ch = s >> 5, sl = s & 31;
                                u32x2 w; w.x = cvt_pk_bf16(v[0], v[1]); w.y = cvt_pk_bf16(v[2], v[3]);
                                *(u32x2*)(Uext + ((size_t)(g * (NB * NCH) + b * NCH + ch)) * KX + sl * 16 + ni) = w;
                            }
                        } else if (mode == 2) {
                            *(f32x4*)(xloc + ((size_t)(u.grp * (NB * NCH) + row)) * 256 + cl) = v;
                        } else if (mode == 3) {
                            const int b = row >> 7, ch = row & 127; const int nn = colt + cl, t = nn >> 4, no = nn & 15; const size_t tok = (size_t)b * SEQ + ch * CH + t;
                            u32x2 w; w.x = cvt_pk_bf16(gelu_tanh(v[0]), gelu_tanh(v[1])); w.y = cvt_pk_bf16(gelu_tanh(v[2]), gelu_tanh(v[3]));
                            *(u32x2*)(Y + tok * 512 + u.grp * 16 + no) = w;
                        } else if (mode == 4) {
                            bf16_t* dst = colt < 1024 ? Kb : Vb; const int cc = (colt & 1023) + cl;
                            u32x2 w; w.x = cvt_pk_bf16(sigmoidf_(v[0]), sigmoidf_(v[1])); w.y = cvt_pk_bf16(sigmoidf_(v[2]), sigmoidf_(v[3])); *(u32x2*)(dst + (size_t)row * DM + cc) = w;
                        } else if (mode == 5) {
                            if (n == 0) {
                                const f32x4 bv = acc[ai][bj][m][1]; const int cc = u.pn * 128 + bj * 64 + wc * 16 + fq * 4; bf16_t* p = Vb + (size_t)row * DM + cc;
                                const u32x2 sg = *(const u32x2*)p;
                                u32x2 w; w.x = cvt_pk_bf16(v[0] * sigmoidf_(bv[0]) * bf_lo(sg.x), v[1] * sigmoidf_(bv[1]) * bf_hi(sg.x));
                                w.y = cvt_pk_bf16(v[2] * sigmoidf_(bv[2]) * bf_lo(sg.y), v[3] * sigmoidf_(bv[3]) * bf_hi(sg.y)); *(u32x2*)p = w;
                            }
                        } else if (mode == 6) {
                            const int cc = colt + cl; bf16_t* p = Kb + (size_t)row * DM + cc; const u32x2 sg = *(const u32x2*)p; const u32x2 os = *(const u32x2*)(Vb + (size_t)row * DM + cc);
                            u32x2 w; w.x = cvt_pk_bf16(bf_lo(sg.x) * v[0] + bf_lo(os.x), bf_hi(sg.x) * v[1] + bf_hi(os.x)); w.y = cvt_pk_bf16(bf_lo(sg.y) * v[2] + bf_lo(os.y), bf_hi(sg.y) * v[3] + bf_hi(os.y));
                            *(u32x2*)p = w;
                        } else if (mode == 7) {
                            const int cc = colt + cl; const int b = row >> 12; const f32x4 gt = *(const f32x4*)(gate + (size_t)b * 6144 + cc); const size_t off = (size_t)row * DM + cc;
                            const f32x4 bs = *(const f32x4*)(base + off); *(f32x4*)(xout + off) = bs + gt * v;
                        } else {
                            u32x2 w; w.x = cvt_pk_bf16(v[0], v[1]); w.y = cvt_pk_bf16(v[2], v[3]); *(u32x2*)(UPh + (size_t)row * NUP + colt + cl) = w;
                        }
                    }
            }
    }
};

__device__ __forceinline__ void gemm_phase(LAS unsigned char* lds, const Gemm g, const Order& S, const Epi& E) {
    int tid = threadIdx.x; asm volatile("" : "+v"(tid));
    const int wid = __builtin_amdgcn_readfirstlane(tid >> 6), lane = tid & 63, wr = wid >> 2, wc = wid & 3, fr = lane & 15, fq = lane >> 4;
    const int K = g.K, nt = K / BK;
    unsigned voffA[2], voffB[2];
#pragma unroll
    for (int i = 0; i < 2; ++i) { int R, C; stage_rc(tid * 16 + i * 8192, R, C); voffA[i] = (unsigned)(R * g.lda + C) * 2u; voffB[i] = (unsigned)(R * g.ldb + C) * 2u; }
    const size_t kstep = (size_t)(BK * 2);
    const size_t hstepA = (size_t)HALF * g.lda * 2, hstepB = (size_t)HALF * g.ldb * 2;
    const size_t tstepA = 2 * hstepA, tstepB = 2 * hstepB;
    const unsigned ldsw = (unsigned)wid * 1024u;
    const int aoff = lds_byte(wr * 64 + fr, fq * 8), boff = lds_byte(wc * 32 + fr, fq * 8);
#define PG8_SA(b, h) (((b) * 2 + (h)) * HTB)
#define PG8_SB(b, h) ((4 + (b) * 2 + (h)) * HTB)
#define PG8_STAGE(bufoff, gbase, voff) do { _Pragma("unroll") for (int _i = 0; _i < 2; ++_i) \
        __builtin_amdgcn_global_load_lds((const unsigned*)((const char*)(gbase) + (voff)[_i]), (LAS unsigned*)(lds + (bufoff) + ldsw + _i * 8192), 16, 0, 0); } while (0)
#define PG8_LDA(dst, b, h) do { _Pragma("unroll") for (int m = 0; m < 4; ++m) _Pragma("unroll") for (int k = 0; k < 2; ++k) dst[m][k] = *(const LAS bf16x8*)(lds + PG8_SA(b, h) + aoff + m * 2048 + k * 1024); } while (0)
#define PG8_LDB(dst, b, h) do { _Pragma("unroll") for (int n = 0; n < 2; ++n) _Pragma("unroll") for (int k = 0; k < 2; ++k) dst[n][k] = *(const LAS bf16x8*)(lds + PG8_SB(b, h) + boff + n * 2048 + k * 1024); } while (0)
#define PG8_MMA(ai, bj, At, Bt) do { __builtin_amdgcn_s_setprio(1); _Pragma("unroll") for (int m = 0; m < 4; ++m) _Pragma("unroll") for (int n = 0; n < 2; ++n) _Pragma("unroll") for (int k = 0; k < 2; ++k) \
        acc[ai][bj][m][n] = __builtin_amdgcn_mfma_f32_16x16x32_bf16(Bt[n][k], At[m][k], acc[ai][bj][m][n], 0, 0, 0); __builtin_amdgcn_s_setprio(0); } while (0)
#define PG8_WAIT_V(n) asm volatile("s_waitcnt vmcnt(" #n ")" ::: "memory")
#define PG8_WAIT_L(n) asm volatile("s_waitcnt lgkmcnt(" #n ")" ::: "memory")
#define PG8_BAR __builtin_amdgcn_s_barrier()
#define PG8_SCHED __builtin_amdgcn_sched_barrier(0)
    Unit cur, nxt; int ui = 0;
    if (!S.next(0, cur)) return;
    f32x4 acc[2][2][4][2];
#pragma unroll
    for (int a = 0; a < 2; ++a)
#pragma unroll
        for (int b = 0; b < 2; ++b)
#pragma unroll
            for (int m = 0; m < 4; ++m)
#pragma unroll
                for (int n = 0; n < 2; ++n) acc[a][b][m][n] = (f32x4){0.f, 0.f, 0.f, 0.f};
    bf16x8 At[4][2], B0[2][2], B1[2][2];
    const char* cA = (const char*)g.A + (size_t)(cur.grp * g.nM + cur.pm) * tstepA; const char* cB = (const char*)g.Bt + (size_t)(cur.grp * g.nN + cur.pn) * tstepB;
    PG8_STAGE(PG8_SB(0, 0), cB, voffB); PG8_STAGE(PG8_SB(0, 1), cB + hstepB, voffB); PG8_STAGE(PG8_SA(0, 0), cA, voffA); PG8_STAGE(PG8_SA(0, 1), cA + hstepA, voffA);
    if (wr == 1) PG8_BAR;
    PG8_WAIT_V(2); PG8_BAR;
    PG8_STAGE(PG8_SB(1, 0), cB + kstep, voffB); PG8_STAGE(PG8_SA(1, 0), cA + kstep, voffA); PG8_STAGE(PG8_SB(1, 1), cB + hstepB + kstep, voffB);
    PG8_WAIT_V(6); PG8_BAR;
    for (;;) {
        const bool has_next = S.next(ui + 1, nxt);
        const char* nA = has_next ? (const char*)g.A + (size_t)(nxt.grp * g.nM + nxt.pm) * tstepA : cA; const char* nB = has_next ? (const char*)g.Bt + (size_t)(nxt.grp * g.nN + nxt.pn) * tstepB : cB;
        for (int t = 0; t < nt; t += 2) {
            const bool last = (t == nt - 2);
            const char* a1 = cA + (size_t)(t + 1) * kstep;
            const char* a2 = last ? nA : cA + (size_t)(t + 2) * kstep; const char* b2 = last ? nB : cB + (size_t)(t + 2) * kstep;
            const char* a3 = a2 + kstep; const char* b3 = b2 + kstep;
            PG8_LDB(B0, 0, 0); PG8_LDB(B1, 0, 1); PG8_SCHED; PG8_LDA(At, 0, 0); PG8_STAGE(PG8_SA(1, 1), a1 + hstepA, voffA);
            PG8_WAIT_V(8); PG8_WAIT_L(0); PG8_BAR; PG8_MMA(0, 0, At, B0); PG8_MMA(0, 1, At, B1); PG8_BAR; PG8_SCHED;
            PG8_LDA(At, 0, 1); PG8_STAGE(PG8_SB(0, 0), b2, voffB); PG8_STAGE(PG8_SB(0, 1), b2 + hstepB, voffB); PG8_STAGE(PG8_SA(0, 0), a2, voffA);
            PG8_WAIT_V(8); PG8_WAIT_L(0); PG8_BAR; PG8_MMA(1, 0, At, B0); PG8_MMA(1, 1, At, B1); PG8_BAR; PG8_SCHED;
            PG8_LDB(B0, 1, 0); PG8_LDB(B1, 1, 1); PG8_SCHED; PG8_LDA(At, 1, 0); PG8_STAGE(PG8_SA(0, 1), a2 + hstepA, voffA);
            PG8_WAIT_V(8); PG8_WAIT_L(0); PG8_BAR; PG8_MMA(0, 0, At, B0); PG8_MMA(0, 1, At, B1); PG8_BAR; PG8_SCHED;
            PG8_LDA(At, 1, 1); PG8_STAGE(PG8_SB(1, 0), b3, voffB); PG8_STAGE(PG8_SB(1, 1), b3 + hstepB, voffB); PG8_STAGE(PG8_SA(1, 0), a3, voffA);
            PG8_WAIT_V(8); PG8_WAIT_L(0); PG8_BAR; PG8_MMA(1, 0, At, B0); PG8_MMA(1, 1, At, B1); PG8_BAR; PG8_SCHED;
        }
        if (wr == 0) PG8_BAR;
        E(acc, cur, wr, wc, fr, fq);
        if (!has_next) break;
#pragma unroll
        for (int a = 0; a < 2; ++a)
#pragma unroll
            for (int b = 0; b < 2; ++b)
#pragma unroll
                for (int m = 0; m < 4; ++m)
#pragma unroll
                    for (int n = 0; n < 2; ++n) acc[a][b][m][n] = (f32x4){0.f, 0.f, 0.f, 0.f};
        cur = nxt; cA = nA; cB = nB; ++ui;
        if (wr == 1) PG8_BAR;
    }
    PG8_WAIT_V(0);
    PG8_BAR;
#undef PG8_SA
#undef PG8_SB
#undef PG8_STAGE
#undef PG8_LDA
#undef PG8_LDB
#undef PG8_MMA
#undef PG8_WAIT_V
#undef PG8_WAIT_L
#undef PG8_BAR
#undef PG8_SCHED
}
}

namespace att {
constexpr int D = 128, NW = 8, QBLK = 32, KVBLK = 64, LD = DM;
constexpr float SCALE = 0.125f, THR = 8.f;
constexpr size_t SHM_V = KVBLK * D * 2, SHM_K = KVBLK * 64 * 2;
#define KSWZ(row, colB) ((row) * 128 + ((colB) ^ ((((row) >> 1) & 7) << 4)))
#define SBAR() __builtin_amdgcn_sched_barrier(0)
__device__ __forceinline__ int crow(int r, int hi) { return (r & 3) + 8 * (r >> 2) + 4 * hi; }
__device__ __forceinline__ void partialSM(f32x16& p0, f32x16& p1, float mnC) {
    constexpr float C = SCALE * 1.4426950408889634f;
#pragma unroll
    for (int r = 0; r < 16; ++r) p0[r] = fmaf(p0[r], C, mnC);
#pragma unroll
    for (int r = 0; r < 16; ++r) p1[r] = fmaf(p1[r], C, mnC);
#pragma unroll
    for (int r = 0; r < 16; ++r) p0[r] = __builtin_amdgcn_exp2f(p0[r]);
}
__device__ __forceinline__ void finishSM(f32x16& p0, f32x16& p1, float& l_reg, bf16x8& pa0, bf16x8& pa1, bf16x8& pa2, bf16x8& pa3) {
#pragma unroll
    for (int r = 0; r < 16; ++r) p1[r] = __builtin_amdgcn_exp2f(p1[r]);
    float ps = 0;
#pragma unroll
    for (int r = 0; r < 16; ++r) ps += p0[r];
#pragma unroll
    for (int r = 0; r < 16; ++r) ps += p1[r];
    l_reg += ps;
#define PK4(P, BASE, OUT) do { unsigned a0 = cvt_pk_bf16(P[BASE + 0], P[BASE + 1]), a1 = cvt_pk_bf16(P[BASE + 2], P[BASE + 3]);   \
    unsigned b0 = cvt_pk_bf16(P[BASE + 4], P[BASE + 5]), b1 = cvt_pk_bf16(P[BASE + 6], P[BASE + 7]);                              \
    auto r0 = __builtin_amdgcn_permlane32_swap(a0, b0, false, false); auto r1 = __builtin_amdgcn_permlane32_swap(a1, b1, false, false); \
    u32x4 w = {r0[0], r1[0], r0[1], r1[1]}; OUT = *reinterpret_cast<bf16x8*>(&w); } while (0)
    PK4(p0, 0, pa0); PK4(p0, 8, pa1); PK4(p1, 0, pa2); PK4(p1, 8, pa3);
#undef PK4
}
__device__ __forceinline__ void qkt(f32x16& p0, f32x16& p1, const char* Ks, const bf16x8* qr, int r32, int hi) {
    p0 = f32x16{}; p1 = f32x16{};
#pragma unroll
    for (int d0 = 0; d0 < 4; ++d0) { const int cb = (d0 * 16 + hi * 8) * 2;
        const bf16x8 b0 = *reinterpret_cast<const bf16x8*>(Ks + KSWZ(r32, cb));
        const bf16x8 b1 = *reinterpret_cast<const bf16x8*>(Ks + KSWZ(32 + r32, cb));
        p0 = __builtin_amdgcn_mfma_f32_32x32x16_bf16(b0, qr[d0], p0, 0, 0, 0);
        p1 = __builtin_amdgcn_mfma_f32_32x32x16_bf16(b1, qr[d0], p1, 0, 0, 0); }
}
__device__ __forceinline__ int v_st(int k, int c) { const int kk = (k & ~0xC) | ((k & 4) << 1) | ((k & 8) >> 1); return ((kk >> 3) * 4 + (c >> 5)) * 512 + ((kk & 7) * 32 + (c & 31)) * 2; }
__device__ __forceinline__ int v_rd_base(int lane) { return ((lane & 3) << 3) | (((lane >> 2) & 3) << 6) | (((lane >> 4) & 1) << 5) | (((lane >> 5) & 1) << 8); }
constexpr int v_rd_off(int d0, int ks, int half) { return d0 * 512 + ks * 4096 + half * 2048; }
template <int OFF> __device__ __forceinline__ s16x4 tr_read(int vb) {
    s16x4 r; asm volatile("ds_read_b64_tr_b16 %0, %1 offset:%2" : "=&v"(r) : "v"(vb), "i"(OFF) : "memory"); return r;
}
template <int D0> __device__ __forceinline__ void pv_one(f32x16& od, int vb, bf16x8 pa0, bf16x8 pa1, bf16x8 pa2, bf16x8 pa3) {
    const s16x4 l0 = tr_read<v_rd_off(D0, 0, 0)>(vb), h0 = tr_read<v_rd_off(D0, 0, 1)>(vb), l1 = tr_read<v_rd_off(D0, 1, 0)>(vb), h1 = tr_read<v_rd_off(D0, 1, 1)>(vb);
    const s16x4 l2 = tr_read<v_rd_off(D0, 2, 0)>(vb), h2 = tr_read<v_rd_off(D0, 2, 1)>(vb), l3 = tr_read<v_rd_off(D0, 3, 0)>(vb), h3 = tr_read<v_rd_off(D0, 3, 1)>(vb);
    asm volatile("s_waitcnt lgkmcnt(0)" ::: "memory"); SBAR();
#define PK(L, H) (bf16x8){L[0], L[1], L[2], L[3], H[0], H[1], H[2], H[3]}
    od = __builtin_amdgcn_mfma_f32_32x32x16_bf16(pa0, PK(l0, h0), od, 0, 0, 0);
    od = __builtin_amdgcn_mfma_f32_32x32x16_bf16(pa1, PK(l1, h1), od, 0, 0, 0);
    od = __builtin_amdgcn_mfma_f32_32x32x16_bf16(pa2, PK(l2, h2), od, 0, 0, 0);
    od = __builtin_amdgcn_mfma_f32_32x32x16_bf16(pa3, PK(l3, h3), od, 0, 0, 0);
#undef PK
}
__device__ __forceinline__ void pv_d0(f32x16* o, int vb, bf16x8 pa0, bf16x8 pa1, bf16x8 pa2, bf16x8 pa3) {
    pv_one<0>(o[0], vb, pa0, pa1, pa2, pa3); pv_one<1>(o[1], vb, pa0, pa1, pa2, pa3); pv_one<2>(o[2], vb, pa0, pa1, pa2, pa3); pv_one<3>(o[3], vb, pa0, pa1, pa2, pa3);
}

__device__ __forceinline__ void attn_pass(const bf16_t* __restrict__ Qb, const bf16_t* __restrict__ Kh, const bf16_t* __restrict__ Vh, float kmax2, f32x16 (&o)[4], float (&rli)[16], char* lds) {
    int tid = threadIdx.x; asm volatile("" : "+v"(tid));
    const int wid = tid >> 6, lane = tid & 63, r32 = lane & 31, hi = lane >> 5;
    char* V_lds = lds; char* K_lds = lds + 2 * SHM_V;
    float* ws = (float*)(lds + 2 * SHM_V + 2 * SHM_K) + wid * 64; float* li_l = ws;
    float l_reg = 0; bf16x8 qr[4];
#pragma unroll
    for (int d = 0; d < 4; ++d) o[d] = f32x16{};
    const bf16_t* Qw = Qb + (long)(wid * QBLK + r32) * LD + hi * 8;
#pragma unroll
    for (int d0 = 0; d0 < 4; ++d0) qr[d0] = *reinterpret_cast<const bf16x8*>(Qw + d0 * 16);
    float mnC;
    { float qs = 0.f;
#pragma unroll
      for (int d0 = 0; d0 < 4; ++d0)
#pragma unroll
          for (int e = 0; e < 8; ++e) { const float qv = __uint_as_float(((unsigned)(unsigned short)qr[d0][e]) << 16); qs += qv * qv; }
      auto rr = __builtin_amdgcn_permlane32_swap(__float_as_uint(qs), __float_as_uint(qs), false, false);
      qs = __uint_as_float(rr[0]) + __uint_as_float(rr[1]);
      mnC = -fminf(sqrtf(qs * kmax2) * SCALE, 60.0f) * 1.4426950408889634f; }
    const int sr = tid >> 4, sc = (tid & 15) * 8, vst0 = v_st(sr, sc), vst1 = v_st(32 + sr, sc);
    const int kr = tid >> 3, kc = (tid & 7) * 8, kst = KSWZ(kr, kc * 2);
    const int vb0 = (int)(uintptr_t)V_lds + v_rd_base(lane);
    struct { bf16x8 vs0, vs1, ks0; } sr_[2];
#define SLOAD(i, k0) do { sr_[i].vs0 = *reinterpret_cast<const bf16x8*>(&Vh[(long)((k0) + sr) * LD + sc]); sr_[i].vs1 = *reinterpret_cast<const bf16x8*>(&Vh[(long)((k0) + 32 + sr) * LD + sc]); \
    sr_[i].ks0 = *reinterpret_cast<const bf16x8*>(&Kh[(long)((k0) + kr) * LD + kc]); } while (0)
#define SWRITE(b, i) do { *(bf16x8*)(V_lds + (b) * SHM_V + vst0) = sr_[i].vs0; *(bf16x8*)(V_lds + (b) * SHM_V + vst1) = sr_[i].vs1; *(bf16x8*)(K_lds + (b) * SHM_K + kst) = sr_[i].ks0; } while (0)
#define SWAIT() asm volatile("s_waitcnt vmcnt(3)" ::: "memory")
    f32x16 pA0, pA1, pB0, pB1; bf16x8 pa0, pa1, pa2, pa3; const int NT = SEQ / KVBLK;
    constexpr int SE = 0, SO = 1;
    SLOAD(SE, 0); asm volatile("s_waitcnt vmcnt(0)" ::: "memory"); SWRITE(0, SE); __syncthreads();
    qkt(pA0, pA1, K_lds, qr, r32, hi); partialSM(pA0, pA1, mnC);
    SLOAD(SO, KVBLK); SLOAD(SE, 2 * KVBLK);
    SWAIT(); SWRITE(1, SO); __syncthreads();
    for (int j = 1; j + 1 < NT; j += 2) {
        SBAR(); qkt(pB0, pB1, K_lds + SHM_K, qr, r32, hi);
        finishSM(pA0, pA1, l_reg, pa0, pa1, pa2, pa3); SBAR();
        SLOAD(SO, (j + 2) * KVBLK); SBAR();
        pv_d0(o, vb0, pa0, pa1, pa2, pa3); partialSM(pB0, pB1, mnC);
        __syncthreads(); SWAIT(); SWRITE(0, SE);
        __syncthreads();
        SBAR(); qkt(pA0, pA1, K_lds, qr, r32, hi);
        finishSM(pB0, pB1, l_reg, pa0, pa1, pa2, pa3); SBAR();
        if (j + 3 < NT) SLOAD(SE, (j + 3) * KVBLK); SBAR();
        pv_d0(o, vb0 + (int)SHM_V, pa0, pa1, pa2, pa3); partialSM(pA0, pA1, mnC);
        __syncthreads(); SWAIT(); SWRITE(1, SO);
        __syncthreads();
    }
    SBAR(); qkt(pB0, pB1, K_lds + SHM_K, qr, r32, hi);
    finishSM(pA0, pA1, l_reg, pa0, pa1, pa2, pa3); SBAR();
    pv_d0(o, vb0, pa0, pa1, pa2, pa3); partialSM(pB0, pB1, mnC);
    __syncthreads();
    finishSM(pB0, pB1, l_reg, pa0, pa1, pa2, pa3); SBAR();
    pv_d0(o, vb0 + (int)SHM_V, pa0, pa1, pa2, pa3);
    { auto rr = __builtin_amdgcn_permlane32_swap(__float_as_uint(l_reg), __float_as_uint(l_reg), false, false); l_reg = __uint_as_float(rr[0]) + __uint_as_float(rr[1]); }
    if (hi == 0) li_l[r32] = l_reg; asm volatile("s_waitcnt lgkmcnt(0)" ::: "memory");
#pragma unroll
    for (int r = 0; r < 16; ++r) rli[r] = __builtin_amdgcn_rcpf(li_l[crow(r, hi)]);
    __syncthreads();
#undef SLOAD
#undef SWRITE
#undef SWAIT
}

__device__ __forceinline__ void attn_unit(int b, int h, int qb, const bf16_t* Q, const bf16_t* K, const bf16_t* V, bf16_t* O, float* scr, const unsigned* kmax2, float lam, float onem, const float* subw, char* lds) {
    int tid = threadIdx.x; asm volatile("" : "+v"(tid));
    const int wid = tid >> 6, lane = tid & 63, r32 = lane & 31, hi = lane >> 5;
    asm volatile("" : "+s"(Q), "+s"(K), "+s"(V), "+s"(O), "+s"(scr), "+s"(kmax2), "+s"(subw));
    const size_t rowbase = (size_t)b * SEQ;
    f32x16 o[4]; float rli[16];
#pragma unroll 1
    for (int pass = 0; pass < 2; ++pass) {
        const int sub = 2 * h + pass;
        attn_pass(Q + (rowbase + (size_t)qb * 256) * LD + sub * 64, K + rowbase * LD + sub * 64, V + rowbase * LD + h * 128, __uint_as_float(kmax2[b * 16 + sub]), o, rli, lds);
        int t2 = tid; asm volatile("" : "+v"(t2));
        const int lane2 = t2 & 63, r32b = lane2 & 31, hib = lane2 >> 5, wid2 = t2 >> 6;
        float* sp = scr + (size_t)t2 * 64;
        if (pass == 0) {
#pragma unroll
            for (int d0 = 0; d0 < 4; ++d0)
#pragma unroll
                for (int r4 = 0; r4 < 4; ++r4) *(f32x4*)(sp + d0 * 16 + r4 * 4) = (f32x4){o[d0][4 * r4] * rli[4 * r4], o[d0][4 * r4 + 1] * rli[4 * r4 + 1], o[d0][4 * r4 + 2] * rli[4 * r4 + 2], o[d0][4 * r4 + 3] * rli[4 * r4 + 3]};
        } else {
            float ss[16];
#pragma unroll
            for (int r = 0; r < 16; ++r) ss[r] = 0.f;
#pragma unroll
            for (int d0 = 0; d0 < 4; ++d0)
#pragma unroll
                for (int r4 = 0; r4 < 4; ++r4) { const f32x4 o1 = *(const f32x4*)(sp + d0 * 16 + r4 * 4);
#pragma unroll
                    for (int q = 0; q < 4; ++q) { const int r = 4 * r4 + q; const float v = o1[q] - lam * (o[d0][r] * rli[r]); o[d0][r] = v; ss[r] += v * v; } }
#pragma unroll
            for (int r = 0; r < 16; ++r) {
#pragma unroll
                for (int x = 1; x < 32; x <<= 1) ss[r] += shfl_xor_l(ss[r], x, lane2);
                ss[r] = rsqrtf(ss[r] * (1.0f / 128.0f) + 1e-5f) * onem; }
            bf16_t* Ow = O + (rowbase + (size_t)qb * 256 + wid2 * QBLK + 4 * hib) * LD + h * 128 + r32b;
#pragma unroll
            for (int d0 = 0; d0 < 4; ++d0) { const float sw = subw[d0 * 32 + r32b];
#pragma unroll
                for (int r = 0; r < 16; ++r) { const unsigned w = cvt_pk_bf16(o[d0][r] * ss[r] * sw, 0.f); Ow[(size_t)((r & 3) + 8 * (r >> 2)) * LD + d0 * 32] = (bf16_t)(w & 0xffffu); } }
        }
    }
}
#undef SBAR
}

__device__ __forceinline__ void transpose_item(const float* W, const float* W2, int K, int ldw, int coff, int sel, int ndst, bf16_t* WT, LAS float* scr, int item, int lane) {
    const int nblk = ndst / 32, kb = item / nblk, nb = item % nblk, k0 = 64 * kb, n0 = 32 * nb;
    const int nd = n0 + (lane & 31); int sc = nd + coff; const float* Wp = W;
    if (sel == 1 && nd < 2048) { const int j = nd & 63; sc = (nd & ~63) + (j & 1) * 32 + (j >> 1); }
    if (sel == 2) { sc = (nd >> 5) * 16 + (nd & 15); if ((nd >> 4) & 1) Wp = W2; }
#pragma unroll 8
    for (int i = 0; i < 32; ++i) { const int kk = 2 * i + (lane >> 5); scr[kk * 33 + (lane & 31)] = Wp[(size_t)(k0 + kk) * ldw + sc]; }
    asm volatile("s_waitcnt lgkmcnt(0)" ::: "memory");
    const int c = lane & 7;
#pragma unroll
    for (int j = 0; j < 4; ++j) { const int n = (lane >> 3) + 8 * j; const LAS float* s = scr + (8 * c) * 33 + n;
        u32x4 o; o.x = cvt_pk_bf16(s[0 * 33], s[1 * 33]); o.y = cvt_pk_bf16(s[2 * 33], s[3 * 33]); o.z = cvt_pk_bf16(s[4 * 33], s[5 * 33]); o.w = cvt_pk_bf16(s[6 * 33], s[7 * 33]);
        *(u32x4*)(WT + (size_t)(n0 + n) * K + k0 + 8 * c) = o; }
    asm volatile("s_waitcnt lgkmcnt(0)" ::: "memory");
}

__device__ __forceinline__ void norm_rows(const float* xin, const float* nw, const float* mod_l, int mod_off, bf16_t* XN, float* fout, int gw, int NGW, int lane) {
    for (int m0 = gw; m0 < T; m0 += 2 * NGW) {
        const int m1 = m0 + NGW;
        const bool has1 = m1 < T; const int m1c = has1 ? m1 : m0;
        const f32x4* x0 = (const f32x4*)(xin + (size_t)m0 * DM) + lane; const f32x4* x1 = (const f32x4*)(xin + (size_t)m1c * DM) + lane;
        f32x4 v[2][4]; float s0 = 0.f, s1 = 0.f;
#pragma unroll
        for (int j = 0; j < 4; ++j) { v[0][j] = x0[64 * j]; v[1][j] = x1[64 * j]; }
#pragma unroll
        for (int j = 0; j < 4; ++j) { s0 += (v[0][j][0] * v[0][j][0] + v[0][j][1] * v[0][j][1]) + (v[0][j][2] * v[0][j][2] + v[0][j][3] * v[0][j][3]);
                                      s1 += (v[1][j][0] * v[1][j][0] + v[1][j][1] * v[1][j][1]) + (v[1][j][2] * v[1][j][2] + v[1][j][3] * v[1][j][3]); }
        const float r0 = rsqrtf(wave_sum(s0, lane) * (1.0f / DM) + 1e-6f), r1 = rsqrtf(wave_sum(s1, lane) * (1.0f / DM) + 1e-6f);
#pragma unroll
        for (int k = 0; k < 2; ++k) {
            if (k == 1 && !has1) break;
            const int m = k == 0 ? m0 : m1; const float r = k == 0 ? r0 : r1;
#pragma unroll
            for (int j = 0; j < 4; ++j) { const int col = lane * 4 + 256 * j; const f32x4 w4 = *(const f32x4*)(nw + col);
                if (mod_l) { const float* md = mod_l + (size_t)(m >> 12) * 6144 + mod_off; const f32x4 sh = *(const f32x4*)(md + col), sc = *(const f32x4*)(md + 1024 + col);
                    const f32x4 hv = v[k][j] * r * w4 * (sc + 1.0f) + sh; u32x2 w; w.x = cvt_pk_bf16(hv[0], hv[1]); w.y = cvt_pk_bf16(hv[2], hv[3]); *(u32x2*)(XN + (size_t)m * DM + col) = w; }
                else *(f32x4*)(fout + (size_t)m * DM + col) = v[k][j] * r * w4; }
        }
    }
}

#define XB_TMO      128
#define XB_XCNT(j)  (256  + 64 * (j))
#define XB_XSUB(j)  (1280 + 64 * (j))
#define XB_XGEN(j)  (2304 + 64 * (j))
#define XB_TOP      3328
#define XB_TOPGEN   3392
#define XCD_BAR_WORDS 3456
#define XB_SPIN_CAP (1u << 22)
__device__ __forceinline__ unsigned xb_ld(unsigned* p)              { return __hip_atomic_load(p, __ATOMIC_RELAXED, __HIP_MEMORY_SCOPE_AGENT); }
__device__ __forceinline__ unsigned xb_add(unsigned* p, unsigned v) { return __hip_atomic_fetch_add(p, v, __ATOMIC_RELAXED, __HIP_MEMORY_SCOPE_AGENT); }
__device__ __forceinline__ unsigned xb_xcc_id() { return (unsigned)__builtin_amdgcn_s_getreg((3 << 11) | 20) & 0xFu; }
#define XB_SPIN(cond, bar) do { unsigned _sp = 0; while (cond) { __builtin_amdgcn_s_sleep(1); \
    if ((++_sp & 255u) == 0u) { if (xb_ld(&(bar)[XB_TMO])) break; if (_sp > XB_SPIN_CAP) { atomicAdd(&(bar)[XB_TMO], 1u); break; } } } } while (0)
struct XcdBarrier { unsigned* bar; unsigned x; volatile LAS unsigned* st; };
__device__ __forceinline__ void xcd_barrier_complete(unsigned* bar, unsigned x, unsigned& nloc, unsigned& nx) {
    const unsigned G = gridDim.x * gridDim.y * gridDim.z;
    unsigned sum, cnt, mine, sp = 0u;
    for (;;) {
        sum = 0u; cnt = 0u; mine = 0u;
#pragma unroll
        for (unsigned j = 0; j < 16; ++j) { const unsigned c = xb_ld(&bar[XB_XCNT(j)]); sum += c; cnt += (c > 0u) ? 1u : 0u; mine = (j == x) ? c : mine; }
        if (sum == G) break;
        __builtin_amdgcn_s_sleep(1);
        if ((++sp & 255u) == 0u) { if (xb_ld(&bar[XB_TMO])) break; if (sp > XB_SPIN_CAP) { atomicAdd(&bar[XB_TMO], 1u); break; } }
    }
    nloc = mine > 0u ? mine : 1u; nx = cnt > 0u ? cnt : 1u;
}
__device__ __forceinline__ void xcd_barrier(const XcdBarrier& b) {
    asm volatile("s_waitcnt vmcnt(0)" ::: "memory");
    __syncthreads();
    if (threadIdx.x == 0) {
        unsigned* bar = b.bar;
        __builtin_amdgcn_s_waitcnt(0);
        unsigned nloc = b.st[0], nx = b.st[1];
        if (nloc == 0u) { xcd_barrier_complete(bar, b.x, nloc, nx); b.st[0] = nloc; b.st[1] = nx; }
        const unsigned old = xb_add(&bar[XB_XSUB(b.x)], 1u);
        const unsigned gen = old / nloc;
        if (old + 1u == (gen + 1u) * nloc) {
            __builtin_amdgcn_fence(__ATOMIC_RELEASE, "agent");
            asm volatile("s_waitcnt vmcnt(0)" ::: "memory");
            const unsigned og = xb_add(&bar[XB_TOP], 1u);
            const unsigned tg = og / nx;
            if (og + 1u == (tg + 1u) * nx) xb_add(&bar[XB_TOPGEN], 1u);
            else XB_SPIN(xb_ld(&bar[XB_TOPGEN]) == tg, bar);
            __builtin_amdgcn_fence(__ATOMIC_ACQUIRE, "agent");
            xb_add(&bar[XB_XGEN(b.x)], 1u);
            asm volatile("s_waitcnt vmcnt(0)" ::: "memory");
        } else {
            XB_SPIN(xb_ld(&bar[XB_XGEN(b.x)]) == gen, bar);
            __builtin_amdgcn_fence(__ATOMIC_ACQUIRE, "agent");
            asm volatile("s_waitcnt vmcnt(0)" ::: "memory");
        }
    }
    __syncthreads();
}

__global__ void __launch_bounds__(NTHR, 2) mega(Params P) {
    extern __shared__ __attribute__((aligned(16))) unsigned char lds_raw[];
    cg::grid_group grid = cg::this_grid();
    LAS unsigned char* lds = (LAS unsigned char*)lds_raw;
    const int G0 = gridDim.x, bx0 = blockIdx.x;
    float* xo = P.out;
    { unsigned* bw = (unsigned*)P.ws; if (bx0 == 0) for (int i = threadIdx.x; i < XCD_BAR_WORDS; i += NTHR) __hip_atomic_store(bw + i, 0u, __ATOMIC_RELAXED, __HIP_MEMORY_SCOPE_AGENT);
      if (threadIdx.x < 2) ((volatile LAS unsigned*)(lds + LDS_BYTES - 64))[threadIdx.x] = 0u; }
    __threadfence();
    grid.sync();
    XcdBarrier xbar; xbar.bar = (unsigned*)P.ws; xbar.x = xb_xcc_id(); xbar.st = (volatile LAS unsigned*)(lds + LDS_BYTES - 64);
    if (threadIdx.x == 0) (void)xb_add(&xbar.bar[XB_XCNT(xbar.x)], 1u);
#define GRID_BAR() xcd_barrier(xbar)
#define PH_INIT unsigned char* ws = P.ws; int tid = threadIdx.x; int L = l; int G = G0, bx = bx0; asm volatile("" : "+s"(ws), "+s"(L), "+s"(G), "+s"(bx)); asm volatile("" : "+v"(tid)); \
    const int vcu = (G % 8 == 0) ? (bx % 8) * (G / 8) + bx / 8 : bx; const int NGW = G * NWAVES; const long NGT = (long)G * NTHR; (void)NGW; (void)NGT; \
    const int lane = tid & 63, wave = __builtin_amdgcn_readfirstlane(tid >> 6); const int gw = vcu * NWAVES + wave; const long gtid = (long)vcu * NTHR + tid; (void)lane; (void)gw; (void)gtid; \
    float* MOD = (float*)(ws + WS_MOD); float* ROPE = (float*)(ws + WS_ROPE); f32x2* PW = (f32x2*)(ws + WS_PW); f32x2* BB = (f32x2*)(ws + WS_BB); float* KM = (float*)(ws + WS_KM); \
    bf16_t* WQKVU = (bf16_t*)(ws + WS_WQKVU); bf16_t* WG = (bf16_t*)(ws + WS_WG); bf16_t* WAO = (bf16_t*)(ws + WS_WAO); bf16_t* WGLU = (bf16_t*)(ws + WS_WGLU); \
    bf16_t* WOUT = (bf16_t*)(ws + WS_WOUT); bf16_t* WUP = (bf16_t*)(ws + WS_WUP); bf16_t* WDOWN = (bf16_t*)(ws + WS_WDOWN); \
    bf16_t* TMAT = (bf16_t*)(ws + WS_TMAT); bf16_t* EMAT = (bf16_t*)(ws + WS_EMAT); bf16_t* XN = (bf16_t*)(ws + WS_XN); \
    bf16_t* QB = (bf16_t*)(ws + WS_Q); bf16_t* KB = (bf16_t*)(ws + WS_K); bf16_t* VB = (bf16_t*)(ws + WS_V); bf16_t* UEXT = (bf16_t*)(ws + WS_UEXT); \
    float* XLOC = (float*)(ws + WS_XLOC); bf16_t* YB = (bf16_t*)(ws + WS_XLOC); float* SCR = (float*)(ws + WS_SCR); \
    bf16_t* UPH = (bf16_t*)(ws + WS_UP); bf16_t* ACT = (bf16_t*)(ws + WS_ACT); \
    (void)MOD; (void)ROPE; (void)PW; (void)BB; (void)KM; (void)WQKVU; (void)WG; (void)WAO; (void)WGLU; (void)WOUT; (void)WUP; (void)WDOWN; (void)TMAT; (void)EMAT; (void)XN; (void)QB; (void)KB; (void)VB; (void)UEXT; (void)XLOC; (void)YB; (void)SCR; (void)UPH; (void)ACT
#define MAKE_E pg8::Epi E{}; E.layer = L; E.Q = QB; E.Kb = KB; E.Vb = VB; E.Uext = UEXT; E.Y = YB; E.UPh = UPH; E.xloc = XLOC; E.rope = ROPE; E.xout = xo

#define RUN_GEMM(A_, Bt_, lda_, ldb_, K_, nM_, nN_, ngrp_, epi_) do { pg8::Gemm g_{A_, Bt_, lda_, ldb_, K_, nM_, nN_, ngrp_}; pg8::Order S_; S_.init(g_, G, bx); pg8::gemm_phase(lds, g_, S_, epi_); } while (0)

#pragma unroll 1
    for (int l = 0; l < 2; ++l) {
        const float lambda_init = (l == 0) ? 0.2f : 0.35550906759f;
        {
            PH_INIT;
            LAS float* scr = (LAS float*)(lds + wave * 16384);
            const int I1 = 16 * 112, I2 = 16 * 64, I3 = 16 * 32, I4 = 8 * 64, I5 = 16 * 32, I6 = 16 * 176, I7 = 44 * 32, NI = I1 + I2 + I3 + I4 + I5 + I6 + I7;
            const float* win = P.in[I_WIN] + (size_t)L * DM * 5632;
            for (int it = gw; it < NI; it += NGW) {
                int r = it;
                if (r < I1) { transpose_item(win, nullptr, 1024, 5632, 0, 1, 3584, WQKVU, scr, r, lane); continue; } r -= I1;
                if (r < I2) { transpose_item(win, nullptr, 1024, 5632, 3584, 0, 2048, WG, scr, r, lane); continue; } r -= I2;
                if (r < I3) { transpose_item(P.in[I_WAO] + (size_t)L * DM * DM, nullptr, 1024, 1024, 0, 0, 1024, WAO, scr, r, lane); continue; } r -= I3;
                if (r < I4) { transpose_item(P.in[I_WGA] + (size_t)L * 512 * DM, P.in[I_WGB] + (size_t)L * 512 * DM, 512, 1024, 0, 2, 2048, WGLU, scr, r, lane); continue; } r -= I4;
                if (r < I5) { transpose_item(P.in[I_WOUT] + (size_t)L * DM * DM, nullptr, 1024, 1024, 0, 0, 1024, WOUT, scr, r, lane); continue; } r -= I5;
                if (r < I6) { transpose_item(P.in[I_WUP] + (size_t)L * DM * NUP, nullptr, 1024, NUP, 0, 0, NUP, WUP, scr, r, lane); continue; } r -= I6;
                transpose_item(P.in[I_WDOWN] + (size_t)L * DFF * DM, nullptr, DFF, 1024, 0, 0, 1024, WDOWN, scr, r, lane);
            }
            for (long i = gtid; i < 2 * 32 * 33 * 64; i += NGT) {
                const int p = (int)(i & 63); const int tau = (int)((i >> 6) % 33); const int dg = (int)(i / (64 * 33));
                const size_t li = ((size_t)L * 64 + dg) * 64 + p; const float lr = P.in[I_SLRE][li], lim = P.in[I_SLIM][li]; const float dt = expf(P.in[I_SLDT][L * 64 + dg]);
                const float mag = expf(lr * dt * (float)tau), ang = (lim * dt) * (float)tau;
                PW[i] = (f32x2){mag * cosf(ang), mag * sinf(ang)};
            }
            for (long i = gtid; i < 2 * 32 * 64 * 16; i += NGT) {
                const int p = (int)((i >> 4) & 63); const int dg = (int)(i >> 10);
                const size_t li = ((size_t)L * 64 + dg) * 64 + p; const float lr = P.in[I_SLRE][li], lim = P.in[I_SLIM][li]; const float dt = expf(P.in[I_SLDT][L * 64 + dg]);
                const float mag = expf(lr * dt), ang = lim * dt; const float ar = mag * cosf(ang), ai = mag * sinf(ang);
                const float den = lr * lr + lim * lim, nr = ar - 1.0f, ni_ = ai;
                const float fre = (nr * lr + ni_ * lim) / den, fim = (ni_ * lr - nr * lim) / den;
                const size_t bi = (size_t)L * 2 * 32 * 64 * 16 + i; const float br = P.in[I_SBRE][bi], bim = P.in[I_SBIM][bi];
                BB[i] = (f32x2){fre * br - fim * bim, fre * bim + fim * br};
            }
            if (L == 0) {
                for (long i = gtid; i < SEQ * 32; i += NGT) { const int s = (int)(i >> 5), f = (int)(i & 31);
                    const float inv = powf(10000.0f, -(float)f / 32.0f); const float ang = (float)s * inv; ROPE[2 * i] = cosf(ang); ROPE[2 * i + 1] = sinf(ang); }
                LAS float* cact = (LAS float*)lds; LAS float* red = (LAS float*)(lds + 32768);
                __syncthreads();
                for (int it = bx; it < 192; it += G) {
                    const int ll = it / 96, j0 = (it % 96) * 64;
                    for (int i = tid; i < NB * DM; i += NTHR) { const float cv = P.in[I_C][i]; cact[i] = cv / (1.0f + expf(-cv)); }
                    __syncthreads();
                    float a[NB];
#pragma unroll
                    for (int b = 0; b < NB; ++b) a[b] = 0.f;
                    const float* aw = P.in[I_ADAW] + (size_t)ll * DM * 6144 + j0 + lane;
                    for (int k = wave * 128; k < wave * 128 + 128; ++k) { const float wv = aw[(size_t)k * 6144];
#pragma unroll
                        for (int b = 0; b < NB; ++b) a[b] += cact[b * DM + k] * wv; }
#pragma unroll
                    for (int b = 0; b < NB; ++b) red[(wave * NB + b) * 64 + lane] = a[b];
                    __syncthreads();
                    { const int b = tid >> 6; float s = P.in[I_ADAB][ll * 6144 + j0 + lane];
#pragma unroll
                      for (int w = 0; w < NWAVES; ++w) s += red[(w * NB + b) * 64 + lane];
                      MOD[((size_t)ll * NB + b) * 6144 + j0 + lane] = s; }
                    __syncthreads();
                }
            }
        }
        GRID_BAR();
        {
            PH_INIT;
            const float* xin = (L == 0) ? P.in[I_X] : xo; const float* nw = P.in[I_N1W] + L * DM;
            norm_rows(xin, nw, MOD + (size_t)L * NB * 6144, 0, XN, nullptr, gw, NGW, lane);
            if (gtid < 128) ((unsigned*)(ws + WS_KMAX))[gtid] = 0u;
            for (long i = gtid; i < 2 * 32 * 32 * 256; i += NGT) {
                const int ni = (int)(i & 15), no = (int)((i >> 4) & 15), tau = (int)((i >> 8) & 31), dg = (int)(i >> 13);
                const float* cre = P.in[I_SCRE] + (((size_t)L * 64 + dg) * 16 + no) * 64; const float* cim = P.in[I_SCIM] + (((size_t)L * 64 + dg) * 16 + no) * 64;
                const f32x2* pw = PW + ((size_t)dg * 33 + tau) * 64; const f32x2* bb = BB + (size_t)dg * 1024 + ni; float acc = 0.f;
                for (int p = 0; p < 64; ++p) { const f32x2 w = pw[p], bv = bb[p * 16]; const float cr = cre[p], ci = cim[p]; const float zr = cr * w.x - ci * w.y, zi = cr * w.y + ci * w.x; acc += zr * bv.x - zi * bv.y; }
                KM[i] = acc;
            }
            for (long i = gtid; i < 32 * 256 * 64; i += NGT) {
                const int k8 = (int)(i & 63), n = (int)((i >> 6) & 255), g = (int)(i >> 14); const int dir = n >> 7, ri = (n >> 6) & 1, p = n & 63; const int s = k8 >> 1, ni0 = (k8 & 1) * 8;
                const int e = dir == 0 ? (CH - 1 - s) : s; const f32x2 w = PW[((size_t)(dir * 32 + g) * 33 + e) * 64 + p]; const f32x2* bb = BB + ((size_t)(dir * 32 + g) * 64 + p) * 16 + ni0;
                float o[8];
#pragma unroll
                for (int q = 0; q < 8; ++q) { const f32x2 bv = bb[q]; o[q] = ri == 0 ? (w.x * bv.x - w.y * bv.y) : (w.x * bv.y + w.y * bv.x); }
                u32x4 ov; ov.x = cvt_pk_bf16(o[0], o[1]); ov.y = cvt_pk_bf16(o[2], o[3]); ov.z = cvt_pk_bf16(o[4], o[5]); ov.w = cvt_pk_bf16(o[6], o[7]);
                *(u32x4*)(EMAT + ((size_t)g * 256 + n) * 512 + k8 * 8) = ov;
            }
            for (long i = gtid; i < 32 * 512 * 32; i += NGT) {
                const int c8 = (int)(i & 31), n = (int)((i >> 5) & 511), g = (int)(i >> 14); const int t = n >> 4, no = n & 15; const int dir = c8 >> 4, ri = (c8 >> 3) & 1, p0 = (c8 & 7) * 8;
                const int e = dir == 0 ? (t + 1) : (CH - t); const f32x2* pw = PW + ((size_t)(dir * 32 + g) * 33 + e) * 64 + p0;
                const float* cre = P.in[I_SCRE] + ((((size_t)L * 2 + dir) * 32 + g) * 16 + no) * 64 + p0; const float* cim = P.in[I_SCIM] + ((((size_t)L * 2 + dir) * 32 + g) * 16 + no) * 64 + p0;
                float o[8];
#pragma unroll
                for (int q = 0; q < 8; ++q) { const f32x2 w = pw[q]; const float cr = cre[q], ci = cim[q]; o[q] = ri == 0 ? (cr * w.x - ci * w.y) : -(cr * w.y + ci * w.x); }
                u32x4 ov; ov.x = cvt_pk_bf16(o[0], o[1]); ov.y = cvt_pk_bf16(o[2], o[3]); ov.z = cvt_pk_bf16(o[4], o[5]); ov.w = cvt_pk_bf16(o[6], o[7]);
                *(u32x4*)(TMAT + ((size_t)g * 512 + n) * KX + 512 + c8 * 8) = ov;
            }
        }
        GRID_BAR();
        { PH_INIT; MAKE_E; E.mode = 1; RUN_GEMM(XN, WQKVU, 1024, 1024, 1024, 128, 14, 1, E); }
        GRID_BAR();
        { PH_INIT; MAKE_E; E.mode = 2; RUN_GEMM(UEXT, EMAT, KX, 512, 512, 4, 1, 32, E); }
        {
            PH_INIT;
            const float* dsk = P.in[I_SD] + L * 512;
            { LAS float* red = (LAS float*)lds; unsigned* kmx = (unsigned*)(ws + WS_KMAX);
              for (int blk = vcu; blk < T / 128; blk += G) {
                  float mx = 0.f;
#pragma unroll 4
                  for (int k = 0; k < 16; ++k) { const int m = blk * 128 + wave * 16 + k; const u32x4* kp = (const u32x4*)(KB + (size_t)m * DM + lane * 16); const u32x4 a = kp[0], b2 = kp[1]; float ss = 0.f;
#pragma unroll
                      for (int q = 0; q < 4; ++q) { ss += bf_lo(a[q]) * bf_lo(a[q]) + bf_hi(a[q]) * bf_hi(a[q]) + bf_lo(b2[q]) * bf_lo(b2[q]) + bf_hi(b2[q]) * bf_hi(b2[q]); }
                      ss += shfl_xor_l(ss, 1, lane); ss += shfl_xor_l(ss, 2, lane); mx = fmaxf(mx, ss); }
                  __syncthreads();
                  if ((lane & 3) == 0) red[wave * 16 + (lane >> 2)] = mx;
                  __syncthreads();
                  if (tid < 16) { float m2 = red[tid];
#pragma unroll
                      for (int w = 1; w < NWAVES; ++w) m2 = fmaxf(m2, red[w * 16 + tid]);
                      __hip_atomic_fetch_max(kmx + (blk >> 5) * 16 + tid, __float_as_uint(m2), __ATOMIC_RELAXED, __HIP_MEMORY_SCOPE_AGENT); }
              }
              __syncthreads(); }
            for (long i = gtid; i < 32 * 512 * 64; i += NGT) {
                const int k8 = (int)(i & 63), n = (int)((i >> 6) & 511), g = (int)(i >> 15); const int t = n >> 4, no = n & 15, s = k8 >> 1, ni0 = (k8 & 1) * 8;
                float o[8];
                if (t != s) { const int dir = t > s ? 0 : 1, tau = t > s ? t - s : s - t; const float* km = KM + ((((size_t)(dir * 32 + g)) * 32 + tau) * 16 + no) * 16 + ni0;
#pragma unroll
                    for (int q = 0; q < 8; ++q) o[q] = km[q];
                } else { const float* k0 = KM + (((size_t)(g) * 32) * 16 + no) * 16 + ni0; const float* k1 = KM + (((size_t)(32 + g) * 32) * 16 + no) * 16 + ni0;
#pragma unroll
                    for (int q = 0; q < 8; ++q) o[q] = k0[q] + k1[q] + ((ni0 + q) == no ? dsk[g * 16 + no] : 0.f);
                }
                u32x4 ov; ov.x = cvt_pk_bf16(o[0], o[1]); ov.y = cvt_pk_bf16(o[2], o[3]); ov.z = cvt_pk_bf16(o[4], o[5]); ov.w = cvt_pk_bf16(o[6], o[7]);
                *(u32x4*)(TMAT + ((size_t)g * 512 + n) * KX + k8 * 8) = ov;
            }
        }
        GRID_BAR();
        {
            PH_INIT;
            const long i = gtid;
            if (i < 32 * NB * 2 * 64) {
                const int p = (int)(i & 63), dir = (int)((i >> 6) & 1), b = (int)((i >> 7) & 7), g = (int)(i >> 10);
                const f32x2 al = PW[((size_t)(dir * 32 + g) * 33 + CH) * 64 + p];
                float xr = 0.f, xi = 0.f;
                const float* xl = XLOC + ((size_t)g * (NB * NCH) + b * NCH) * 256 + dir * 128 + p;
                bf16_t* ue = UEXT + ((size_t)g * (NB * NCH) + b * NCH) * KX + 512 + dir * 128 + p;
#pragma unroll 1
                for (int cb0 = 0; cb0 < NCH; cb0 += 16) {
                    float lr[16], li[16];
#pragma unroll
                    for (int q = 0; q < 16; ++q) { const int c = dir == 0 ? cb0 + q : NCH - 1 - cb0 - q; lr[q] = xl[(size_t)c * 256]; li[q] = xl[(size_t)c * 256 + 64]; }
#pragma unroll
                    for (int q = 0; q < 16; ++q) { const int c = dir == 0 ? cb0 + q : NCH - 1 - cb0 - q;
                        ue[(size_t)c * KX] = (bf16_t)(cvt_pk_bf16(xr, 0.f) & 0xffffu); ue[(size_t)c * KX + 64] = (bf16_t)(cvt_pk_bf16(xi, 0.f) & 0xffffu);
                        const float nr = al.x * xr - al.y * xi + lr[q], nim = al.x * xi + al.y * xr + li[q]; xr = nr; xi = nim; }
                }
            }
        }
        GRID_BAR();
        {
            PH_INIT;
            float s1 = wave_sum(P.in[I_LQ1][L * 64 + lane] * P.in[I_LK1][L * 64 + lane], lane), s2 = wave_sum(P.in[I_LQ2][L * 64 + lane] * P.in[I_LK2][L * 64 + lane], lane);
            const float lam = expf(s1) - expf(s2) + lambda_init;
            for (int i = 0; i < 4; ++i) { const int u = i * G + vcu; if (u >= 1024) break; const int bh = u >> 4, qb = u & 15;
                att::attn_unit(bh >> 3, bh & 7, qb, QB, KB, VB, QB, SCR + (size_t)bx * 32768, (const unsigned*)(ws + WS_KMAX), lam, 1.0f - lambda_init, P.in[I_SUBW] + L * 128, (char*)lds_raw); }
            __syncthreads();
        }
        { PH_INIT; MAKE_E; E.mode = 3; RUN_GEMM(UEXT, TMAT, KX, KX, KX, 4, 2, 32, E); }
        GRID_BAR();
        { PH_INIT; MAKE_E; E.mode = 4; RUN_GEMM(XN, WG, 1024, 1024, 1024, 128, 8, 1, E); }
        GRID_BAR();
        { PH_INIT; MAKE_E; E.mode = 5; RUN_GEMM(YB, WGLU, 512, 512, 512, 128, 8, 1, E); }
        GRID_BAR();
        { PH_INIT; MAKE_E; E.mode = 6; RUN_GEMM(QB, WAO, 1024, 1024, 1024, 128, 4, 1, E); }
        GRID_BAR();
        { PH_INIT; MAKE_E; E.mode = 7; E.gate = MOD + (size_t)L * NB * 6144 + 2048; E.base = (L == 0) ? P.in[I_X] : xo; RUN_GEMM(KB, WOUT, 1024, 1024, 1024, 128, 4, 1, E); }
        GRID_BAR();
        {
            PH_INIT;
            const float* nw = P.in[I_N2W] + L * DM;
            norm_rows(xo, nw, MOD + (size_t)L * NB * 6144, 3072, XN, nullptr, gw, NGW, lane);
        }
        GRID_BAR();
#pragma unroll 1
        for (int hf = 0; hf < 2; ++hf) {
            { PH_INIT; MAKE_E; E.mode = 8; RUN_GEMM(XN + (size_t)hf * 16384 * DM, WUP, 1024, 1024, 1024, 64, 22, 1, E); }
            GRID_BAR();
            {
                PH_INIT;
                const float* cw = P.in[I_CONVW] + (size_t)L * 3 * NUP; const float* cb = P.in[I_CONVB] + (size_t)L * NUP;
                for (long it = gtid; it < 2048L * 352; it += NGT) {
                    const int rb = (int)(it / 352), jc = (int)(it % 352), j = jc * 8, r0 = rb * 8;
                    const u32x4 z4 = (u32x4){0u, 0u, 0u, 0u};
                    u32x4 rv[10], rg[10];
                    const bf16_t* up0 = UPH + (size_t)r0 * NUP + j;
                    if ((r0 & (SEQ - 1)) != 0) { rv[0] = *(const u32x4*)(up0 - NUP); rg[0] = *(const u32x4*)(up0 - NUP + DFF); } else { rv[0] = z4; rg[0] = z4; }
#pragma unroll
                    for (int q = 0; q < 8; ++q) { rv[q + 1] = *(const u32x4*)(up0 + (size_t)q * NUP); rg[q + 1] = *(const u32x4*)(up0 + (size_t)q * NUP + DFF); }
                    if (((r0 + 8) & (SEQ - 1)) != 0) { rv[9] = *(const u32x4*)(up0 + (size_t)8 * NUP); rg[9] = *(const u32x4*)(up0 + (size_t)8 * NUP + DFF); } else { rv[9] = z4; rg[9] = z4; }
                    float wv[3][8], wg[3][8], bv[8], bg[8];
#pragma unroll
                    for (int k = 0; k < 3; ++k) { const f32x4 a0 = *(const f32x4*)(cw + k * NUP + j), a1 = *(const f32x4*)(cw + k * NUP + j + 4), g0 = *(const f32x4*)(cw + k * NUP + DFF + j), g1 = *(const f32x4*)(cw + k * NUP + DFF + j + 4);
#pragma unroll
                        for (int q = 0; q < 4; ++q) { wv[k][q] = a0[q]; wv[k][q + 4] = a1[q]; wg[k][q] = g0[q]; wg[k][q + 4] = g1[q]; } }
                    { const f32x4 a0 = *(const f32x4*)(cb + j), a1 = *(const f32x4*)(cb + j + 4), g0 = *(const f32x4*)(cb + DFF + j), g1 = *(const f32x4*)(cb + DFF + j + 4);
#pragma unroll
                      for (int q = 0; q < 4; ++q) { bv[q] = a0[q]; bv[q + 4] = a1[q]; bg[q] = g0[q]; bg[q + 4] = g1[q]; } }
                    bf16_t* ao = ACT + ((size_t)hf * 16384 + r0) * DFF + j;
#pragma unroll
                    for (int r = 0; r < 8; ++r) {
                        float o[8];
#pragma unroll
                        for (int q2 = 0; q2 < 4; ++q2) {
                            const float v0 = wv[0][2 * q2] * bf_lo(rv[r][q2]) + wv[1][2 * q2] * bf_lo(rv[r + 1][q2]) + wv[2][2 * q2] * bf_lo(rv[r + 2][q2]) + bv[2 * q2];
                            const float v1 = wv[0][2 * q2 + 1] * bf_hi(rv[r][q2]) + wv[1][2 * q2 + 1] * bf_hi(rv[r + 1][q2]) + wv[2][2 * q2 + 1] * bf_hi(rv[r + 2][q2]) + bv[2 * q2 + 1];
                            const float g0 = wg[0][2 * q2] * bf_lo(rg[r][q2]) + wg[1][2 * q2] * bf_lo(rg[r + 1][q2]) + wg[2][2 * q2] * bf_lo(rg[r + 2][q2]) + bg[2 * q2];
                            const float g1 = wg[0][2 * q2 + 1] * bf_hi(rg[r][q2]) + wg[1][2 * q2 + 1] * bf_hi(rg[r + 1][q2]) + wg[2][2 * q2 + 1] * bf_hi(rg[r + 2][q2]) + bg[2 * q2 + 1];
                            o[2 * q2] = g0 * sigmoidf_(g0) * v0; o[2 * q2 + 1] = g1 * sigmoidf_(g1) * v1;
                        }
                        u32x4 ov; ov.x = cvt_pk_bf16(o[0], o[1]); ov.y = cvt_pk_bf16(o[2], o[3]); ov.z = cvt_pk_bf16(o[4], o[5]); ov.w = cvt_pk_bf16(o[6], o[7]);
                        *(u32x4*)(ao + (size_t)r * DFF) = ov;
                    }
                }
            }
            GRID_BAR();
        }
        { PH_INIT; MAKE_E; E.mode = 7; E.gate = MOD + (size_t)L * NB * 6144 + 5120; E.base = xo; RUN_GEMM(ACT, WDOWN, DFF, DFF, DFF, 128, 4, 1, E); }
        GRID_BAR();
    }
    {
        const int l = 2;
        PH_INIT;
        const float* nw = P.in[I_FINW];
        norm_rows(xo, nw, nullptr, 0, nullptr, xo, gw, NGW, lane);
    }
}

extern "C" void kernel_launch(void* const* d_in, const int* in_sizes, int n_in, void* d_out, int out_size, void* d_ws, size_t ws_size, hipStream_t stream) {
    static int grid = 0;
    if (grid == 0) {
        if (n_in != 29 || out_size != T * DM || ws_size < WS_END) { fprintf(stderr, "kernel_launch: unexpected shapes n_in %d out %d ws %zu (need %zu)\n", n_in, out_size, ws_size, (size_t)WS_END); grid = -1; return; }
        int dev = 0, cus = 0, per_cu = 0;
        (void)hipGetDevice(&dev); (void)hipDeviceGetAttribute(&cus, hipDeviceAttributeMultiprocessorCount, dev);
        if (hipFuncSetAttribute((const void*)mega, hipFuncAttributeMaxDynamicSharedMemorySize, LDS_BYTES) != hipSuccess) { fprintf(stderr, "kernel_launch: hipFuncSetAttribute failed\n"); grid = -1; return; }
        (void)hipOccupancyMaxActiveBlocksPerMultiprocessor(&per_cu, (const void*)mega, NTHR, LDS_BYTES);
        if (per_cu < 1) { fprintf(stderr, "kernel_launch: occupancy query says %d blocks per CU\n", per_cu); per_cu = 1; }
        (void)hipGetLastError();
        grid = cus;
    }
    if (grid < 0) return;
    Params p{};
    for (int i = 0; i < 29; ++i) p.in[i] = (const float*)d_in[i];
    p.out = (float*)d_out; p.ws = (unsigned char*)d_ws;
    void* args[] = {&p};
    hipError_t e = hipLaunchCooperativeKernel((const void*)mega, dim3(grid), dim3(NTHR), args, LDS_BYTES, stream);
    if (e != hipSuccess) fprintf(stderr, "cooperative launch failed: %s (grid %d)\n", hipGetErrorString(e), grid);
}
```

```cpp
#include <hip/hip_runtime.h>
#include <hip/hip_cooperative_groups.h>
#include <cstdio>
#include <cstdint>
namespace cg = cooperative_groups;

#define LAS __attribute__((address_space(3)))
typedef unsigned short bf16_t;
typedef short bf16x8 __attribute__((ext_vector_type(8)));
typedef short s16x4 __attribute__((ext_vector_type(4)));
typedef float f32x2 __attribute__((ext_vector_type(2)));
typedef float f32x4 __attribute__((ext_vector_type(4)));
typedef float f32x16 __attribute__((ext_vector_type(16)));
typedef unsigned u32x2 __attribute__((ext_vector_type(2)));
typedef unsigned u32x4 __attribute__((ext_vector_type(4)));

constexpr int NB = 8, SEQ = 4096, DM = 1024, T = NB * SEQ, DFF = 2816, NUP = 2 * DFF, NWAVES = 8, NTHR = 512;
constexpr int CH = 32, NCH = SEQ / CH, KX = 768;
constexpr size_t MiB = 1u << 20;
constexpr size_t WS_KMAX = 64 * 1024, WS_MOD = 1 * MiB, WS_ROPE = 2 * MiB, WS_PW = 3 * MiB, WS_BB = 5 * MiB, WS_KM = 6 * MiB;
constexpr size_t WS_WQKVU = 8 * MiB, WS_WG = 15 * MiB, WS_WAO = 19 * MiB, WS_WGLU = 21 * MiB, WS_WOUT = 23 * MiB, WS_WUP = 25 * MiB, WS_WDOWN = 36 * MiB;
constexpr size_t WS_TMAT = 42 * MiB, WS_EMAT = 66 * MiB, WS_XN = 74 * MiB;
constexpr size_t WS_Q = 138 * MiB, WS_K = 202 * MiB, WS_V = 266 * MiB, WS_UEXT = 330 * MiB, WS_XLOC = 378 * MiB, WS_SCR = 410 * MiB;
constexpr size_t WS_OS = 442 * MiB;
constexpr size_t WS_UP = 138 * MiB, WS_ACT = 314 * MiB, WS_END = 506 * MiB;
constexpr int LDS_BYTES = 147456;

struct Params {
    const float* in[29];
    float* out;
    unsigned char* ws;
};
enum { I_X = 0, I_C, I_N1W, I_N2W, I_ADAW, I_ADAB, I_WIN, I_LQ1, I_LK1, I_LQ2, I_LK2, I_SUBW, I_WAO, I_SLRE, I_SLIM, I_SLDT, I_SBRE, I_SBIM, I_SCRE, I_SCIM, I_SD,
       I_WGA, I_WGB, I_WOUT, I_WUP, I_CONVW, I_CONVB, I_WDOWN, I_FINW };

__device__ __forceinline__ unsigned cvt_pk_bf16(float lo, float hi) { unsigned r; asm volatile("v_cvt_pk_bf16_f32 %0, %1, %2" : "=v"(r) : "v"(lo), "v"(hi)); return r; }
__device__ __forceinline__ float bf_lo(unsigned w) { return __uint_as_float(w << 16); }
__device__ __forceinline__ float bf_hi(unsigned w) { return __uint_as_float(w & 0xffff0000u); }
__device__ __forceinline__ float sigmoidf_(float x) { return 1.0f / (1.0f + __expf(-x)); }
__device__ __forceinline__ float gelu_tanh(float x) { const float z = 0.7978845608028654f * (x + 0.044715f * x * x * x); return x / (1.0f + __expf(-2.0f * z)); }
__device__ __forceinline__ float shfl_xor_l(float v, int x, int lane) { return __uint_as_float((unsigned)__builtin_amdgcn_ds_bpermute((lane ^ x) << 2, (int)__float_as_uint(v))); }
__device__ __forceinline__ float wave_sum(float v, int lane) {
#pragma unroll
    for (int o = 1; o < 64; o <<= 1) v += shfl_xor_l(v, o, lane);
    return v;
}

namespace pg8 {
constexpr int BM = 256, BK = 64, HALF = 128, HTB = HALF * BK * 2, NXCD = 8, WGM = 8;
__host__ __device__ __forceinline__ int lds_byte(int r, int c) { const int st = (r >> 4) * 2 + (c >> 5), rr = r & 15, cc = c & 31, ob = rr * 64 + cc * 2; return st * 1024 + (ob ^ (((ob >> 9) & 1) << 5)); }
__host__ __device__ __forceinline__ void stage_rc(int b, int& R, int& C) { const int st = b / 1024, sb = b % 1024, swz = sb ^ (((sb >> 9) & 1) << 5); R = (st >> 1) * 16 + swz / 64; C = (st & 1) * 32 + (swz % 64) / 2; }

__host__ __device__ __forceinline__ int perm32(int rho) { const int n = rho >> 4, i = rho & 15; return 8 * (i >> 2) + 4 * n + (i & 3); }
struct Unit { int pm, pn, grp; };
struct Gemm { const bf16_t* A; const bf16_t* Bt; int lda, ldb, K, nM, nN, ngrp; };
struct Order {
    int nM, nN, ngrp, nwg, G, c;
    __device__ void init(const Gemm& g, int G_, int c_) { nM = g.nM; nN = g.nN; ngrp = g.ngrp; nwg = nM * nN * ngrp; G = G_; c = c_; }
    __device__ bool next(int i, Unit& u) const {
        const long L = (long)i * G + c; if (L >= nwg) return false;
        if (ngrp == 1) {
            int wgid = (int)L; { const int q = nwg / NXCD, r = nwg % NXCD, xcd = wgid % NXCD, off = wgid / NXCD; wgid = (xcd < r ? xcd * (q + 1) : r * (q + 1) + (xcd - r) * q) + off; }
            const int nig = WGM * nN, gid = wgid / nig, fm = gid * WGM, gsz = (nM - fm) < WGM ? (nM - fm) : WGM;
            u.pm = fm + ((wgid % nig) % gsz); u.pn = (wgid % nig) / gsz; u.grp = 0;
        } else {
            const int per = nM * nN; const int w = (int)(L % per); u.grp = (int)(L / per); u.pm = w % nM; u.pn = w / nM;
        }
        return true;
    }
};

struct Epi {
    int mode, layer;
    bf16_t *Q, *Kb, *Vb, *Uext, *Y, *UPh, *OS;
    float* xloc; const float* rope; const float* gate; const float* base; float* xout;
    static __device__ __forceinline__ u32x4 pack8(const f32x4 a, const f32x4 b) { u32x4 w; w.x = cvt_pk_bf16(a[0], a[1]); w.y = cvt_pk_bf16(a[2], a[3]); w.z = cvt_pk_bf16(b[0], b[1]); w.w = cvt_pk_bf16(b[2], b[3]); return w; }
    __device__ __forceinline__ void operator()(const f32x4 (&acc)[2][2][4][2], const Unit& u, int wr, int wc, int fr, int fq) const {
        const int colt = u.pn * BM;
#pragma unroll
        for (int ai = 0; ai < 2; ++ai)
#pragma unroll
            for (int m = 0; m < 4; ++m) {
                const int rl = ai * HALF + wr * 64 + m * 16 + fr;
                const int row = u.pm * BM + rl;
#pragma unroll
                for (int bj = 0; bj < 2; ++bj) {
                    const int cl = bj * HALF + wc * 32 + fq * 8;
                    const f32x4 v0 = acc[ai][bj][m][0], v1 = acc[ai][bj][m][1];
                    if (mode == 1) {
                        if (colt < 2048) {
                            bf16_t* dst = colt < 1024 ? Q : Kb; const int cc = (colt & 1023) + cl; const int s = row & (SEQ - 1); const int i = (cc & 63) >> 1;
                            const f32x4 c0 = *(const f32x4*)(rope + ((size_t)s * 32 + i) * 2), c1 = *(const f32x4*)(rope + ((size_t)s * 32 + i) * 2 + 4);
                            const f32x4 o0 = {v0[0] * c0[0] - v0[1] * c0[1], v0[1] * c0[0] + v0[0] * c0[1], v0[2] * c0[2] - v0[3] * c0[3], v0[3] * c0[2] + v0[2] * c0[3]};
                            const f32x4 o1 = {v1[0] * c1[0] - v1[1] * c1[1], v1[1] * c1[0] + v1[0] * c1[1], v1[2] * c1[2] - v1[3] * c1[3], v1[3] * c1[2] + v1[2] * c1[3]};
                            *(u32x4*)(dst + (size_t)row * DM + cc) = pack8(o0, o1);
                        } else if (colt < 3072) {
                            *(u32x4*)(Vb + (size_t)row * DM + (colt - 2048) + cl) = pack8(v0, v1);
                        } else {
                            const int uc = colt - 3072 + cl, g = uc >> 4, ni = uc & 15; const int b = row >> 12, s = row & (SEQ - 1), ch = s >> 5, sl = s & 31;
                            *(u32x4*)(Uext + ((size_t)(g * (NB * NCH) + b * NCH + ch)) * KX + sl * 16 + ni) = pack8(v0, v1);
                        }
                    } else if (mode == 2) {
                        float* p = xloc + ((size_t)(u.grp * (NB * NCH) + row)) * 256 + cl; *(f32x4*)p = v0; *(f32x4*)(p + 4) = v1;
                    } else if (mode == 3) {
                        const int b = row >> 7, ch = row & 127; const int nn = colt + cl, t = nn >> 4, no = nn & 15; const size_t tok = (size_t)b * SEQ + ch * CH + t;
                        const f32x4 g0 = {gelu_tanh(v0[0]), gelu_tanh(v0[1]), gelu_tanh(v0[2]), gelu_tanh(v0[3])}, g1 = {gelu_tanh(v1[0]), gelu_tanh(v1[1]), gelu_tanh(v1[2]), gelu_tanh(v1[3])};
                        *(u32x4*)(Y + tok * 512 + u.grp * 16 + no) = pack8(g0, g1);
                    } else if (mode == 4) {
                        bf16_t* dst = colt < 1024 ? Kb : Vb; const int cc = (colt & 1023) + cl;
                        const f32x4 g0 = {sigmoidf_(v0[0]), sigmoidf_(v0[1]), sigmoidf_(v0[2]), sigmoidf_(v0[3])}, g1 = {sigmoidf_(v1[0]), sigmoidf_(v1[1]), sigmoidf_(v1[2]), sigmoidf_(v1[3])};
                        *(u32x4*)(dst + (size_t)row * DM + cc) = pack8(g0, g1);
                    } else if (mode == 5) {
                        const int cc = u.pn * 128 + bj * 64 + wc * 16 + fq * 4;
                        u32x2 w; w.x = cvt_pk_bf16(v0[0] * sigmoidf_(v1[0]), v0[1] * sigmoidf_(v1[1])); w.y = cvt_pk_bf16(v0[2] * sigmoidf_(v1[2]), v0[3] * sigmoidf_(v1[3]));
                        *(u32x2*)(OS + (size_t)row * DM + cc) = w;
                    } else if (mode == 6) {
                        const int cc = colt + cl; bf16_t* p = Kb + (size_t)row * DM + cc; const u32x4 sg = *(const u32x4*)p; const u32x4 ss = *(const u32x4*)(Vb + (size_t)row * DM + cc); const u32x4 os = *(const u32x4*)(OS + (size_t)row * DM + cc);
                        const f32x4 o0 = {bf_lo(sg.x) * v0[0] + bf_lo(ss.x) * bf_lo(os.x), bf_hi(sg.x) * v0[1] + bf_hi(ss.x) * bf_hi(os.x), bf_lo(sg.y) * v0[2] + bf_lo(ss.y) * bf_lo(os.y), bf_hi(sg.y) * v0[3] + bf_hi(ss.y) * bf_hi(os.y)};
                        const f32x4 o1 = {bf_lo(sg.z) * v1[0] + bf_lo(ss.z) * bf_lo(os.z), bf_hi(sg.z) * v1[1] + bf_hi(ss.z) * bf_hi(os.z), bf_lo(sg.w) * v1[2] + bf_lo(ss.w) * bf_lo(os.w), bf_hi(sg.w) * v1[3] + bf_hi(ss.w) * bf_hi(os.w)};
                        *(u32x4*)p = pack8(o0, o1);
                    } else if (mode == 7) {
                        const int cc = colt + cl; const int b = row >> 12; const float* gp = gate + (size_t)b * 6144 + cc; const f32x4 g0 = *(const f32x4*)gp, g1 = *(const f32x4*)(gp + 4); const size_t off = (size_t)row * DM + cc;
                        const f32x4 b0 = *(const f32x4*)(base + off), b1 = *(const f32x4*)(base + off + 4); *(f32x4*)(xout + off) = b0 + g0 * v0; *(f32x4*)(xout + off + 4) = b1 + g1 * v1;
                    } else {
                        *(u32x4*)(UPh + (size_t)row * NUP + colt + cl) = pack8(v0, v1);
                    }
                }
            }
    }
};

__device__ __forceinline__ void gemm_phase(LAS unsigned char* lds, const Gemm g, const Order& S, const Epi& E) {
    int tid = threadIdx.x; asm volatile("" : "+v"(tid));
    const int wid = __builtin_amdgcn_readfirstlane(tid >> 6), lane = tid & 63, wr = wid >> 2, wc = wid & 3, fr = lane & 15, fq = lane >> 4;
    const int K = g.K, nt = K / BK;
    unsigned voffA[2], voffB[2];
#pragma unroll
    for (int i = 0; i < 2; ++i) { int R, C; stage_rc(tid * 16 + i * 8192, R, C); const int Rb = (R & ~31) + perm32(R & 31); voffA[i] = (unsigned)(R * g.lda + C) * 2u; voffB[i] = (unsigned)(Rb * g.ldb + C) * 2u; }
    const size_t kstep = (size_t)(BK * 2);
    const size_t hstepA = (size_t)HALF * g.lda * 2, hstepB = (size_t)HALF * g.ldb * 2;
    const size_t tstepA = 2 * hstepA, tstepB = 2 * hstepB;
    const unsigned ldsw = (unsigned)wid * 1024u;
    const int aoff = lds_byte(wr * 64 + fr, fq * 8), boff = lds_byte(wc * 32 + fr, fq * 8);
#define PG8_SA(b, h) (((b) * 2 + (h)) * HTB)
#define PG8_SB(b, h) ((4 + (b) * 2 + (h)) * HTB)
#define PG8_STAGE(bufoff, gbase, voff) do { _Pragma("unroll") for (int _i = 0; _i < 2; ++_i) \
        __builtin_amdgcn_global_load_lds((const unsigned*)((const char*)(gbase) + (voff)[_i]), (LAS unsigned*)(lds + (bufoff) + ldsw + _i * 8192), 16, 0, 0); } while (0)
#define PG8_LDA(dst, b, h) do { _Pragma("unroll") for (int m = 0; m < 4; ++m) _Pragma("unroll") for (int k = 0; k < 2; ++k) dst[m][k] = *(const LAS bf16x8*)(lds + PG8_SA(b, h) + aoff + m * 2048 + k * 1024); } while (0)
#define PG8_LDB(dst, b, h) do { _Pragma("unroll") for (int n = 0; n < 2; ++n) _Pragma("unroll") for (int k = 0; k < 2; ++k) dst[n][k] = *(const LAS bf16x8*)(lds + PG8_SB(b, h) + boff + n * 2048 + k * 1024); } while (0)
#define PG8_MMA(ai, bj, At, Bt) do { __builtin_amdgcn_s_setprio(1); _Pragma("unroll") for (int m = 0; m < 4; ++m) _Pragma("unroll") for (int n = 0; n < 2; ++n) _Pragma("unroll") for (int k = 0; k < 2; ++k) \
        acc[ai][bj][m][n] = __builtin_amdgcn_mfma_f32_16x16x32_bf16(Bt[n][k], At[m][k], acc[ai][bj][m][n], 0, 0, 0); __builtin_amdgcn_s_setprio(0); } while (0)
#define PG8_WAIT_V(n) asm volatile("s_waitcnt vmcnt(" #n ")" ::: "memory")
#define PG8_WAIT_L(n) asm volatile("s_waitcnt lgkmcnt(" #n ")" ::: "memory")
#define PG8_BAR __builtin_amdgcn_s_barrier()
#define PG8_SCHED __builtin_amdgcn_sched_barrier(0)
    Unit cur, nxt; int ui = 0;
    if (!S.next(0, cur)) return;
    f32x4 acc[2][2][4][2];
#pragma unroll
    for (int a = 0; a < 2; ++a)
#pragma unroll
        for (int b = 0; b < 2; ++b)
#pragma unroll
            for (int m = 0; m < 4; ++m)
#pragma unroll
                for (int n = 0; n < 2; ++n) acc[a][b][m][n] = (f32x4){0.f, 0.f, 0.f, 0.f};
    bf16x8 At[4][2], B0[2][2], B1[2][2];
    const char* cA = (const char*)g.A + (size_t)(cur.grp * g.nM + cur.pm) * tstepA; const char* cB = (const char*)g.Bt + (size_t)(cur.grp * g.nN + cur.pn) * tstepB;
    PG8_STAGE(PG8_SB(0, 0), cB, voffB); PG8_STAGE(PG8_SB(0, 1), cB + hstepB, voffB); PG8_STAGE(PG8_SA(0, 0), cA, voffA); PG8_STAGE(PG8_SA(0, 1), cA + hstepA, voffA);
    if (wr == 1) PG8_BAR;
    PG8_WAIT_V(2); PG8_BAR;
    PG8_STAGE(PG8_SB(1, 0), cB + kstep, voffB); PG8_STAGE(PG8_SA(1, 0), cA + kstep, voffA); PG8_STAGE(PG8_SB(1, 1), cB + hstepB + kstep, voffB);
    PG8_WAIT_V(6); PG8_BAR;
    for (;;) {
        const bool has_next = S.next(ui + 1, nxt);
        const char* nA = has_next ? (const char*)g.A + (size_t)(nxt.grp * g.nM + nxt.pm) * tstepA : cA; const char* nB = has_next ? (const char*)g.Bt + (size_t)(nxt.grp * g.nN + nxt.pn) * tstepB : cB;
        for (int t = 0; t < nt; t += 2) {
            const bool last = (t == nt - 2);
            const char* a1 = cA + (size_t)(t + 1) * kstep;
            const char* a2 = last ? nA : cA + (size_t)(t + 2) * kstep; const char* b2 = last ? nB : cB + (size_t)(t + 2) * kstep;
            const char* a3 = a2 + kstep; const char* b3 = b2 + kstep;
            PG8_LDB(B0, 0, 0); PG8_LDB(B1, 0, 1); PG8_SCHED; PG8_LDA(At, 0, 0); PG8_STAGE(PG8_SA(1, 1), a1 + hstepA, voffA);
            PG8_WAIT_V(8); PG8_WAIT_L(0); PG8_BAR; PG8_MMA(0, 0, At, B0); PG8_MMA(0, 1, At, B1); PG8_BAR; PG8_SCHED;
            PG8_LDA(At, 0, 1); PG8_STAGE(PG8_SB(0, 0), b2, voffB); PG8_STAGE(PG8_SB(0, 1), b2 + hstepB, voffB); PG8_STAGE(PG8_SA(0, 0), a2, voffA);
            PG8_WAIT_V(8); PG8_WAIT_L(0); PG8_BAR; PG8_MMA(1, 0, At, B0); PG8_MMA(1, 1, At, B1); PG8_BAR; PG8_SCHED;
            PG8_LDB(B0, 1, 0); PG8_LDB(B1, 1, 1); PG8_SCHED; PG8_LDA(At, 1, 0); PG8_STAGE(PG8_SA(0, 1), a2 + hstepA, voffA);
            PG8_WAIT_V(8); PG8_WAIT_L(0); PG8_BAR; PG8_MMA(0, 0, At, B0); PG8_MMA(0, 1, At, B1); PG8_BAR; PG8_SCHED;
            PG8_LDA(At, 1, 1); PG8_STAGE(PG8_SB(1, 0), b3, voffB); PG8_STAGE(PG8_SB(1, 1), b3 + hstepB, voffB); PG8_STAGE(PG8_SA(1, 0), a3, voffA);
            PG8_WAIT_V(8); PG8_WAIT_L(0); PG8_BAR; PG8_MMA(1, 0, At, B0); PG8_MMA(1, 1, At, B1); PG8_BAR; PG8_SCHED;
        }
        if (wr == 0) PG8_BAR;
        E(acc, cur, wr, wc, fr, fq);
        if (!has_next) break;
#pragma unroll
        for (int a = 0; a < 2; ++a)
#pragma unroll
            for (int b = 0; b < 2; ++b)
#pragma unroll
                for (int m = 0; m < 4; ++m)
#pragma unroll
                    for (int n = 0; n < 2; ++n) acc[a][b][m][n] = (f32x4){0.f, 0.f, 0.f, 0.f};
        cur = nxt; cA = nA; cB = nB; ++ui;
        if (wr == 1) PG8_BAR;
    }
    PG8_WAIT_V(0);
    PG8_BAR;
#undef PG8_SA
#undef PG8_SB
#undef PG8_STAGE
#undef PG8_LDA
#undef PG8_LDB
#undef PG8_MMA
#undef PG8_WAIT_V
#undef PG8_WAIT_L
#undef PG8_BAR
#undef PG8_SCHED
}
}

namespace att {
constexpr int D = 128, NW = 8, QBLK = 32, KVBLK = 64, LD = DM;
constexpr float SCALE = 0.125f, THR = 8.f;
constexpr size_t SHM_V = KVBLK * D * 2, SHM_K = KVBLK * 64 * 2;
#define KSWZ(row, colB) ((row) * 128 + ((colB) ^ ((((row) >> 1) & 7) << 4)))
#define SBAR() __builtin_amdgcn_sched_barrier(0)
__device__ __forceinline__ int crow(int r, int hi) { return (r & 3) + 8 * (r >> 2) + 4 * hi; }
__device__ __forceinline__ void partialSM(f32x16& p0, f32x16& p1, float mnC) {
    constexpr float C = SCALE * 1.4426950408889634f;
#pragma unroll
    for (int r = 0; r < 16; ++r) p0[r] = fmaf(p0[r], C, mnC);
#pragma unroll
    for (int r = 0; r < 16; ++r) p1[r] = fmaf(p1[r], C, mnC);
#pragma unroll
    for (int r = 0; r < 16; ++r) p0[r] = __builtin_amdgcn_exp2f(p0[r]);
}
__device__ __forceinline__ void finishSM(f32x16& p0, f32x16& p1, float& l_reg, bf16x8& pa0, bf16x8& pa1, bf16x8& pa2, bf16x8& pa3) {
#pragma unroll
    for (int r = 0; r < 16; ++r) p1[r] = __builtin_amdgcn_exp2f(p1[r]);
    float ps = 0;
#pragma unroll
    for (int r = 0; r < 16; ++r) ps += p0[r];
#pragma unroll
    for (int r = 0; r < 16; ++r) ps += p1[r];
    l_reg += ps;
#define PK4(P, BASE, OUT) do { unsigned a0 = cvt_pk_bf16(P[BASE + 0], P[BASE + 1]), a1 = cvt_pk_bf16(P[BASE + 2], P[BASE + 3]);   \
    unsigned b0 = cvt_pk_bf16(P[BASE + 4], P[BASE + 5]), b1 = cvt_pk_bf16(P[BASE + 6], P[BASE + 7]);                              \
    auto r0 = __builtin_amdgcn_permlane32_swap(a0, b0, false, false); auto r1 = __builtin_amdgcn_permlane32_swap(a1, b1, false, false); \
    u32x4 w = {r0[0], r1[0], r0[1], r1[1]}; OUT = *reinterpret_cast<bf16x8*>(&w); } while (0)
    PK4(p0, 0, pa0); PK4(p0, 8, pa1); PK4(p1, 0, pa2); PK4(p1, 8, pa3);
#undef PK4
}
__device__ __forceinline__ void qkt(f32x16& p0, f32x16& p1, const char* Ks, const bf16x8* qr, int r32, int hi) {
    p0 = f32x16{}; p1 = f32x16{};
#pragma unroll
    for (int d0 = 0; d0 < 4; ++d0) { const int cb = (d0 * 16 + hi * 8) * 2;
        const bf16x8 b0 = *reinterpret_cast<const bf16x8*>(Ks + KSWZ(r32, cb));
        const bf16x8 b1 = *reinterpret_cast<const bf16x8*>(Ks + KSWZ(32 + r32, cb));
        p0 = __builtin_amdgcn_mfma_f32_32x32x16_bf16(b0, qr[d0], p0, 0, 0, 0);
        p1 = __builtin_amdgcn_mfma_f32_32x32x16_bf16(b1, qr[d0], p1, 0, 0, 0); }
}
__device__ __forceinline__ int v_st(int k, int c) { const int kk = (k & ~0xC) | ((k & 4) << 1) | ((k & 8) >> 1); return ((kk >> 3) * 4 + (c >> 5)) * 512 + ((kk & 7) * 32 + (c & 31)) * 2; }
__device__ __forceinline__ int v_rd_base(int lane) { return ((lane & 3) << 3) | (((lane >> 2) & 3) << 6) | (((lane >> 4) & 1) << 5) | (((lane >> 5) & 1) << 8); }
constexpr int v_rd_off(int d0, int ks, int half) { return d0 * 512 + ks * 4096 + half * 2048; }
template <int OFF> __device__ __forceinline__ s16x4 tr_read(int vb) {
    s16x4 r; asm volatile("ds_read_b64_tr_b16 %0, %1 offset:%2" : "=&v"(r) : "v"(vb), "i"(OFF) : "memory"); return r;
}
template <int D0> __device__ __forceinline__ void pv_one(f32x16& od, int vb, bf16x8 pa0, bf16x8 pa1, bf16x8 pa2, bf16x8 pa3) {
    const s16x4 l0 = tr_read<v_rd_off(D0, 0, 0)>(vb), h0 = tr_read<v_rd_off(D0, 0, 1)>(vb), l1 = tr_read<v_rd_off(D0, 1, 0)>(vb), h1 = tr_read<v_rd_off(D0, 1, 1)>(vb);
    const s16x4 l2 = tr_read<v_rd_off(D0, 2, 0)>(vb), h2 = tr_read<v_rd_off(D0, 2, 1)>(vb), l3 = tr_read<v_rd_off(D0, 3, 0)>(vb), h3 = tr_read<v_rd_off(D0, 3, 1)>(vb);
    asm volatile("s_waitcnt lgkmcnt(0)" ::: "memory"); SBAR();
#define PK(L, H) (bf16x8){L[0], L[1], L[2], L[3], H[0], H[1], H[2], H[3]}
    od = __builtin_amdgcn_mfma_f32_32x32x16_bf16(pa0, PK(l0, h0), od, 0, 0, 0);
    od = __builtin_amdgcn_mfma_f32_32x32x16_bf16(pa1, PK(l1, h1), od, 0, 0, 0);
    od = __builtin_amdgcn_mfma_f32_32x32x16_bf16(pa2, PK(l2, h2), od, 0, 0, 0);
    od = __builtin_amdgcn_mfma_f32_32x32x16_bf16(pa3, PK(l3, h3), od, 0, 0, 0);
#undef PK
}
__device__ __forceinline__ void pv_d0(f32x16* o, int vb, bf16x8 pa0, bf16x8 pa1, bf16x8 pa2, bf16x8 pa3) {
    pv_one<0>(o[0], vb, pa0, pa1, pa2, pa3); pv_one<1>(o[1], vb, pa0, pa1, pa2, pa3); pv_one<2>(o[2], vb, pa0, pa1, pa2, pa3); pv_one<3>(o[3], vb, pa0, pa1, pa2, pa3);
}

__device__ __forceinline__ void attn_pass(const bf16_t* __restrict__ Qb, const bf16_t* __restrict__ Kh, const bf16_t* __restrict__ Vh, float kmax2, f32x16 (&o)[4], float (&rli)[16], char* lds) {
    int tid = threadIdx.x; asm volatile("" : "+v"(tid));
    const int wid = tid >> 6, lane = tid & 63, r32 = lane & 31, hi = lane >> 5;
    char* V_lds = lds; char* K_lds = lds + 2 * SHM_V;
    float* ws = (float*)(lds + 2 * SHM_V + 2 * SHM_K) + wid * 64; float* li_l = ws;
    float l_reg = 0; bf16x8 qr[4];
#pragma unroll
    for (int d = 0; d < 4; ++d) o[d] = f32x16{};
    const bf16_t* Qw = Qb + (long)(wid * QBLK + r32) * LD + hi * 8;
#pragma unroll
    for (int d0 = 0; d0 < 4; ++d0) qr[d0] = *reinterpret_cast<const bf16x8*>(Qw + d0 * 16);
    float mnC;
    { float qs = 0.f;
#pragma unroll
      for (int d0 = 0; d0 < 4; ++d0)
#pragma unroll
          for (int e = 0; e < 8; ++e) { const float qv = __uint_as_float(((unsigned)(unsigned short)qr[d0][e]) << 16); qs += qv * qv; }
      auto rr = __builtin_amdgcn_permlane32_swap(__float_as_uint(qs), __float_as_uint(qs), false, false);
      qs = __uint_as_float(rr[0]) + __uint_as_float(rr[1]);
      mnC = -fminf(sqrtf(qs * kmax2) * SCALE, 60.0f) * 1.4426950408889634f; }
    const int sr = tid >> 4, sc = (tid & 15) * 8, vst0 = v_st(sr, sc), vst1 = v_st(32 + sr, sc);
    const int kr = tid >> 3, kc = (tid & 7) * 8, kst = KSWZ(kr, kc * 2);
    const int vb0 = (int)(uintptr_t)V_lds + v_rd_base(lane);
    struct { bf16x8 vs0, vs1, ks0; } sr_[2];
#define SLOAD(i, k0) do { sr_[i].vs0 = *reinterpret_cast<const bf16x8*>(&Vh[(long)((k0) + sr) * LD + sc]); sr_[i].vs1 = *reinterpret_cast<const bf16x8*>(&Vh[(long)((k0) + 32 + sr) * LD + sc]); \
    sr_[i].ks0 = *reinterpret_cast<const bf16x8*>(&Kh[(long)((k0) + kr) * LD + kc]); } while (0)
#define SWRITE(b, i) do { *(bf16x8*)(V_lds + (b) * SHM_V + vst0) = sr_[i].vs0; *(bf16x8*)(V_lds + (b) * SHM_V + vst1) = sr_[i].vs1; *(bf16x8*)(K_lds + (b) * SHM_K + kst) = sr_[i].ks0; } while (0)
#define SWAIT() asm volatile("s_waitcnt vmcnt(3)" ::: "memory")
    f32x16 pA0, pA1, pB0, pB1; bf16x8 pa0, pa1, pa2, pa3; const int NT = SEQ / KVBLK;
    constexpr int SE = 0, SO = 1;
    SLOAD(SE, 0); asm volatile("s_waitcnt vmcnt(0)" ::: "memory"); SWRITE(0, SE); __syncthreads();
    qkt(pA0, pA1, K_lds, qr, r32, hi); partialSM(pA0, pA1, mnC);
    SLOAD(SO, KVBLK); SLOAD(SE, 2 * KVBLK);
    SWAIT(); SWRITE(1, SO); __syncthreads();
    for (int j = 1; j + 1 < NT; j += 2) {
        SBAR(); qkt(pB0, pB1, K_lds + SHM_K, qr, r32, hi);
        finishSM(pA0, pA1, l_reg, pa0, pa1, pa2, pa3); SBAR();
        SLOAD(SO, (j + 2) * KVBLK); SBAR();
        pv_d0(o, vb0, pa0, pa1, pa2, pa3); partialSM(pB0, pB1, mnC);
        __syncthreads(); SWAIT(); SWRITE(0, SE);
        __syncthreads();
        SBAR(); qkt(pA0, pA1, K_lds, qr, r32, hi);
        finishSM(pB0, pB1, l_reg, pa0, pa1, pa2, pa3); SBAR();
        if (j + 3 < NT) SLOAD(SE, (j + 3) * KVBLK); SBAR();
        pv_d0(o, vb0 + (int)SHM_V, pa0, pa1, pa2, pa3); partialSM(pA0, pA1, mnC);
        __syncthreads(); SWAIT(); SWRITE(1, SO);
        __syncthreads();
    }
    SBAR(); qkt(pB0, pB1, K_lds + SHM_K, qr, r32, hi);
    finishSM(pA0, pA1, l_reg, pa0, pa1, pa2, pa3); SBAR();
    pv_d0(o, vb0, pa0, pa1, pa2, pa3); partialSM(pB0, pB1, mnC);
    __syncthreads();
    finishSM(pB0, pB1, l_reg, pa0, pa1, pa2, pa3); SBAR();
    pv_d0(o, vb0 + (int)SHM_V, pa0, pa1, pa2, pa3);
    { auto rr = __builtin_amdgcn_permlane32_swap(__float_as_uint(l_reg), __float_as_uint(l_reg), false, false); l_reg = __uint_as_float(rr[0]) + __uint_as_float(rr[1]); }
    if (hi == 0) li_l[r32] = l_reg; asm volatile("s_waitcnt lgkmcnt(0)" ::: "memory");
#pragma unroll
    for (int r = 0; r < 16; ++r) rli[r] = __builtin_amdgcn_rcpf(li_l[crow(r, hi)]);
    __syncthreads();
#undef SLOAD
#undef SWRITE
#undef SWAIT
}

__device__ __forceinline__ void attn_unit(int b, int h, int qb, const bf16_t* Q, const bf16_t* K, const bf16_t* V, bf16_t* O, float* scr, const unsigned* kmax2, float lam, float onem, const float* subw, char* lds) {
    int tid = threadIdx.x; asm volatile("" : "+v"(tid));
    const int wid = tid >> 6, lane = tid & 63, r32 = lane & 31, hi = lane >> 5;
    asm volatile("" : "+s"(Q), "+s"(K), "+s"(V), "+s"(O), "+s"(scr), "+s"(kmax2), "+s"(subw));
    const size_t rowbase = (size_t)b * SEQ;
    f32x16 o[4]; float rli[16];
#pragma unroll 1
    for (int pass = 0; pass < 2; ++pass) {
        const int sub = 2 * h + pass;
        attn_pass(Q + (rowbase + (size_t)qb * 256) * LD + sub * 64, K + rowbase * LD + sub * 64, V + rowbase * LD + h * 128, __uint_as_float(kmax2[b * 16 + sub]), o, rli, lds);
        int t2 = tid; asm volatile("" : "+v"(t2));
        const int lane2 = t2 & 63, r32b = lane2 & 31, hib = lane2 >> 5, wid2 = t2 >> 6;
        float* sp = scr + (size_t)t2 * 64;
        if (pass == 0) {
#pragma unroll
            for (int d0 = 0; d0 < 4; ++d0)
#pragma unroll
                for (int r4 = 0; r4 < 4; ++r4) *(f32x4*)(sp + d0 * 16 + r4 * 4) = (f32x4){o[d0][4 * r4] * rli[4 * r4], o[d0][4 * r4 + 1] * rli[4 * r4 + 1], o[d0][4 * r4 + 2] * rli[4 * r4 + 2], o[d0][4 * r4 + 3] * rli[4 * r4 + 3]};
        } else {
            float ss[16];
#pragma unroll
            for (int r = 0; r < 16; ++r) ss[r] = 0.f;
#pragma unroll
            for (int d0 = 0; d0 < 4; ++d0)
#pragma unroll
                for (int r4 = 0; r4 < 4; ++r4) { const f32x4 o1 = *(const f32x4*)(sp + d0 * 16 + r4 * 4);
#pragma unroll
                    for (int q = 0; q < 4; ++q) { const int r = 4 * r4 + q; const float v = o1[q] - lam * (o[d0][r] * rli[r]); o[d0][r] = v; ss[r] += v * v; } }
#pragma unroll
            for (int r = 0; r < 16; ++r) {
#pragma unroll
                for (int x = 1; x < 32; x <<= 1) ss[r] += shfl_xor_l(ss[r], x, lane2);
                ss[r] = rsqrtf(ss[r] * (1.0f / 128.0f) + 1e-5f) * onem; }
            bf16_t* Ow = O + (rowbase + (size_t)qb * 256 + wid2 * QBLK + 4 * hib) * LD + h * 128 + r32b;
#pragma unroll
            for (int d0 = 0; d0 < 4; ++d0) { const float sw = subw[d0 * 32 + r32b];
#pragma unroll
                for (int r = 0; r < 16; ++r) { const unsigned w = cvt_pk_bf16(o[d0][r] * ss[r] * sw, 0.f); Ow[(size_t)((r & 3) + 8 * (r >> 2)) * LD + d0 * 32] = (bf16_t)(w & 0xffffu); } }
        }
    }
}
#undef SBAR
}

__device__ __forceinline__ void transpose_item(const float* W, const float* W2, int K, int ldw, int coff, int sel, int ndst, bf16_t* WT, LAS float* scr, int item, int lane) {
    const int nblk = ndst / 32, kb = item / nblk, nb = item % nblk, k0 = 64 * kb, n0 = 32 * nb;
    const int nd = n0 + (lane & 31); int sc = nd + coff; const float* Wp = W;
    if (sel == 1 && nd < 2048) { const int j = nd & 63; sc = (nd & ~63) + (j & 1) * 32 + (j >> 1); }
    if (sel == 2) { sc = (nd >> 3) * 4 + (nd & 3); if ((nd >> 2) & 1) Wp = W2; }
#pragma unroll 8
    for (int i = 0; i < 32; ++i) { const int kk = 2 * i + (lane >> 5); scr[kk * 33 + (lane & 31)] = Wp[(size_t)(k0 + kk) * ldw + sc]; }
    asm volatile("s_waitcnt lgkmcnt(0)" ::: "memory");
    const int c = lane & 7;
#pragma unroll
    for (int j = 0; j < 4; ++j) { const int n = (lane >> 3) + 8 * j; const LAS float* s = scr + (8 * c) * 33 + n;
        u32x4 o; o.x = cvt_pk_bf16(s[0 * 33], s[1 * 33]); o.y = cvt_pk_bf16(s[2 * 33], s[3 * 33]); o.z = cvt_pk_bf16(s[4 * 33], s[5 * 33]); o.w = cvt_pk_bf16(s[6 * 33], s[7 * 33]);
        *(u32x4*)(WT + (size_t)(n0 + n) * K + k0 + 8 * c) = o; }
    asm volatile("s_waitcnt lgkmcnt(0)" ::: "memory");
}

__device__ __forceinline__ void norm_rows(const float* xin, const float* nw, const float* mod_l, int mod_off, bf16_t* XN, float* fout, int gw, int NGW, int lane) {
    for (int m0 = gw; m0 < T; m0 += 2 * NGW) {
        const int m1 = m0 + NGW;
        const bool has1 = m1 < T; const int m1c = has1 ? m1 : m0;
        const f32x4* x0 = (const f32x4*)(xin + (size_t)m0 * DM) + lane; const f32x4* x1 = (const f32x4*)(xin + (size_t)m1c * DM) + lane;
        f32x4 v[2][4]; float s0 = 0.f, s1 = 0.f;
#pragma unroll
        for (int j = 0; j < 4; ++j) { v[0][j] = x0[64 * j]; v[1][j] = x1[64 * j]; }
#pragma unroll
        for (int j = 0; j < 4; ++j) { s0 += (v[0][j][0] * v[0][j][0] + v[0][j][1] * v[0][j][1]) + (v[0][j][2] * v[0][j][2] + v[0][j][3] * v[0][j][3]);
                                      s1 += (v[1][j][0] * v[1][j][0] + v[1][j][1] * v[1][j][1]) + (v[1][j][2] * v[1][j][2] + v[1][j][3] * v[1][j][3]); }
        const float r0 = rsqrtf(wave_sum(s0, lane) * (1.0f / DM) + 1e-6f), r1 = rsqrtf(wave_sum(s1, lane) * (1.0f / DM) + 1e-6f);
#pragma unroll
        for (int k = 0; k < 2; ++k) {
            if (k == 1 && !has1) break;
            const int m = k == 0 ? m0 : m1; const float r = k == 0 ? r0 : r1;
#pragma unroll
            for (int j = 0; j < 4; ++j) { const int col = lane * 4 + 256 * j; const f32x4 w4 = *(const f32x4*)(nw + col);
                if (mod_l) { const float* md = mod_l + (size_t)(m >> 12) * 6144 + mod_off; const f32x4 sh = *(const f32x4*)(md + col), sc = *(const f32x4*)(md + 1024 + col);
                    const f32x4 hv = v[k][j] * r * w4 * (sc + 1.0f) + sh; u32x2 w; w.x = cvt_pk_bf16(hv[0], hv[1]); w.y = cvt_pk_bf16(hv[2], hv[3]); *(u32x2*)(XN + (size_t)m * DM + col) = w; }
                else *(f32x4*)(fout + (size_t)m * DM + col) = v[k][j] * r * w4; }
        }
    }
}

#define XB_TMO      128
#define XB_XCNT(j)  (256  + 64 * (j))
#define XB_XSUB(j)  (1280 + 64 * (j))
#define XB_XGEN(j)  (2304 + 64 * (j))
#define XB_TOP      3328
#define XB_TOPGEN   3392
#define XCD_BAR_WORDS 3456
#define XB_SPIN_CAP (1u << 22)
__device__ __forceinline__ unsigned xb_ld(unsigned* p)              { return __hip_atomic_load(p, __ATOMIC_RELAXED, __HIP_MEMORY_SCOPE_AGENT); }
__device__ __forceinline__ unsigned xb_add(unsigned* p, unsigned v) { return __hip_atomic_fetch_add(p, v, __ATOMIC_RELAXED, __HIP_MEMORY_SCOPE_AGENT); }
__device__ __forceinline__ unsigned xb_xcc_id() { return (unsigned)__builtin_amdgcn_s_getreg((3 << 11) | 20) & 0xFu; }
#define XB_SPIN(cond, bar) do { unsigned _sp = 0; while (cond) { __builtin_amdgcn_s_sleep(1); \
    if ((++_sp & 255u) == 0u) { if (xb_ld(&(bar)[XB_TMO])) break; if (_sp > XB_SPIN_CAP) { atomicAdd(&(bar)[XB_TMO], 1u); break; } } } } while (0)
struct XcdBarrier { unsigned* bar; unsigned x; volatile LAS unsigned* st; };
__device__ __forceinline__ void xcd_barrier_complete(unsigned* bar, unsigned x, unsigned& nloc, unsigned& nx) {
    const unsigned G = gridDim.x * gridDim.y * gridDim.z;
    unsigned sum, cnt, mine, sp = 0u;
    for (;;) {
        sum = 0u; cnt = 0u; mine = 0u;
#pragma unroll
        for (unsigned j = 0; j < 16; ++j) { const unsigned c = xb_ld(&bar[XB_XCNT(j)]); sum += c; cnt += (c > 0u) ? 1u : 0u; mine = (j == x) ? c : mine; }
        if (sum == G) break;
        __builtin_amdgcn_s_sleep(1);
        if ((++sp & 255u) == 0u) { if (xb_ld(&bar[XB_TMO])) break; if (sp > XB_SPIN_CAP) { atomicAdd(&bar[XB_TMO], 1u); break; } }
    }
    nloc = mine > 0u ? mine : 1u; nx = cnt > 0u ? cnt : 1u;
}
__device__ __forceinline__ void xcd_barrier(const XcdBarrier& b) {
    asm volatile("s_waitcnt vmcnt(0)" ::: "memory");
    __syncthreads();
    if (threadIdx.x == 0) {
        unsigned* bar = b.bar;
        __builtin_amdgcn_s_waitcnt(0);
        unsigned nloc = b.st[0], nx = b.st[1];
        if (nloc == 0u) { xcd_barrier_complete(bar, b.x, nloc, nx); b.st[0] = nloc; b.st[1] = nx; }
        const unsigned old = xb_add(&bar[XB_XSUB(b.x)], 1u);
        const unsigned gen = old / nloc;
        if (old + 1u == (gen + 1u) * nloc) {
            __builtin_amdgcn_fence(__ATOMIC_RELEASE, "agent");
            asm volatile("s_waitcnt vmcnt(0)" ::: "memory");
            const unsigned og = xb_add(&bar[XB_TOP], 1u);
            const unsigned tg = og / nx;
            if (og + 1u == (tg + 1u) * nx) xb_add(&bar[XB_TOPGEN], 1u);
            else XB_SPIN(xb_ld(&bar[XB_TOPGEN]) == tg, bar);
            __builtin_amdgcn_fence(__ATOMIC_ACQUIRE, "agent");
            xb_add(&bar[XB_XGEN(b.x)], 1u);
            asm volatile("s_waitcnt vmcnt(0)" ::: "memory");
        } else {
            XB_SPIN(xb_ld(&bar[XB_XGEN(b.x)]) == gen, bar);
            __builtin_amdgcn_fence(__ATOMIC_ACQUIRE, "agent");
            asm volatile("s_waitcnt vmcnt(0)" ::: "memory");
        }
    }
    __syncthreads();
}

__global__ void __launch_bounds__(NTHR, 2) mega(Params P) {
    extern __shared__ __attribute__((aligned(16))) unsigned char lds_raw[];
    cg::grid_group grid = cg::this_grid();
    LAS unsigned char* lds = (LAS unsigned char*)lds_raw;
    const int G0 = gridDim.x, bx0 = blockIdx.x;
    float* xo = P.out;
    { unsigned* bw = (unsigned*)P.ws; if (bx0 == 0) for (int i = threadIdx.x; i < XCD_BAR_WORDS; i += NTHR) __hip_atomic_store(bw + i, 0u, __ATOMIC_RELAXED, __HIP_MEMORY_SCOPE_AGENT);
      if (threadIdx.x < 2) ((volatile LAS unsigned*)(lds + LDS_BYTES - 64))[threadIdx.x] = 0u; }
    __threadfence();
    grid.sync();
    XcdBarrier xbar; xbar.bar = (unsigned*)P.ws; xbar.x = xb_xcc_id(); xbar.st = (volatile LAS unsigned*)(lds + LDS_BYTES - 64);
    if (threadIdx.x == 0) (void)xb_add(&xbar.bar[XB_XCNT(xbar.x)], 1u);
#define GRID_BAR() xcd_barrier(xbar)
#define PH_INIT unsigned char* ws = P.ws; int tid = threadIdx.x; int L = l; int G = G0, bx = bx0; asm volatile("" : "+s"(ws), "+s"(L), "+s"(G), "+s"(bx)); asm volatile("" : "+v"(tid)); \
    const int vcu = (G % 8 == 0) ? (bx % 8) * (G / 8) + bx / 8 : bx; const int NGW = G * NWAVES; const long NGT = (long)G * NTHR; (void)NGW; (void)NGT; \
    const int lane = tid & 63, wave = __builtin_amdgcn_readfirstlane(tid >> 6); const int gw = vcu * NWAVES + wave; const long gtid = (long)vcu * NTHR + tid; (void)lane; (void)gw; (void)gtid; \
    float* MOD = (float*)(ws + WS_MOD); float* ROPE = (float*)(ws + WS_ROPE); f32x2* PW = (f32x2*)(ws + WS_PW); f32x2* BB = (f32x2*)(ws + WS_BB); float* KM = (float*)(ws + WS_KM); \
    bf16_t* WQKVU = (bf16_t*)(ws + WS_WQKVU); bf16_t* WG = (bf16_t*)(ws + WS_WG); bf16_t* WAO = (bf16_t*)(ws + WS_WAO); bf16_t* WGLU = (bf16_t*)(ws + WS_WGLU); \
    bf16_t* WOUT = (bf16_t*)(ws + WS_WOUT); bf16_t* WUP = (bf16_t*)(ws + WS_WUP); bf16_t* WDOWN = (bf16_t*)(ws + WS_WDOWN); \
    bf16_t* TMAT = (bf16_t*)(ws + WS_TMAT); bf16_t* EMAT = (bf16_t*)(ws + WS_EMAT); bf16_t* XN = (bf16_t*)(ws + WS_XN); \
    bf16_t* QB = (bf16_t*)(ws + WS_Q); bf16_t* KB = (bf16_t*)(ws + WS_K); bf16_t* VB = (bf16_t*)(ws + WS_V); bf16_t* UEXT = (bf16_t*)(ws + WS_UEXT); \
    float* XLOC = (float*)(ws + WS_XLOC); bf16_t* YB = (bf16_t*)(ws + WS_XLOC); float* SCR = (float*)(ws + WS_SCR); \
    bf16_t* UPH = (bf16_t*)(ws + WS_UP); bf16_t* ACT = (bf16_t*)(ws + WS_ACT); \
    (void)MOD; (void)ROPE; (void)PW; (void)BB; (void)KM; (void)WQKVU; (void)WG; (void)WAO; (void)WGLU; (void)WOUT; (void)WUP; (void)WDOWN; (void)TMAT; (void)EMAT; (void)XN; (void)QB; (void)KB; (void)VB; (void)UEXT; (void)XLOC; (void)YB; (void)SCR; (void)UPH; (void)ACT
#define MAKE_E pg8::Epi E{}; E.layer = L; E.Q = QB; E.Kb = KB; E.Vb = VB; E.Uext = UEXT; E.Y = YB; E.UPh = UPH; E.OS = (bf16_t*)(ws + WS_OS); E.xloc = XLOC; E.rope = ROPE; E.xout = xo

#define RUN_GEMM(A_, Bt_, lda_, ldb_, K_, nM_, nN_, ngrp_, epi_) do { pg8::Gemm g_{A_, Bt_, lda_, ldb_, K_, nM_, nN_, ngrp_}; pg8::Order S_; S_.init(g_, G, bx); pg8::gemm_phase(lds, g_, S_, epi_); } while (0)

#pragma unroll 1
    for (int l = 0; l < 2; ++l) {
        const float lambda_init = (l == 0) ? 0.2f : 0.35550906759f;
        {
            PH_INIT;
            LAS float* scr = (LAS float*)(lds + wave * 16384);
            const int I1 = 16 * 112, I2 = 16 * 64, I3 = 16 * 32, I4 = 8 * 64, I5 = 16 * 32, I6 = 16 * 176, I7 = 44 * 32, NI = I1 + I2 + I3 + I4 + I5 + I6 + I7;
            const float* win = P.in[I_WIN] + (size_t)L * DM * 5632;
            for (int it = gw; it < NI; it += NGW) {
                int r = it;
                if (r < I1) { transpose_item(win, nullptr, 1024, 5632, 0, 1, 3584, WQKVU, scr, r, lane); continue; } r -= I1;
                if (r < I2) { transpose_item(win, nullptr, 1024, 5632, 3584, 0, 2048, WG, scr, r, lane); continue; } r -= I2;
                if (r < I3) { transpose_item(P.in[I_WAO] + (size_t)L * DM * DM, nullptr, 1024, 1024, 0, 0, 1024, WAO, scr, r, lane); continue; } r -= I3;
                if (r < I4) { transpose_item(P.in[I_WGA] + (size_t)L * 512 * DM, P.in[I_WGB] + (size_t)L * 512 * DM, 512, 1024, 0, 2, 2048, WGLU, scr, r, lane); continue; } r -= I4;
                if (r < I5) { transpose_item(P.in[I_WOUT] + (size_t)L * DM * DM, nullptr, 1024, 1024, 0, 0, 1024, WOUT, scr, r, lane); continue; } r -= I5;
                if (r < I6) { transpose_item(P.in[I_WUP] + (size_t)L * DM * NUP, nullptr, 1024, NUP, 0, 0, NUP, WUP, scr, r, lane); continue; } r -= I6;
                transpose_item(P.in[I_WDOWN] + (size_t)L * DFF * DM, nullptr, DFF, 1024, 0, 0, 1024, WDOWN, scr, r, lane);
            }
            for (long i = gtid; i < 2 * 32 * 33 * 64; i += NGT) {
                const int p = (int)(i & 63); const int tau = (int)((i >> 6) % 33); const int dg = (int)(i / (64 * 33));
                const size_t li = ((size_t)L * 64 + dg) * 64 + p; const float lr = P.in[I_SLRE][li], lim = P.in[I_SLIM][li]; const float dt = expf(P.in[I_SLDT][L * 64 + dg]);
                const float mag = expf(lr * dt * (float)tau), ang = (lim * dt) * (float)tau;
                PW[i] = (f32x2){mag * cosf(ang), mag * sinf(ang)};
            }
            for (long i = gtid; i < 2 * 32 * 64 * 16; i += NGT) {
                const int p = (int)((i >> 4) & 63); const int dg = (int)(i >> 10);
                const size_t li = ((size_t)L * 64 + dg) * 64 + p; const float lr = P.in[I_SLRE][li], lim = P.in[I_SLIM][li]; const float dt = expf(P.in[I_SLDT][L * 64 + dg]);
                const float mag = expf(lr * dt), ang = lim * dt; const float ar = mag * cosf(ang), ai = mag * sinf(ang);
                const float den = lr * lr + lim * lim, nr = ar - 1.0f, ni_ = ai;
                const float fre = (nr * lr + ni_ * lim) / den, fim = (ni_ * lr - nr * lim) / den;
                const size_t bi = (size_t)L * 2 * 32 * 64 * 16 + i; const float br = P.in[I_SBRE][bi], bim = P.in[I_SBIM][bi];
                BB[i] = (f32x2){fre * br - fim * bim, fre * bim + fim * br};
            }
            if (L == 0) {
                for (long i = gtid; i < SEQ * 32; i += NGT) { const int s = (int)(i >> 5), f = (int)(i & 31);
                    const float inv = powf(10000.0f, -(float)f / 32.0f); const float ang = (float)s * inv; ROPE[2 * i] = cosf(ang); ROPE[2 * i + 1] = sinf(ang); }
                LAS float* cact = (LAS float*)lds; LAS float* red = (LAS float*)(lds + 32768);
                __syncthreads();
                for (int it = bx; it < 192; it += G) {
                    const int ll = it / 96, j0 = (it % 96) * 64;
                    for (int i = tid; i < NB * DM; i += NTHR) { const float cv = P.in[I_C][i]; cact[i] = cv / (1.0f + expf(-cv)); }
                    __syncthreads();
                    float a[NB];
#pragma unroll
                    for (int b = 0; b < NB; ++b) a[b] = 0.f;
                    const float* aw = P.in[I_ADAW] + (size_t)ll * DM * 6144 + j0 + lane;
                    for (int k = wave * 128; k < wave * 128 + 128; ++k) { const float wv = aw[(size_t)k * 6144];
#pragma unroll
                        for (int b = 0; b < NB; ++b) a[b] += cact[b * DM + k] * wv; }
#pragma unroll
                    for (int b = 0; b < NB; ++b) red[(wave * NB + b) * 64 + lane] = a[b];
                    __syncthreads();
                    { const int b = tid >> 6; float s = P.in[I_ADAB][ll * 6144 + j0 + lane];
#pragma unroll
                      for (int w = 0; w < NWAVES; ++w) s += red[(w * NB + b) * 64 + lane];
                      MOD[((size_t)ll * NB + b) * 6144 + j0 + lane] = s; }
                    __syncthreads();
                }
            }
        }
        GRID_BAR();
        {
            PH_INIT;
            const float* xin = (L == 0) ? P.in[I_X] : xo; const float* nw = P.in[I_N1W] + L * DM;
            norm_rows(xin, nw, MOD + (size_t)L * NB * 6144, 0, XN, nullptr, gw, NGW, lane);
            if (gtid < 128) ((unsigned*)(ws + WS_KMAX))[gtid] = 0u;
            for (long i = gtid; i < 2 * 32 * 32 * 256; i += NGT) {
                const int ni = (int)(i & 15), no = (int)((i >> 4) & 15), tau = (int)((i >> 8) & 31), dg = (int)(i >> 13);
                const float* cre = P.in[I_SCRE] + (((size_t)L * 64 + dg) * 16 + no) * 64; const float* cim = P.in[I_SCIM] + (((size_t)L * 64 + dg) * 16 + no) * 64;
                const f32x2* pw = PW + ((size_t)dg * 33 + tau) * 64; const f32x2* bb = BB + (size_t)dg * 1024 + ni; float acc = 0.f;
                for (int p = 0; p < 64; ++p) { const f32x2 w = pw[p], bv = bb[p * 16]; const float cr = cre[p], ci = cim[p]; const float zr = cr * w.x - ci * w.y, zi = cr * w.y + ci * w.x; acc += zr * bv.x - zi * bv.y; }
                KM[i] = acc;
            }
            for (long i = gtid; i < 32 * 256 * 64; i += NGT) {
                const int k8 = (int)(i & 63), n = (int)((i >> 6) & 255), g = (int)(i >> 14); const int dir = n >> 7, ri = (n >> 6) & 1, p = n & 63; const int s = k8 >> 1, ni0 = (k8 & 1) * 8;
                const int e = dir == 0 ? (CH - 1 - s) : s; const f32x2 w = PW[((size_t)(dir * 32 + g) * 33 + e) * 64 + p]; const f32x2* bb = BB + ((size_t)(dir * 32 + g) * 64 + p) * 16 + ni0;
                float o[8];
#pragma unroll
                for (int q = 0; q < 8; ++q) { const f32x2 bv = bb[q]; o[q] = ri == 0 ? (w.x * bv.x - w.y * bv.y) : (w.x * bv.y + w.y * bv.x); }
                u32x4 ov; ov.x = cvt_pk_bf16(o[0], o[1]); ov.y = cvt_pk_bf16(o[2], o[3]); ov.z = cvt_pk_bf16(o[4], o[5]); ov.w = cvt_pk_bf16(o[6], o[7]);
                *(u32x4*)(EMAT + ((size_t)g * 256 + n) * 512 + k8 * 8) = ov;
            }
            for (long i = gtid; i < 32 * 512 * 32; i += NGT) {
                const int c8 = (int)(i & 31), n = (int)((i >> 5) & 511), g = (int)(i >> 14); const int t = n >> 4, no = n & 15; const int dir = c8 >> 4, ri = (c8 >> 3) & 1, p0 = (c8 & 7) * 8;
                const int e = dir == 0 ? (t + 1) : (CH - t); const f32x2* pw = PW + ((size_t)(dir * 32 + g) * 33 + e) * 64 + p0;
                const float* cre = P.in[I_SCRE] + ((((size_t)L * 2 + dir) * 32 + g) * 16 + no) * 64 + p0; const float* cim = P.in[I_SCIM] + ((((size_t)L * 2 + dir) * 32 + g) * 16 + no) * 64 + p0;
                float o[8];
#pragma unroll
                for (int q = 0; q < 8; ++q) { const f32x2 w = pw[q]; const float cr = cre[q], ci = cim[q]; o[q] = ri == 0 ? (cr * w.x - ci * w.y) : -(cr * w.y + ci * w.x); }
                u32x4 ov; ov.x = cvt_pk_bf16(o[0], o[1]); ov.y = cvt_pk_bf16(o[2], o[3]); ov.z = cvt_pk_bf16(o[4], o[5]); ov.w = cvt_pk_bf16(o[6], o[7]);
                *(u32x4*)(TMAT + ((size_t)g * 512 + n) * KX + 512 + c8 * 8) = ov;
            }
        }
        GRID_BAR();
        { PH_INIT; MAKE_E; E.mode = 1; RUN_GEMM(XN, WQKVU, 1024, 1024, 1024, 128, 14, 1, E); }
        GRID_BAR();
        { PH_INIT; MAKE_E; E.mode = 2; RUN_GEMM(UEXT, EMAT, KX, 512, 512, 4, 1, 32, E); }
        {
            PH_INIT;
            __builtin_amdgcn_fence(__ATOMIC_ACQUIRE, "agent");
            if (bx < 128 && tid < 256) {
                const int g = bx >> 2, pm = bx & 3; const int p = tid & 63, dir = (tid >> 6) & 1, b = 2 * pm + (tid >> 7);
                const f32x2 al = PW[((size_t)(dir * 32 + g) * 33 + CH) * 64 + p];
                float xr = 0.f, xi = 0.f;
                const float* xl = XLOC + ((size_t)g * (NB * NCH) + b * NCH) * 256 + dir * 128 + p;
                bf16_t* ue = UEXT + ((size_t)g * (NB * NCH) + b * NCH) * KX + 512 + dir * 128 + p;
#pragma unroll 1
                for (int cb0 = 0; cb0 < NCH; cb0 += 16) {
                    float lr[16], li[16];
#pragma unroll
                    for (int q = 0; q < 16; ++q) { const int c = dir == 0 ? cb0 + q : NCH - 1 - cb0 - q; lr[q] = xl[(size_t)c * 256]; li[q] = xl[(size_t)c * 256 + 64]; }
#pragma unroll
                    for (int q = 0; q < 16; ++q) { const int c = dir == 0 ? cb0 + q : NCH - 1 - cb0 - q;
                        ue[(size_t)c * KX] = (bf16_t)(cvt_pk_bf16(xr, 0.f) & 0xffffu); ue[(size_t)c * KX + 64] = (bf16_t)(cvt_pk_bf16(xi, 0.f) & 0xffffu);
                        const float nr = al.x * xr - al.y * xi + lr[q], nim = al.x * xi + al.y * xr + li[q]; xr = nr; xi = nim; }
                }
            }
        }
        {
            PH_INIT;
            const float* dsk = P.in[I_SD] + L * 512;
            { LAS float* red = (LAS float*)lds; unsigned* kmx = (unsigned*)(ws + WS_KMAX);
              for (int blk = vcu; blk < T / 128; blk += G) {
                  float mx = 0.f;
#pragma unroll 4
                  for (int k = 0; k < 16; ++k) { const int m = blk * 128 + wave * 16 + k; const u32x4* kp = (const u32x4*)(KB + (size_t)m * DM + lane * 16); const u32x4 a = kp[0], b2 = kp[1]; float ss = 0.f;
#pragma unroll
                      for (int q = 0; q < 4; ++q) { ss += bf_lo(a[q]) * bf_lo(a[q]) + bf_hi(a[q]) * bf_hi(a[q]) + bf_lo(b2[q]) * bf_lo(b2[q]) + bf_hi(b2[q]) * bf_hi(b2[q]); }
                      ss += shfl_xor_l(ss, 1, lane); ss += shfl_xor_l(ss, 2, lane); mx = fmaxf(mx, ss); }
                  __syncthreads();
                  if ((lane & 3) == 0) red[wave * 16 + (lane >> 2)] = mx;
                  __syncthreads();
                  if (tid < 16) { float m2 = red[tid];
#pragma unroll
                      for (int w = 1; w < NWAVES; ++w) m2 = fmaxf(m2, red[w * 16 + tid]);
                      __hip_atomic_fetch_max(kmx + (blk >> 5) * 16 + tid, __float_as_uint(m2), __ATOMIC_RELAXED, __HIP_MEMORY_SCOPE_AGENT); }
              }
              __syncthreads(); }
            for (long i = gtid; i < 32 * 512 * 64; i += NGT) {
                const int k8 = (int)(i & 63), n = (int)((i >> 6) & 511), g = (int)(i >> 15); const int t = n >> 4, no = n & 15, s = k8 >> 1, ni0 = (k8 & 1) * 8;
                float o[8];
                if (t != s) { const int dir = t > s ? 0 : 1, tau = t > s ? t - s : s - t; const float* km = KM + ((((size_t)(dir * 32 + g)) * 32 + tau) * 16 + no) * 16 + ni0;
#pragma unroll
                    for (int q = 0; q < 8; ++q) o[q] = km[q];
                } else { const float* k0 = KM + (((size_t)(g) * 32) * 16 + no) * 16 + ni0; const float* k1 = KM + (((size_t)(32 + g) * 32) * 16 + no) * 16 + ni0;
#pragma unroll
                    for (int q = 0; q < 8; ++q) o[q] = k0[q] + k1[q] + ((ni0 + q) == no ? dsk[g * 16 + no] : 0.f);
                }
                u32x4 ov; ov.x = cvt_pk_bf16(o[0], o[1]); ov.y = cvt_pk_bf16(o[2], o[3]); ov.z = cvt_pk_bf16(o[4], o[5]); ov.w = cvt_pk_bf16(o[6], o[7]);
                *(u32x4*)(TMAT + ((size_t)g * 512 + n) * KX + k8 * 8) = ov;
            }
        }
        GRID_BAR();
        {
            PH_INIT;
            float s1 = wave_sum(P.in[I_LQ1][L * 64 + lane] * P.in[I_LK1][L * 64 + lane], lane), s2 = wave_sum(P.in[I_LQ2][L * 64 + lane] * P.in[I_LK2][L * 64 + lane], lane);
            const float lam = expf(s1) - expf(s2) + lambda_init;
            for (int i = 0; i < 4; ++i) { const int u = i * G + vcu; if (u >= 1024) break; const int bh = u >> 4, qb = u & 15;
                att::attn_unit(bh >> 3, bh & 7, qb, QB, KB, VB, QB, SCR + (size_t)bx * 32768, (const unsigned*)(ws + WS_KMAX), lam, 1.0f - lambda_init, P.in[I_SUBW] + L * 128, (char*)lds_raw); }
            __syncthreads();
        }
        { PH_INIT; MAKE_E; E.mode = 3; RUN_GEMM(UEXT, TMAT, KX, KX, KX, 4, 2, 32, E); }
        GRID_BAR();
        { PH_INIT; MAKE_E; E.mode = 4; RUN_GEMM(XN, WG, 1024, 1024, 1024, 128, 8, 1, E); }
        { PH_INIT; MAKE_E; E.mode = 5; RUN_GEMM(YB, WGLU, 512, 512, 512, 128, 8, 1, E); }
        GRID_BAR();
        { PH_INIT; MAKE_E; E.mode = 6; RUN_GEMM(QB, WAO, 1024, 1024, 1024, 128, 4, 1, E); }
        GRID_BAR();
        { PH_INIT; MAKE_E; E.mode = 7; E.gate = MOD + (size_t)L * NB * 6144 + 2048; E.base = (L == 0) ? P.in[I_X] : xo; RUN_GEMM(KB, WOUT, 1024, 1024, 1024, 128, 4, 1, E); }
        GRID_BAR();
        {
            PH_INIT;
            const float* nw = P.in[I_N2W] + L * DM;
            norm_rows(xo, nw, MOD + (size_t)L * NB * 6144, 3072, XN, nullptr, gw, NGW, lane);
        }
        GRID_BAR();
#pragma unroll 1
        for (int hf = 0; hf < 2; ++hf) {
            { PH_INIT; MAKE_E; E.mode = 8; RUN_GEMM(XN + (size_t)hf * 16384 * DM, WUP, 1024, 1024, 1024, 64, 22, 1, E); }
            GRID_BAR();
            {
                PH_INIT;
                const float* cw = P.in[I_CONVW] + (size_t)L * 3 * NUP; const float* cb = P.in[I_CONVB] + (size_t)L * NUP;
                for (long it = gtid; it < 2048L * 352; it += NGT) {
                    const int rb = (int)(it / 352), jc = (int)(it % 352), j = jc * 8, r0 = rb * 8;
                    const u32x4 z4 = (u32x4){0u, 0u, 0u, 0u};
                    u32x4 rv[10], rg[10];
                    const bf16_t* up0 = UPH + (size_t)r0 * NUP + j;
                    if ((r0 & (SEQ - 1)) != 0) { rv[0] = *(const u32x4*)(up0 - NUP); rg[0] = *(const u32x4*)(up0 - NUP + DFF); } else { rv[0] = z4; rg[0] = z4; }
#pragma unroll
                    for (int q = 0; q < 8; ++q) { rv[q + 1] = *(const u32x4*)(up0 + (size_t)q * NUP); rg[q + 1] = *(const u32x4*)(up0 + (size_t)q * NUP + DFF); }
                    if (((r0 + 8) & (SEQ - 1)) != 0) { rv[9] = *(const u32x4*)(up0 + (size_t)8 * NUP); rg[9] = *(const u32x4*)(up0 + (size_t)8 * NUP + DFF); } else { rv[9] = z4; rg[9] = z4; }
                    float wv[3][8], wg[3][8], bv[8], bg[8];
#pragma unroll
                    for (int k = 0; k < 3; ++k) { const f32x4 a0 = *(const f32x4*)(cw + k * NUP + j), a1 = *(const f32x4*)(cw + k * NUP + j + 4), g0 = *(const f32x4*)(cw + k * NUP + DFF + j), g1 = *(const f32x4*)(cw + k * NUP + DFF + j + 4);
#pragma unroll
                        for (int q = 0; q < 4; ++q) { wv[k][q] = a0[q]; wv[k][q + 4] = a1[q]; wg[k][q] = g0[q]; wg[k][q + 4] = g1[q]; } }
                    { const f32x4 a0 = *(const f32x4*)(cb + j), a1 = *(const f32x4*)(cb + j + 4), g0 = *(const f32x4*)(cb + DFF + j), g1 = *(const f32x4*)(cb + DFF + j + 4);
#pragma unroll
                      for (int q = 0; q < 4; ++q) { bv[q] = a0[q]; bv[q + 4] = a1[q]; bg[q] = g0[q]; bg[q + 4] = g1[q]; } }
                    bf16_t* ao = ACT + ((size_t)hf * 16384 + r0) * DFF + j;
#pragma unroll
                    for (int r = 0; r < 8; ++r) {
                        float o[8];
#pragma unroll
                        for (int q2 = 0; q2 < 4; ++q2) {
                            const float v0 = wv[0][2 * q2] * bf_lo(rv[r][q2]) + wv[1][2 * q2] * bf_lo(rv[r + 1][q2]) + wv[2][2 * q2] * bf_lo(rv[r + 2][q2]) + bv[2 * q2];
                            const float v1 = wv[0][2 * q2 + 1] * bf_hi(rv[r][q2]) + wv[1][2 * q2 + 1] * bf_hi(rv[r + 1][q2]) + wv[2][2 * q2 + 1] * bf_hi(rv[r + 2][q2]) + bv[2 * q2 + 1];
                            const float g0 = wg[0][2 * q2] * bf_lo(rg[r][q2]) + wg[1][2 * q2] * bf_lo(rg[r + 1][q2]) + wg[2][2 * q2] * bf_lo(rg[r + 2][q2]) + bg[2 * q2];
                            const float g1 = wg[0][2 * q2 + 1] * bf_hi(rg[r][q2]) + wg[1][2 * q2 + 1] * bf_hi(rg[r + 1][q2]) + wg[2][2 * q2 + 1] * bf_hi(rg[r + 2][q2]) + bg[2 * q2 + 1];
                            o[2 * q2] = g0 * sigmoidf_(g0) * v0; o[2 * q2 + 1] = g1 * sigmoidf_(g1) * v1;
                        }
                        u32x4 ov; ov.x = cvt_pk_bf16(o[0], o[1]); ov.y = cvt_pk_bf16(o[2], o[3]); ov.z = cvt_pk_bf16(o[4], o[5]); ov.w = cvt_pk_bf16(o[6], o[7]);
                        *(u32x4*)(ao + (size_t)r * DFF) = ov;
                    }
                }
            }
            GRID_BAR();
        }
        { PH_INIT; MAKE_E; E.mode = 7; E.gate = MOD + (size_t)L * NB * 6144 + 5120; E.base = xo; RUN_GEMM(ACT, WDOWN, DFF, DFF, DFF, 128, 4, 1, E); }
        GRID_BAR();
    }
    {
        const int l = 2;
        PH_INIT;
        const float* nw = P.in[I_FINW];
        norm_rows(xo, nw, nullptr, 0, nullptr, xo, gw, NGW, lane);
    }
}

extern "C" void kernel_launch(void* const* d_in, const int* in_sizes, int n_in, void* d_out, int out_size, void* d_ws, size_t ws_size, hipStream_t stream) {
    static int grid = 0;
    if (grid == 0) {
        if (n_in != 29 || out_size != T * DM || ws_size < WS_END) { fprintf(stderr, "kernel_launch: unexpected shapes n_in %d out %d ws %zu (need %zu)\n", n_in, out_size, ws_size, (size_t)WS_END); grid = -1; return; }
        int dev = 0, cus = 0, per_cu = 0;
        (void)hipGetDevice(&dev); (void)hipDeviceGetAttribute(&cus, hipDeviceAttributeMultiprocessorCount, dev);
        if (hipFuncSetAttribute((const void*)mega, hipFuncAttributeMaxDynamicSharedMemorySize, LDS_BYTES) != hipSuccess) { fprintf(stderr, "kernel_launch: hipFuncSetAttribute failed\n"); grid = -1; return; }
        (void)hipOccupancyMaxActiveBlocksPerMultiprocessor(&per_cu, (const void*)mega, NTHR, LDS_BYTES);
        if (per_cu < 1) { fprintf(stderr, "kernel_launch: occupancy query says %d blocks per CU\n", per_cu); per_cu = 1; }
        (void)hipGetLastError();
        grid = cus;
    }
    if (grid < 0) return;
    Params p{};
    for (int i = 0; i < 29; ++i) p.in[i] = (const float*)d_in[i];
    p.out = (float*)d_out; p.ws = (unsigned char*)d_ws;
    void* args[] = {&p};
    hipError_t e = hipLaunchCooperativeKernel((const void*)mega, dim3(grid), dim3(NTHR), args, LDS_BYTES, stream);
    if (e != hipSuccess) fprintf(stderr, "cooperative launch failed: %s (grid %d)\n", hipGetErrorString(e), grid);
}
```

```cpp
#include <hip/hip_runtime.h>
#include <hip/hip_cooperative_groups.h>
#include <cstdio>
#include <cstdint>
namespace cg = cooperative_groups;

#define LAS __attribute__((address_space(3)))
#define GAS __attribute__((address_space(1)))
typedef unsigned short bf16_t;
typedef short bf16x8 __attribute__((ext_vector_type(8)));
typedef short s16x4 __attribute__((ext_vector_type(4)));
typedef float f32x2 __attribute__((ext_vector_type(2)));
typedef float f32x4 __attribute__((ext_vector_type(4)));
typedef float f32x16 __attribute__((ext_vector_type(16)));
typedef unsigned u32x2 __attribute__((ext_vector_type(2)));
typedef unsigned u32x4 __attribute__((ext_vector_type(4)));

constexpr int NB = 8, SEQ = 4096, DM = 1024, T = NB * SEQ, DFF = 2816, NUP = 2 * DFF, NWAVES = 8, NTHR = 512;
constexpr int CH = 32, NCH = SEQ / CH, KX = 768;
constexpr size_t MiB = 1u << 20;
constexpr size_t WS_APAN = 768 * 1024;
constexpr size_t WS_CNT = 128 * 1024, WS_XS = 256 * 1024;
constexpr size_t WS_KMAX = 64 * 1024, WS_MOD = 1 * MiB, WS_ROPE = 2 * MiB, WS_PW = 3 * MiB, WS_BB = 5 * MiB, WS_KM = 6 * MiB;
constexpr size_t WS_WQKVU = 8 * MiB, WS_WG = 15 * MiB, WS_WAO = 19 * MiB, WS_WGLU = 21 * MiB, WS_WOUT = 23 * MiB, WS_WUP = 25 * MiB, WS_WDOWN = 36 * MiB;
constexpr size_t WS_TMAT = 42 * MiB, WS_EMAT = 66 * MiB, WS_XN = 74 * MiB;
constexpr size_t WS_Q = 138 * MiB, WS_K = 202 * MiB, WS_V = 266 * MiB, WS_UEXT = 330 * MiB, WS_XLOC = 378 * MiB, WS_SCR = 410 * MiB;
constexpr size_t WS_OS = 442 * MiB;
constexpr size_t WS_UP = 138 * MiB, WS_ACT = 314 * MiB, WS_END = 506 * MiB;
constexpr int LDS_BYTES = 147456;

struct Params {
    const float* in[29];
    float* out;
    unsigned char* ws;
};
enum { I_X = 0, I_C, I_N1W, I_N2W, I_ADAW, I_ADAB, I_WIN, I_LQ1, I_LK1, I_LQ2, I_LK2, I_SUBW, I_WAO, I_SLRE, I_SLIM, I_SLDT, I_SBRE, I_SBIM, I_SCRE, I_SCIM, I_SD,
       I_WGA, I_WGB, I_WOUT, I_WUP, I_CONVW, I_CONVB, I_WDOWN, I_FINW };

__device__ __forceinline__ unsigned cvt_pk_bf16(float lo, float hi) { unsigned r; asm volatile("v_cvt_pk_bf16_f32 %0, %1, %2" : "=v"(r) : "v"(lo), "v"(hi)); return r; }
__device__ __forceinline__ float bf_lo(unsigned w) { return __uint_as_float(w << 16); }
__device__ __forceinline__ float bf_hi(unsigned w) { return __uint_as_float(w & 0xffff0000u); }
__device__ __forceinline__ float sigmoidf_(float x) { return 1.0f / (1.0f + __expf(-x)); }
__device__ __forceinline__ float gelu_tanh(float x) { const float z = 0.7978845608028654f * (x + 0.044715f * x * x * x); return x / (1.0f + __expf(-2.0f * z)); }
__device__ __forceinline__ float shfl_xor_l(float v, int x, int lane) { return __uint_as_float((unsigned)__builtin_amdgcn_ds_bpermute((lane ^ x) << 2, (int)__float_as_uint(v))); }
__device__ __forceinline__ float wave_sum(float v, int lane) {
#pragma unroll
    for (int o = 1; o < 64; o <<= 1) v += shfl_xor_l(v, o, lane);
    return v;
}

namespace pg8 {
constexpr int BM = 256, BK = 64, HALF = 128, HTB = HALF * BK * 2, NXCD = 8, WGM = 8;
__host__ __device__ __forceinline__ int lds_byte(int r, int c) { const int st = (r >> 4) * 2 + (c >> 5), rr = r & 15, cc = c & 31, ob = rr * 64 + cc * 2; return st * 1024 + (ob ^ (((ob >> 9) & 1) << 5)); }
__host__ __device__ __forceinline__ void stage_rc(int b, int& R, int& C) { const int st = b / 1024, sb = b % 1024, swz = sb ^ (((sb >> 9) & 1) << 5); R = (st >> 1) * 16 + swz / 64; C = (st & 1) * 32 + (swz % 64) / 2; }

__host__ __device__ __forceinline__ int perm32(int rho) { const int n = rho >> 4, i = rho & 15; return 8 * (i >> 2) + 4 * n + (i & 3); }
struct Unit { int pm, pn, grp; };
struct Gemm { const bf16_t* A; const bf16_t* Bt; int lda, ldb, K, nM, nN, ngrp, ovl; };
struct Order {
    int nM, nN, ngrp, nwg, G, c, single; Unit one;
    __device__ __forceinline__ void init(const Gemm& g, int G_, int c_) { nM = g.nM; nN = g.nN; ngrp = g.ngrp; nwg = nM * nN * ngrp; G = G_; c = c_; single = 0; one.pm = 0; one.pn = 0; one.grp = 0; }
    __device__ __forceinline__ bool next(int i, Unit& u) const {
        if (single) { if (i) return false; u = one; return true; }
        const long L = (long)i * G + c; if (L >= nwg) return false;
        if (ngrp == 1) {
            int wgid = (int)L; { const int q = nwg / NXCD, r = nwg % NXCD, xcd = wgid % NXCD, off = wgid / NXCD; wgid = (xcd < r ? xcd * (q + 1) : r * (q + 1) + (xcd - r) * q) + off; }
            const int nig = WGM * nN, gid = wgid / nig, fm = gid * WGM, gsz = (nM - fm) < WGM ? (nM - fm) : WGM;
            u.pm = fm + ((wgid % nig) % gsz); u.pn = (wgid % nig) / gsz; u.grp = 0;
        } else {
            const int per = nM * nN; const int w = (int)(L % per); u.grp = (int)(L / per); u.pm = w % nM; u.pn = w / nM;
        }
        return true;
    }
};

struct Epi {
    int mode, layer;
    bf16_t *Q, *Kb, *Vb, *Uext, *Y, *TS, *ACT, *OS, *RAWb; const float *cw, *cb;
    int nf; const float *nw, *nmod; bf16_t* XNo; float* xs; unsigned* cnt;
    float* xloc; const float* rope; const float* gate; const float* base; float* xout;
    static __device__ __forceinline__ u32x4 pack8(const f32x4 a, const f32x4 b) { u32x4 w; w.x = cvt_pk_bf16(a[0], a[1]); w.y = cvt_pk_bf16(a[2], a[3]); w.z = cvt_pk_bf16(b[0], b[1]); w.w = cvt_pk_bf16(b[2], b[3]); return w; }
    __device__ __forceinline__ void fused(const f32x4 (&acc)[2][2][4][2], const Unit& u, int wr, int wc, int fr, int fq, LAS unsigned char* lds) const {
        constexpr int RS = 528;
        LAS unsigned char* tb = lds + RS;
#pragma unroll
        for (int ai = 0; ai < 2; ++ai)
#pragma unroll
            for (int m = 0; m < 4; ++m)
#pragma unroll
                for (int bj = 0; bj < 2; ++bj) *(LAS u32x4*)(tb + (ai * HALF + wr * 64 + m * 16 + fr) * RS + (bj * HALF + wc * 32 + fq * 8) * 2) = pack8(acc[ai][bj][m][0], acc[ai][bj][m][1]);
        asm volatile("s_waitcnt lgkmcnt(0)" ::: "memory"); __builtin_amdgcn_s_barrier(); asm volatile("" ::: "memory");
        int tid2 = (wr * 4 + wc) * 64 + fq * 16 + fr; asm volatile("" : "+v"(tid2));
        const int cp = tid2 & 15, rg = tid2 >> 4;
        const int bb = u.pm >> 4, ti = u.pm & 15, s0 = 256 * ti; const int j0 = u.pn * 128 + cp * 8;
        u32x4 ra[10], rb[10];
        { const LAS unsigned char* p0 = tb + (8 * rg - 1) * RS + cp * 32;
#pragma unroll
          for (int q = 0; q < 10; ++q) { ra[q] = *(const LAS u32x4*)(p0 + q * RS); rb[q] = *(const LAS u32x4*)(p0 + q * RS + 16); } }
        float wv[3][8], wg[3][8], bv[8], bg[8];
#pragma unroll
        for (int k = 0; k < 3; ++k) { const f32x4 a0 = *(const GAS f32x4*)(cw + k * NUP + j0), a1 = *(const GAS f32x4*)(cw + k * NUP + j0 + 4), g0 = *(const GAS f32x4*)(cw + k * NUP + DFF + j0), g1 = *(const GAS f32x4*)(cw + k * NUP + DFF + j0 + 4);
#pragma unroll
            for (int q = 0; q < 4; ++q) { wv[k][q] = a0[q]; wv[k][q + 4] = a1[q]; wg[k][q] = g0[q]; wg[k][q + 4] = g1[q]; } }
        { const f32x4 a0 = *(const GAS f32x4*)(cb + j0), a1 = *(const GAS f32x4*)(cb + j0 + 4), g0 = *(const GAS f32x4*)(cb + DFF + j0), g1 = *(const GAS f32x4*)(cb + DFF + j0 + 4);
#pragma unroll
          for (int q = 0; q < 4; ++q) { bv[q] = a0[q]; bv[q + 4] = a1[q]; bg[q] = g0[q]; bg[q + 4] = g1[q]; } }
        asm volatile("s_waitcnt lgkmcnt(0)" ::: "memory"); __builtin_amdgcn_s_barrier(); asm volatile("" ::: "memory");
        if (rg == 0) { bf16_t* rp = RAWb + ((size_t)u.pm * 4) * NUP + u.pn * 256 + cp * 16; *(GAS u32x4*)rp = ra[1]; *(GAS u32x4*)(rp + 8) = rb[1]; *(GAS u32x4*)(rp + NUP) = ra[2]; *(GAS u32x4*)(rp + NUP + 8) = rb[2]; }
        if (rg == 31) { bf16_t* rp = RAWb + ((size_t)u.pm * 4 + 2) * NUP + u.pn * 256 + cp * 16; *(GAS u32x4*)rp = ra[7]; *(GAS u32x4*)(rp + 8) = rb[7]; *(GAS u32x4*)(rp + NUP) = ra[8]; *(GAS u32x4*)(rp + NUP + 8) = rb[8]; }
#pragma unroll
        for (int r = 0; r < 8; ++r) {
            const int tl = 8 * rg + r, s = s0 + tl;
            if ((tl >= 1 && tl <= 254) || (tl == 0 && ti == 0) || (tl == 255 && ti == 15)) {
                const bool pz = (s == 0), nz = (s == SEQ - 1); const u32x4 z4 = (u32x4){0u, 0u, 0u, 0u};
                float o[8];
#pragma unroll
                for (int h = 0; h < 2; ++h) {
                    const u32x4 p = pz ? z4 : (h ? rb[r] : ra[r]), c = h ? rb[r + 1] : ra[r + 1], n = nz ? z4 : (h ? rb[r + 2] : ra[r + 2]);
#pragma unroll
                    for (int q2 = 0; q2 < 2; ++q2) { const int e = 4 * h + 2 * q2;
                        const float v0 = wv[0][e] * bf_lo(p[q2]) + wv[1][e] * bf_lo(c[q2]) + wv[2][e] * bf_lo(n[q2]) + bv[e];
                        const float v1 = wv[0][e + 1] * bf_hi(p[q2]) + wv[1][e + 1] * bf_hi(c[q2]) + wv[2][e + 1] * bf_hi(n[q2]) + bv[e + 1];
                        const float g0 = wg[0][e] * bf_lo(p[2 + q2]) + wg[1][e] * bf_lo(c[2 + q2]) + wg[2][e] * bf_lo(n[2 + q2]) + bg[e];
                        const float g1 = wg[0][e + 1] * bf_hi(p[2 + q2]) + wg[1][e + 1] * bf_hi(c[2 + q2]) + wg[2][e + 1] * bf_hi(n[2 + q2]) + bg[e + 1];
                        o[e] = g0 * sigmoidf_(g0) * v0; o[e + 1] = g1 * sigmoidf_(g1) * v1; }
                }
                u32x4 ov; ov.x = cvt_pk_bf16(o[0], o[1]); ov.y = cvt_pk_bf16(o[2], o[3]); ov.z = cvt_pk_bf16(o[4], o[5]); ov.w = cvt_pk_bf16(o[6], o[7]);
                *(GAS u32x4*)(ACT + ((size_t)bb * SEQ + s) * DFF + j0) = ov;
            }
        }
    }
    __device__ __forceinline__ void resnorm(f32x4 (&acc)[2][2][4][2], const Unit& u, int wr, int wc, int fr, int fq, LAS unsigned char* lds) const {
        LAS float* Pt = (LAS float*)(lds + 131072); LAS float* St = (LAS float*)(lds + 131072 + 4096);
        const int colt = u.pn * BM; const int cc0 = colt + wc * 32 + fq * 8; const int bb = (u.pm * BM) >> 12;
        int lane_ = fq * 16 + fr; asm volatile("" : "+v"(lane_));
        f32x4 gv[2][2];
#pragma unroll
        for (int bj = 0; bj < 2; ++bj) { const float* gp = gate + (size_t)bb * 6144 + cc0 + bj * HALF; gv[bj][0] = *(const f32x4*)gp; gv[bj][1] = *(const GAS f32x4*)(gp + 4); }
#pragma unroll
        for (int ai = 0; ai < 2; ++ai)
#pragma unroll
            for (int m = 0; m < 4; ++m) {
                float s = 0.f;
#pragma unroll
                for (int bj = 0; bj < 2; ++bj) { const size_t off = (size_t)(u.pm * BM + ai * HALF + wr * 64 + m * 16 + fr) * DM + cc0 + bj * HALF;
                    const f32x4 x0 = *(const GAS f32x4*)(base + off) + gv[bj][0] * acc[ai][bj][m][0], x1 = *(const GAS f32x4*)(base + off + 4) + gv[bj][1] * acc[ai][bj][m][1];
                    if (nf != 2) { *(GAS f32x4*)(xout + off) = x0; *(GAS f32x4*)(xout + off + 4) = x1; } acc[ai][bj][m][0] = x0; acc[ai][bj][m][1] = x1;
                    s += (x0[0] * x0[0] + x0[1] * x0[1]) + (x0[2] * x0[2] + x0[3] * x0[3]) + (x1[0] * x1[0] + x1[1] * x1[1]) + (x1[2] * x1[2] + x1[3] * x1[3]); }
                s += shfl_xor_l(s, 16, lane_); s += shfl_xor_l(s, 32, lane_);
                if (fq == 0) Pt[(ai * HALF + wr * 64 + m * 16 + fr) * 4 + wc] = s;
            }
        asm volatile("s_waitcnt lgkmcnt(0)" ::: "memory"); __builtin_amdgcn_s_barrier(); asm volatile("" ::: "memory");
        int tid_ = (wr * 4 + wc) * 64 + lane_; asm volatile("" : "+v"(tid_));
        unsigned* cw_ = cnt + 64 * u.pm;
        if (tid_ < 256) { const float tot = (Pt[tid_ * 4 + 0] + Pt[tid_ * 4 + 1]) + (Pt[tid_ * 4 + 2] + Pt[tid_ * 4 + 3]);
            __hip_atomic_store(xs + ((size_t)(u.pm * BM + tid_) * 4 + u.pn), tot, __ATOMIC_RELAXED, __HIP_MEMORY_SCOPE_AGENT);
            asm volatile("s_waitcnt vmcnt(0)" ::: "memory");
            if (lane_ == 0) __hip_atomic_fetch_add(cw_, 1u, __ATOMIC_RELAXED, __HIP_MEMORY_SCOPE_AGENT); }
        if (tid_ < 64) {
            unsigned sp = 0;
            while ((unsigned)__builtin_amdgcn_readfirstlane((int)__hip_atomic_load(cw_, __ATOMIC_RELAXED, __HIP_MEMORY_SCOPE_AGENT)) < 16u) { __builtin_amdgcn_s_sleep(2); if (++sp > (1u << 22)) break; }
            __builtin_amdgcn_fence(__ATOMIC_ACQUIRE, "agent");
        }
        asm volatile("s_waitcnt vmcnt(0) lgkmcnt(0)" ::: "memory"); __builtin_amdgcn_s_barrier(); asm volatile("" ::: "memory");
        if (tid_ < 256) { const float* sl = xs + (size_t)(u.pm * BM + tid_) * 4;
            const float t0 = __hip_atomic_load(sl + 0, __ATOMIC_RELAXED, __HIP_MEMORY_SCOPE_AGENT), t1 = __hip_atomic_load(sl + 1, __ATOMIC_RELAXED, __HIP_MEMORY_SCOPE_AGENT),
                        t2 = __hip_atomic_load(sl + 2, __ATOMIC_RELAXED, __HIP_MEMORY_SCOPE_AGENT), t3 = __hip_atomic_load(sl + 3, __ATOMIC_RELAXED, __HIP_MEMORY_SCOPE_AGENT);
            St[tid_] = rsqrtf(((t0 + t1) + (t2 + t3)) * (1.0f / DM) + 1e-6f); }
        asm volatile("s_waitcnt lgkmcnt(0)" ::: "memory"); __builtin_amdgcn_s_barrier(); asm volatile("" ::: "memory");
        if (nf == 2) {
#pragma unroll
            for (int bj = 0; bj < 2; ++bj) { const int cc = cc0 + bj * HALF; const f32x4 w0 = *(const GAS f32x4*)(nw + cc), w1 = *(const GAS f32x4*)(nw + cc + 4);
#pragma unroll
                for (int ai = 0; ai < 2; ++ai)
#pragma unroll
                    for (int m = 0; m < 4; ++m) { const int rl = ai * HALF + wr * 64 + m * 16 + fr; const float r = St[rl]; float* o = xout + (size_t)(u.pm * BM + rl) * DM + cc;
                        *(GAS f32x4*)o = acc[ai][bj][m][0] * r * w0; *(GAS f32x4*)(o + 4) = acc[ai][bj][m][1] * r * w1; } }
            return;
        }
        const float* md = nmod + (size_t)bb * 6144;
#pragma unroll
        for (int bj = 0; bj < 2; ++bj) {
            const int cc = cc0 + bj * HALF;
            const f32x4 w0 = *(const GAS f32x4*)(nw + cc), w1 = *(const GAS f32x4*)(nw + cc + 4), sh0 = *(const GAS f32x4*)(md + cc), sh1 = *(const GAS f32x4*)(md + cc + 4), sc0 = *(const GAS f32x4*)(md + 1024 + cc), sc1 = *(const GAS f32x4*)(md + 1024 + cc + 4);
            const f32x4 a0 = w0 * (sc0 + 1.0f), a1 = w1 * (sc1 + 1.0f);
#pragma unroll
            for (int ai = 0; ai < 2; ++ai)
#pragma unroll
                for (int m = 0; m < 4; ++m) { const int rl = ai * HALF + wr * 64 + m * 16 + fr; const float r = St[rl];
                    *(GAS u32x4*)(XNo + (size_t)(u.pm * BM + rl) * DM + cc) = pack8(acc[ai][bj][m][0] * r * a0 + sh0, acc[ai][bj][m][1] * r * a1 + sh1); }
        }
    }
    __device__ __forceinline__ void operator()(const f32x4 (&acc)[2][2][4][2], const Unit& u, int wr, int wc, int fr, int fq) const {
        const int colt = u.pn * BM;
#pragma unroll
        for (int ai = 0; ai < 2; ++ai)
#pragma unroll
            for (int m = 0; m < 4; ++m) {
                const int rl = ai * HALF + wr * 64 + m * 16 + fr;
                const int row = u.pm * BM + rl;
#pragma unroll
                for (int bj = 0; bj < 2; ++bj) {
                    const int cl = bj * HALF + wc * 32 + fq * 8;
                    const f32x4 v0 = acc[ai][bj][m][0], v1 = acc[ai][bj][m][1];
                    if (mode == 1) {
                        if (colt < 2048) {
                            bf16_t* dst = colt < 1024 ? Q : Kb; const int cc = (colt & 1023) + cl; const int s = row & (SEQ - 1); const int i = (cc & 63) >> 1;
                            const f32x4 c0 = *(const GAS f32x4*)(rope + ((size_t)s * 32 + i) * 2), c1 = *(const GAS f32x4*)(rope + ((size_t)s * 32 + i) * 2 + 4);
                            const f32x4 o0 = {v0[0] * c0[0] - v0[1] * c0[1], v0[1] * c0[0] + v0[0] * c0[1], v0[2] * c0[2] - v0[3] * c0[3], v0[3] * c0[2] + v0[2] * c0[3]};
                            const f32x4 o1 = {v1[0] * c1[0] - v1[1] * c1[1], v1[1] * c1[0] + v1[0] * c1[1], v1[2] * c1[2] - v1[3] * c1[3], v1[3] * c1[2] + v1[2] * c1[3]};
                            const float qsc = colt < 1024 ? 0.18033688011112042f : 1.0f;
                            *(GAS u32x4*)(dst + (size_t)row * DM + cc) = pack8(o0 * qsc, o1 * qsc);
                        } else if (colt < 3072) {
                            *(GAS u32x4*)(Vb + (size_t)row * DM + (colt - 2048) + cl) = pack8(v0, v1);
                        } else {
                            const int uc = colt - 3072 + cl, g = uc >> 4, ni = uc & 15; const int b = row >> 12, s = row & (SEQ - 1), ch = s >> 5, sl = s & 31;
                            *(GAS u32x4*)(Uext + ((size_t)(g * (NB * NCH) + b * NCH + ch)) * KX + sl * 16 + ni) = pack8(v0, v1);
                        }
                    } else if (mode == 2) {
                        float* p = xloc + ((size_t)(u.grp * (NB * NCH) + row)) * 256 + cl; *(GAS f32x4*)p = v0; *(GAS f32x4*)(p + 4) = v1;
                    } else if (mode == 3) {
                        const int b = row >> 7, ch = row & 127; const int nn = colt + cl, t = nn >> 4, no = nn & 15; const size_t tok = (size_t)b * SEQ + ch * CH + t;
                        const f32x4 g0 = {gelu_tanh(v0[0]), gelu_tanh(v0[1]), gelu_tanh(v0[2]), gelu_tanh(v0[3])}, g1 = {gelu_tanh(v1[0]), gelu_tanh(v1[1]), gelu_tanh(v1[2]), gelu_tanh(v1[3])};
                        *(GAS u32x4*)(Y + tok * 512 + u.grp * 16 + no) = pack8(g0, g1);
                    } else if (mode == 4) {
                        bf16_t* dst = colt < 1024 ? Kb : Vb; const int cc = (colt & 1023) + cl;
                        const f32x4 g0 = {sigmoidf_(v0[0]), sigmoidf_(v0[1]), sigmoidf_(v0[2]), sigmoidf_(v0[3])}, g1 = {sigmoidf_(v1[0]), sigmoidf_(v1[1]), sigmoidf_(v1[2]), sigmoidf_(v1[3])};
                        *(GAS u32x4*)(dst + (size_t)row * DM + cc) = pack8(g0, g1);
                    } else if (mode == 5) {
                        const int cc = u.pn * 128 + bj * 64 + wc * 16 + fq * 4;
                        u32x2 w; w.x = cvt_pk_bf16(v0[0] * sigmoidf_(v1[0]), v0[1] * sigmoidf_(v1[1])); w.y = cvt_pk_bf16(v0[2] * sigmoidf_(v1[2]), v0[3] * sigmoidf_(v1[3]));
                        *(GAS u32x2*)(OS + (size_t)row * DM + cc) = w;
                    } else if (mode == 6) {
                        const int cc = colt + cl; bf16_t* p = Kb + (size_t)row * DM + cc; const u32x4 sg = *(const GAS u32x4*)p; const u32x4 ss = *(const GAS u32x4*)(Vb + (size_t)row * DM + cc); const u32x4 os = *(const GAS u32x4*)(OS + (size_t)row * DM + cc);
                        const f32x4 o0 = {bf_lo(sg.x) * v0[0] + bf_lo(ss.x) * bf_lo(os.x), bf_hi(sg.x) * v0[1] + bf_hi(ss.x) * bf_hi(os.x), bf_lo(sg.y) * v0[2] + bf_lo(ss.y) * bf_lo(os.y), bf_hi(sg.y) * v0[3] + bf_hi(ss.y) * bf_hi(os.y)};
                        const f32x4 o1 = {bf_lo(sg.z) * v1[0] + bf_lo(ss.z) * bf_lo(os.z), bf_hi(sg.z) * v1[1] + bf_hi(ss.z) * bf_hi(os.z), bf_lo(sg.w) * v1[2] + bf_lo(ss.w) * bf_lo(os.w), bf_hi(sg.w) * v1[3] + bf_hi(ss.w) * bf_hi(os.w)};
                        *(GAS u32x4*)p = pack8(o0, o1);
                    } else if (mode == 7) {
                        const int cc = colt + cl; const int b = row >> 12; const float* gp = gate + (size_t)b * 6144 + cc; const f32x4 g0 = *(const f32x4*)gp, g1 = *(const GAS f32x4*)(gp + 4); const size_t off = (size_t)row * DM + cc;
                        const f32x4 b0 = *(const GAS f32x4*)(base + off), b1 = *(const GAS f32x4*)(base + off + 4); *(GAS f32x4*)(xout + off) = b0 + g0 * v0; *(GAS f32x4*)(xout + off + 4) = b1 + g1 * v1;
                    }
                }
            }
    }
};

__device__ __forceinline__ void gemm_phase(LAS unsigned char* lds, const Gemm g, const Order& S, const Epi& E) {
    int tid = threadIdx.x; asm volatile("" : "+v"(tid));
    const int wid = __builtin_amdgcn_readfirstlane(tid >> 6), lane = tid & 63, wr = wid >> 2, wc = wid & 3, fr = lane & 15, fq = lane >> 4;
    const int K = g.K, nt = K / BK;
    unsigned voffA[2], voffB[2];
#pragma unroll
    for (int i = 0; i < 2; ++i) { int R, C; stage_rc(tid * 16 + i * 8192, R, C); const int Rb = (R & ~31) + perm32(R & 31); voffA[i] = (unsigned)(R * g.lda + C) * 2u; voffB[i] = (unsigned)(Rb * g.ldb + C) * 2u; }
    const size_t kstep = (size_t)(BK * 2);
    const size_t hstepA = (size_t)HALF * g.lda * 2, hstepB = (size_t)HALF * g.ldb * 2;
    const size_t tstepA = 2 * hstepA, tstepB = 2 * hstepB;
    const unsigned ldsw = (unsigned)wid * 1024u;
    const int aoff = lds_byte(wr * 64 + fr, fq * 8), boff = lds_byte(wc * 32 + fr, fq * 8);
#define PG8_SA(b, h) (((b) * 2 + (h)) * HTB)
#define PG8_SB(b, h) ((4 + (b) * 2 + (h)) * HTB)
#define PG8_STAGE(bufoff, gbase, voff) do { _Pragma("unroll") for (int _i = 0; _i < 2; ++_i) \
        __builtin_amdgcn_global_load_lds((const unsigned*)((const char*)(gbase) + (voff)[_i]), (LAS unsigned*)(lds + (bufoff) + ldsw + _i * 8192), 16, 0, 0); } while (0)
#define PG8_LDA(dst, b, h) do { _Pragma("unroll") for (int m = 0; m < 4; ++m) _Pragma("unroll") for (int k = 0; k < 2; ++k) dst[m][k] = *(const LAS bf16x8*)(lds + PG8_SA(b, h) + aoff + m * 2048 + k * 1024); } while (0)
#define PG8_LDB(dst, b, h) do { _Pragma("unroll") for (int n = 0; n < 2; ++n) _Pragma("unroll") for (int k = 0; k < 2; ++k) dst[n][k] = *(const LAS bf16x8*)(lds + PG8_SB(b, h) + boff + n * 2048 + k * 1024); } while (0)
#define PG8_MMA(ai, bj, At, Bt) do { __builtin_amdgcn_s_setprio(1); _Pragma("unroll") for (int m = 0; m < 4; ++m) _Pragma("unroll") for (int n = 0; n < 2; ++n) _Pragma("unroll") for (int k = 0; k < 2; ++k) \
        acc[ai][bj][m][n] = __builtin_amdgcn_mfma_f32_16x16x32_bf16(Bt[n][k], At[m][k], acc[ai][bj][m][n], 0, 0, 0); __builtin_amdgcn_s_setprio(0); } while (0)
#define PG8_WAIT_V(n) asm volatile("s_waitcnt vmcnt(" #n ")" ::: "memory")
#define PG8_WAIT_L(n) asm volatile("s_waitcnt lgkmcnt(" #n ")" ::: "memory")
#define PG8_BAR __builtin_amdgcn_s_barrier()
#define PG8_SCHED __builtin_amdgcn_sched_barrier(0)
    Unit cur, nxt; int ui = 0;
    if (!S.next(0, cur)) return;
    f32x4 acc[2][2][4][2];
#pragma unroll
    for (int a = 0; a < 2; ++a)
#pragma unroll
        for (int b = 0; b < 2; ++b)
#pragma unroll
            for (int m = 0; m < 4; ++m)
#pragma unroll
                for (int n = 0; n < 2; ++n) acc[a][b][m][n] = (f32x4){0.f, 0.f, 0.f, 0.f};
    bf16x8 At[4][2], B0[2][2], B1[2][2];
#define PG8_AOFF(u_) ((long)((u_).grp * g.nM + (u_).pm) * (long)tstepA)
    const char* cA = (const char*)g.A + PG8_AOFF(cur); const char* cB = (const char*)g.Bt + (size_t)(cur.grp * g.nN + cur.pn) * tstepB;
    PG8_STAGE(PG8_SB(0, 0), cB, voffB); PG8_STAGE(PG8_SB(0, 1), cB + hstepB, voffB); PG8_STAGE(PG8_SA(0, 0), cA, voffA); PG8_STAGE(PG8_SA(0, 1), cA + hstepA, voffA);
    if (wr == 1) PG8_BAR;
    PG8_WAIT_V(2); PG8_BAR;
    PG8_STAGE(PG8_SB(1, 0), cB + kstep, voffB); PG8_STAGE(PG8_SA(1, 0), cA + kstep, voffA); PG8_STAGE(PG8_SB(1, 1), cB + hstepB + kstep, voffB);
    PG8_WAIT_V(6); PG8_BAR;
    for (;;) {
        const bool has_next = S.next(ui + 1, nxt);
        const char* nA = has_next ? (const char*)g.A + PG8_AOFF(nxt) : cA; const char* nB = has_next ? (const char*)g.Bt + (size_t)(nxt.grp * g.nN + nxt.pn) * tstepB : cB;
        for (int t = 0; t < nt; t += 2) {
            const bool last = (t == nt - 2);
            const char* a1 = cA + (size_t)(t + 1) * kstep;
            const char* a2 = last ? nA : cA + (size_t)(t + 2) * kstep; const char* b2 = last ? nB : cB + (size_t)(t + 2) * kstep;
            const char* a3 = a2 + kstep; const char* b3 = b2 + kstep;
            PG8_LDB(B0, 0, 0); PG8_LDB(B1, 0, 1); PG8_SCHED; PG8_LDA(At, 0, 0); PG8_STAGE(PG8_SA(1, 1), a1 + hstepA, voffA);
            PG8_WAIT_V(8); PG8_WAIT_L(0); PG8_BAR; PG8_MMA(0, 0, At, B0); PG8_MMA(0, 1, At, B1); PG8_BAR; PG8_SCHED;
            PG8_LDA(At, 0, 1); PG8_STAGE(PG8_SB(0, 0), b2, voffB); PG8_STAGE(PG8_SB(0, 1), b2 + hstepB, voffB); PG8_STAGE(PG8_SA(0, 0), a2, voffA);
            PG8_WAIT_V(8); PG8_WAIT_L(0); PG8_BAR; PG8_MMA(1, 0, At, B0); PG8_MMA(1, 1, At, B1); PG8_BAR; PG8_SCHED;
            PG8_LDB(B0, 1, 0); PG8_LDB(B1, 1, 1); PG8_SCHED; PG8_LDA(At, 1, 0); PG8_STAGE(PG8_SA(0, 1), a2 + hstepA, voffA);
            PG8_WAIT_V(8); PG8_WAIT_L(0); PG8_BAR; PG8_MMA(0, 0, At, B0); PG8_MMA(0, 1, At, B1); PG8_BAR; PG8_SCHED;
            PG8_LDA(At, 1, 1); PG8_STAGE(PG8_SB(1, 0), b3, voffB); PG8_STAGE(PG8_SB(1, 1), b3 + hstepB, voffB); PG8_STAGE(PG8_SA(1, 0), a3, voffA);
            PG8_WAIT_V(8); PG8_WAIT_L(0); PG8_BAR; PG8_MMA(1, 0, At, B0); PG8_MMA(1, 1, At, B1); PG8_BAR; PG8_SCHED;
        }
        if (wr == 0) PG8_BAR;
        if (!g.ovl) { if (E.mode == 7 && E.nf) E.resnorm(acc, cur, wr, wc, fr, fq, lds); else E(acc, cur, wr, wc, fr, fq); }
        if (!has_next) break;
#pragma unroll
        for (int a = 0; a < 2; ++a)
#pragma unroll
            for (int b = 0; b < 2; ++b)
#pragma unroll
                for (int m = 0; m < 4; ++m)
#pragma unroll
                    for (int n = 0; n < 2; ++n) acc[a][b][m][n] = (f32x4){0.f, 0.f, 0.f, 0.f};
        cur = nxt; cA = nA; cB = nB; ++ui;
        if (wr == 1) PG8_BAR;
    }
    PG8_WAIT_V(0);
    PG8_BAR;
    if (g.ovl) E.fused(acc, cur, wr, wc, fr, fq, lds);
#undef PG8_AOFF
#undef PG8_SA
#undef PG8_SB
#undef PG8_STAGE
#undef PG8_LDA
#undef PG8_LDB
#undef PG8_MMA
#undef PG8_WAIT_V
#undef PG8_WAIT_L
#undef PG8_BAR
#undef PG8_SCHED
}
}

namespace att {
constexpr int D = 128, NW = 8, QBLK = 32, KVBLK = 64, LD = DM;
constexpr float SCALE = 0.125f, THR = 8.f;
constexpr size_t SHM_V = KVBLK * D * 2, SHM_K = KVBLK * 64 * 2;
#define KSWZ(row, colB) ((row) * 128 + ((colB) ^ ((((row) >> 1) & 7) << 4)))
#define SBAR() __builtin_amdgcn_sched_barrier(0)
__device__ __forceinline__ int crow(int r, int hi) { return (r & 3) + 8 * (r >> 2) + 4 * hi; }
__device__ __forceinline__ void partialSM(f32x16& p0, f32x16& p1) {
#pragma unroll
    for (int r = 0; r < 16; ++r) p0[r] = __builtin_amdgcn_exp2f(p0[r]);
    (void)p1;
}
__device__ __forceinline__ void finishSM(f32x16& p0, f32x16& p1, float& l_reg, bf16x8& pa0, bf16x8& pa1, bf16x8& pa2, bf16x8& pa3) {
#pragma unroll
    for (int r = 0; r < 16; ++r) p1[r] = __builtin_amdgcn_exp2f(p1[r]);
    float ps = 0;
#pragma unroll
    for (int r = 0; r < 16; ++r) ps += p0[r];
#pragma unroll
    for (int r = 0; r < 16; ++r) ps += p1[r];
    l_reg += ps;
#define PK4(P, BASE, OUT) do { u32x4 w = {cvt_pk_bf16(P[BASE + 0], P[BASE + 1]), cvt_pk_bf16(P[BASE + 2], P[BASE + 3]), cvt_pk_bf16(P[BASE + 4], P[BASE + 5]), cvt_pk_bf16(P[BASE + 6], P[BASE + 7])}; \
    OUT = *reinterpret_cast<bf16x8*>(&w); } while (0)
    PK4(p0, 0, pa0); PK4(p0, 8, pa1); PK4(p1, 0, pa2); PK4(p1, 8, pa3);
#undef PK4
}
__device__ __forceinline__ void qkt(f32x16& p0, f32x16& p1, const char* Ks, const bf16x8* qr, const f32x16& negm, int r32, int hi) {
#pragma unroll
    for (int d0 = 0; d0 < 4; ++d0) { const int cb = (d0 * 16 + hi * 8) * 2;
        const bf16x8 b0 = *reinterpret_cast<const bf16x8*>(Ks + KSWZ(r32, cb));
        const bf16x8 b1 = *reinterpret_cast<const bf16x8*>(Ks + KSWZ(32 + r32, cb));
        if (d0 == 0) { p0 = __builtin_amdgcn_mfma_f32_32x32x16_bf16(b0, qr[0], negm, 0, 0, 0); p1 = __builtin_amdgcn_mfma_f32_32x32x16_bf16(b1, qr[0], negm, 0, 0, 0); }
        else { p0 = __builtin_amdgcn_mfma_f32_32x32x16_bf16(b0, qr[d0], p0, 0, 0, 0); p1 = __builtin_amdgcn_mfma_f32_32x32x16_bf16(b1, qr[d0], p1, 0, 0, 0); } }
}
__device__ __forceinline__ int v_st(int k, int c) { const int kk = k; return ((kk >> 3) * 4 + (c >> 5)) * 512 + ((kk & 7) * 32 + (c & 31)) * 2; }
__device__ __forceinline__ int v_rd_base(int lane) { return ((lane & 3) << 3) | (((lane >> 2) & 3) << 6) | (((lane >> 4) & 1) << 5) | (((lane >> 5) & 1) << 8); }
constexpr int v_rd_off(int d0, int ks, int half) { return d0 * 512 + ks * 4096 + half * 2048; }
template <int OFF> __device__ __forceinline__ s16x4 tr_read(int vb) {
    s16x4 r; asm volatile("ds_read_b64_tr_b16 %0, %1 offset:%2" : "=&v"(r) : "v"(vb), "i"(OFF) : "memory"); return r;
}
template <int D0> __device__ __forceinline__ void pv_one(f32x16& od, int vb, bf16x8 pa0, bf16x8 pa1, bf16x8 pa2, bf16x8 pa3) {
    const s16x4 l0 = tr_read<v_rd_off(D0, 0, 0)>(vb), h0 = tr_read<v_rd_off(D0, 0, 1)>(vb), l1 = tr_read<v_rd_off(D0, 1, 0)>(vb), h1 = tr_read<v_rd_off(D0, 1, 1)>(vb);
    const s16x4 l2 = tr_read<v_rd_off(D0, 2, 0)>(vb), h2 = tr_read<v_rd_off(D0, 2, 1)>(vb), l3 = tr_read<v_rd_off(D0, 3, 0)>(vb), h3 = tr_read<v_rd_off(D0, 3, 1)>(vb);
    asm volatile("s_waitcnt lgkmcnt(0)" ::: "memory"); SBAR();
#define PK(L, H) (bf16x8){L[0], L[1], L[2], L[3], H[0], H[1], H[2], H[3]}
    od = __builtin_amdgcn_mfma_f32_32x32x16_bf16(pa0, PK(l0, h0), od, 0, 0, 0);
    od = __builtin_amdgcn_mfma_f32_32x32x16_bf16(pa1, PK(l1, h1), od, 0, 0, 0);
    od = __builtin_amdgcn_mfma_f32_32x32x16_bf16(pa2, PK(l2, h2), od, 0, 0, 0);
    od = __builtin_amdgcn_mfma_f32_32x32x16_bf16(pa3, PK(l3, h3), od, 0, 0, 0);
#undef PK
}
__device__ __forceinline__ void pv_d0(f32x16* o, int vb, bf16x8 pa0, bf16x8 pa1, bf16x8 pa2, bf16x8 pa3) {
    pv_one<0>(o[0], vb, pa0, pa1, pa2, pa3); pv_one<1>(o[1], vb, pa0, pa1, pa2, pa3); pv_one<2>(o[2], vb, pa0, pa1, pa2, pa3); pv_one<3>(o[3], vb, pa0, pa1, pa2, pa3);
}

__device__ __forceinline__ void attn_pass(const bf16_t* __restrict__ Qb, const bf16_t* __restrict__ Kh, const bf16_t* __restrict__ Vh, float kmax2, f32x16 (&o)[4], float (&rli)[16], char* lds) {
    int tid = threadIdx.x; asm volatile("" : "+v"(tid));
    const int wid = tid >> 6, lane = tid & 63, r32 = lane & 31, hi = lane >> 5;
    char* V_lds = lds; char* K_lds = lds + 3 * SHM_V;
    float* ws = (float*)(lds + 3 * SHM_V + 3 * SHM_K) + wid * 64; float* li_l = ws;
    float l_reg = 0; bf16x8 qr[4];
#pragma unroll
    for (int d = 0; d < 4; ++d) o[d] = f32x16{};
    const GAS bf16_t* Qw = (const GAS bf16_t*)Qb + (long)(wid * QBLK + r32) * LD + hi * 8; const GAS bf16_t* Kg = (const GAS bf16_t*)Kh; const GAS bf16_t* Vg = (const GAS bf16_t*)Vh;
#pragma unroll
    for (int d0 = 0; d0 < 4; ++d0) qr[d0] = *(const GAS bf16x8*)(Qw + d0 * 16);
    float mnC;
    { float qs = 0.f;
#pragma unroll
      for (int d0 = 0; d0 < 4; ++d0)
#pragma unroll
          for (int e = 0; e < 8; ++e) { const float qv = __uint_as_float(((unsigned)(unsigned short)qr[d0][e]) << 16); qs += qv * qv; }
      auto rr = __builtin_amdgcn_permlane32_swap(__float_as_uint(qs), __float_as_uint(qs), false, false);
      qs = __uint_as_float(rr[0]) + __uint_as_float(rr[1]);
      mnC = -fminf(sqrtf(qs * kmax2), 60.0f * 1.4426950408889634f); }
    f32x16 negm;
#pragma unroll
    for (int r = 0; r < 16; ++r) negm[r] = mnC;
    asm volatile("" : "+v"(negm));
    const int sr = tid >> 4, sc = (tid & 15) * 8, vst0 = v_st(sr, sc), vst1 = v_st(32 + sr, sc);
    const int kr = tid >> 3, kc = (tid & 7) * 8, kst = KSWZ(kr, kc * 2);
    const int vb0 = (int)(uintptr_t)V_lds + v_rd_base(lane);
    struct { bf16x8 vs0, vs1, ks0; } sr_[2];
#define SLOAD(i, k0) do { sr_[i].vs0 = *(const GAS bf16x8*)(&Vg[(long)((k0) + sr) * LD + sc]); sr_[i].vs1 = *(const GAS bf16x8*)(&Vg[(long)((k0) + 32 + sr) * LD + sc]); \
    sr_[i].ks0 = *(const GAS bf16x8*)(&Kg[(long)((k0) + kr) * LD + kc]); } while (0)
#define SWRITE(b, i) do { *(bf16x8*)(V_lds + (b) * SHM_V + vst0) = sr_[i].vs0; *(bf16x8*)(V_lds + (b) * SHM_V + vst1) = sr_[i].vs1; *(bf16x8*)(K_lds + (b) * SHM_K + kst) = sr_[i].ks0; } while (0)
#define SWAIT() asm volatile("s_waitcnt vmcnt(3)" ::: "memory")
    f32x16 pA0, pA1, pB0, pB1; bf16x8 pa0, pa1, pa2, pa3; const int NT = SEQ / KVBLK;
    SLOAD(0, 0); asm volatile("s_waitcnt vmcnt(0)" ::: "memory"); SWRITE(0, 0);
    SLOAD(1, KVBLK); SLOAD(0, 2 * KVBLK);
    __syncthreads();
    qkt(pA0, pA1, K_lds, qr, negm, r32, hi); partialSM(pA0, pA1);
    int rc = 1, rp = 0;
#define RING_NEXT() do { rp = rc; rc = (rc == 2) ? 0 : rc + 1; } while (0)
    for (int j = 1; j + 1 < NT; j += 2) {
        SWAIT(); SWRITE(rc, 1); if (j + 2 < NT) SLOAD(1, (j + 2) * KVBLK);
        __syncthreads();
        SBAR(); qkt(pB0, pB1, K_lds + rc * SHM_K, qr, negm, r32, hi);
        finishSM(pA0, pA1, l_reg, pa0, pa1, pa2, pa3); SBAR();
        pv_d0(o, vb0 + rp * (int)SHM_V, pa0, pa1, pa2, pa3); partialSM(pB0, pB1);
        RING_NEXT();
        SWAIT(); SWRITE(rc, 0); if (j + 3 < NT) SLOAD(0, (j + 3) * KVBLK);
        __syncthreads();
        SBAR(); qkt(pA0, pA1, K_lds + rc * SHM_K, qr, negm, r32, hi);
        finishSM(pB0, pB1, l_reg, pa0, pa1, pa2, pa3); SBAR();
        pv_d0(o, vb0 + rp * (int)SHM_V, pa0, pa1, pa2, pa3); partialSM(pA0, pA1);
        RING_NEXT();
    }
    asm volatile("s_waitcnt vmcnt(0)" ::: "memory"); SWRITE(rc, 1);
    __syncthreads();
    SBAR(); qkt(pB0, pB1, K_lds + rc * SHM_K, qr, negm, r32, hi);
    finishSM(pA0, pA1, l_reg, pa0, pa1, pa2, pa3); SBAR();
    pv_d0(o, vb0 + rp * (int)SHM_V, pa0, pa1, pa2, pa3); partialSM(pB0, pB1);
    finishSM(pB0, pB1, l_reg, pa0, pa1, pa2, pa3); SBAR();
    pv_d0(o, vb0 + rc * (int)SHM_V, pa0, pa1, pa2, pa3);
#undef RING_NEXT
    { auto rr = __builtin_amdgcn_permlane32_swap(__float_as_uint(l_reg), __float_as_uint(l_reg), false, false); l_reg = __uint_as_float(rr[0]) + __uint_as_float(rr[1]); }
    if (hi == 0) li_l[r32] = l_reg; asm volatile("s_waitcnt lgkmcnt(0)" ::: "memory");
#pragma unroll
    for (int r = 0; r < 16; ++r) rli[r] = __builtin_amdgcn_rcpf(li_l[crow(r, hi)]);
    __syncthreads();
#undef SLOAD
#undef SWRITE
#undef SWAIT
}

__device__ __forceinline__ void attn_unit(int b, int h, int qb, const bf16_t* Q, const bf16_t* K, const bf16_t* V, bf16_t* O, float* scr, const unsigned* kmax2, float lam, float onem, const float* subw, char* lds) {
    int tid = threadIdx.x; asm volatile("" : "+v"(tid));
    const int wid = tid >> 6, lane = tid & 63, r32 = lane & 31, hi = lane >> 5;
    asm volatile("" : "+s"(Q), "+s"(K), "+s"(V), "+s"(O), "+s"(scr), "+s"(kmax2), "+s"(subw));
    const size_t rowbase = (size_t)b * SEQ;
    f32x16 o[4]; float rli[16];
#pragma unroll 1
    for (int pass = 0; pass < 2; ++pass) {
        const int sub = 2 * h + pass;
        attn_pass(Q + (rowbase + (size_t)qb * 256) * LD + sub * 64, K + rowbase * LD + sub * 64, V + rowbase * LD + h * 128, __uint_as_float(kmax2[b * 16 + sub]), o, rli, lds);
        int t2 = tid; asm volatile("" : "+v"(t2));
        const int lane2 = t2 & 63, r32b = lane2 & 31, hib = lane2 >> 5, wid2 = t2 >> 6;
        float* sp = scr + (size_t)t2 * 64;
        if (pass == 0) {
#pragma unroll
            for (int d0 = 0; d0 < 4; ++d0)
#pragma unroll
                for (int r4 = 0; r4 < 4; ++r4) *(f32x4*)(sp + d0 * 16 + r4 * 4) = (f32x4){o[d0][4 * r4] * rli[4 * r4], o[d0][4 * r4 + 1] * rli[4 * r4 + 1], o[d0][4 * r4 + 2] * rli[4 * r4 + 2], o[d0][4 * r4 + 3] * rli[4 * r4 + 3]};
        } else {
            float ss[16];
#pragma unroll
            for (int r = 0; r < 16; ++r) ss[r] = 0.f;
#pragma unroll
            for (int d0 = 0; d0 < 4; ++d0)
#pragma unroll
                for (int r4 = 0; r4 < 4; ++r4) { const f32x4 o1 = *(const f32x4*)(sp + d0 * 16 + r4 * 4);
#pragma unroll
                    for (int q = 0; q < 4; ++q) { const int r = 4 * r4 + q; const float v = o1[q] - lam * (o[d0][r] * rli[r]); o[d0][r] = v; ss[r] += v * v; } }
#pragma unroll
            for (int r = 0; r < 16; ++r) {
#pragma unroll
                for (int x = 1; x < 32; x <<= 1) ss[r] += shfl_xor_l(ss[r], x, lane2);
                ss[r] = rsqrtf(ss[r] * (1.0f / 128.0f) + 1e-5f) * onem; }
            bf16_t* Ow = O + (rowbase + (size_t)qb * 256 + wid2 * QBLK + 4 * hib) * LD + h * 128 + r32b;
#pragma unroll
            for (int d0 = 0; d0 < 4; ++d0) { const float sw = subw[d0 * 32 + r32b];
#pragma unroll
                for (int r = 0; r < 16; ++r) { const unsigned w = cvt_pk_bf16(o[d0][r] * ss[r] * sw, 0.f); Ow[(size_t)((r & 3) + 8 * (r >> 2)) * LD + d0 * 32] = (bf16_t)(w & 0xffffu); } }
        }
    }
}
#undef SBAR
}

__device__ __forceinline__ void transpose_item(const float* W, const float* W2, int K, int ldw, int coff, int sel, int ndst, bf16_t* WT, LAS float* scr, int item, int lane) {
    const int nblk = ndst / 32, kb = item / nblk, nb = item % nblk, k0 = 64 * kb, n0 = 32 * nb;
    const int nd = n0 + (lane & 31); int sc = nd + coff; const float* Wp = W;
    if (sel == 1 && nd < 2048) { const int j = nd & 63; sc = (nd & ~63) + (j & 1) * 32 + (j >> 1); }
    if (sel == 2) { sc = (nd >> 3) * 4 + (nd & 3); if ((nd >> 2) & 1) Wp = W2; }
    if (sel == 3) { sc = (nd >> 3) * 4 + (nd & 3) + ((nd >> 2) & 1) * DFF; }
#pragma unroll 8
    for (int i = 0; i < 32; ++i) { const int kk = 2 * i + (lane >> 5); scr[kk * 33 + (lane & 31)] = Wp[(size_t)(k0 + kk) * ldw + sc]; }
    asm volatile("s_waitcnt lgkmcnt(0)" ::: "memory");
    const int c = lane & 7;
#pragma unroll
    for (int j = 0; j < 4; ++j) { const int n = (lane >> 3) + 8 * j; const LAS float* s = scr + (8 * c) * 33 + n;
        u32x4 o; o.x = cvt_pk_bf16(s[0 * 33], s[1 * 33]); o.y = cvt_pk_bf16(s[2 * 33], s[3 * 33]); o.z = cvt_pk_bf16(s[4 * 33], s[5 * 33]); o.w = cvt_pk_bf16(s[6 * 33], s[7 * 33]);
        *(u32x4*)(WT + (size_t)(n0 + n) * K + k0 + 8 * c) = o; }
    asm volatile("s_waitcnt lgkmcnt(0)" ::: "memory");
}

__device__ __forceinline__ void norm_rows(const float* xin, const float* nw, const float* mod_l, int mod_off, bf16_t* XN, float* fout, int gw, int NGW, int lane) {
    for (int m0 = gw; m0 < T; m0 += 2 * NGW) {
        const int m1 = m0 + NGW;
        const bool has1 = m1 < T; const int m1c = has1 ? m1 : m0;
        const f32x4* x0 = (const f32x4*)(xin + (size_t)m0 * DM) + lane; const f32x4* x1 = (const f32x4*)(xin + (size_t)m1c * DM) + lane;
        f32x4 v[2][4]; float s0 = 0.f, s1 = 0.f;
#pragma unroll
        for (int j = 0; j < 4; ++j) { v[0][j] = x0[64 * j]; v[1][j] = x1[64 * j]; }
#pragma unroll
        for (int j = 0; j < 4; ++j) { s0 += (v[0][j][0] * v[0][j][0] + v[0][j][1] * v[0][j][1]) + (v[0][j][2] * v[0][j][2] + v[0][j][3] * v[0][j][3]);
                                      s1 += (v[1][j][0] * v[1][j][0] + v[1][j][1] * v[1][j][1]) + (v[1][j][2] * v[1][j][2] + v[1][j][3] * v[1][j][3]); }
        const float r0 = rsqrtf(wave_sum(s0, lane) * (1.0f / DM) + 1e-6f), r1 = rsqrtf(wave_sum(s1, lane) * (1.0f / DM) + 1e-6f);
#pragma unroll
        for (int k = 0; k < 2; ++k) {
            if (k == 1 && !has1) break;
            const int m = k == 0 ? m0 : m1; const float r = k == 0 ? r0 : r1;
#pragma unroll
            for (int j = 0; j < 4; ++j) { const int col = lane * 4 + 256 * j; const f32x4 w4 = *(const f32x4*)(nw + col);
                if (mod_l) { const float* md = mod_l + (size_t)(m >> 12) * 6144 + mod_off; const f32x4 sh = *(const f32x4*)(md + col), sc = *(const f32x4*)(md + 1024 + col);
                    const f32x4 hv = v[k][j] * r * w4 * (sc + 1.0f) + sh; u32x2 w; w.x = cvt_pk_bf16(hv[0], hv[1]); w.y = cvt_pk_bf16(hv[2], hv[3]); *(u32x2*)(XN + (size_t)m * DM + col) = w; }
                else *(f32x4*)(fout + (size_t)m * DM + col) = v[k][j] * r * w4; }
        }
    }
}

__device__ __forceinline__ void conv_fix(int pm, const bf16_t* RAWb, bf16_t* ACT, const float* cw, const float* cb, int tid) {
    const int bb = pm >> 4, ti = pm & 15;
    for (int t = tid; t < 704; t += NTHR) {
        const int rowsel = t / 352, c = t % 352, j0 = c * 8; const int ioff = (j0 >> 7) * 256 + ((j0 & 127) >> 3) * 16;
        if ((rowsel == 0 && ti == 0) || (rowsel == 1 && ti == 15)) continue;
        const bf16_t* pp = rowsel == 0 ? RAWb + ((size_t)(pm - 1) * 4 + 3) * NUP : RAWb + ((size_t)pm * 4 + 2) * NUP;
        const bf16_t* pc = rowsel == 0 ? RAWb + ((size_t)pm * 4 + 0) * NUP : RAWb + ((size_t)pm * 4 + 3) * NUP;
        const bf16_t* pn = rowsel == 0 ? RAWb + ((size_t)pm * 4 + 1) * NUP : RAWb + ((size_t)(pm + 1) * 4 + 0) * NUP;
        const int s = 256 * ti + (rowsel == 0 ? 0 : 255);
        float o[8];
#pragma unroll
        for (int h = 0; h < 2; ++h) {
            const u32x4 p = *(const u32x4*)(pp + ioff + 8 * h), cc = *(const u32x4*)(pc + ioff + 8 * h), n = *(const u32x4*)(pn + ioff + 8 * h);
#pragma unroll
            for (int q2 = 0; q2 < 2; ++q2) { const int e = 4 * h + 2 * q2; const int jv = j0 + e, jg = DFF + j0 + e;
                const float v0 = cw[jv] * bf_lo(p[q2]) + cw[NUP + jv] * bf_lo(cc[q2]) + cw[2 * NUP + jv] * bf_lo(n[q2]) + cb[jv];
                const float v1 = cw[jv + 1] * bf_hi(p[q2]) + cw[NUP + jv + 1] * bf_hi(cc[q2]) + cw[2 * NUP + jv + 1] * bf_hi(n[q2]) + cb[jv + 1];
                const float g0 = cw[jg] * bf_lo(p[2 + q2]) + cw[NUP + jg] * bf_lo(cc[2 + q2]) + cw[2 * NUP + jg] * bf_lo(n[2 + q2]) + cb[jg];
                const float g1 = cw[jg + 1] * bf_hi(p[2 + q2]) + cw[NUP + jg + 1] * bf_hi(cc[2 + q2]) + cw[2 * NUP + jg + 1] * bf_hi(n[2 + q2]) + cb[jg + 1];
                o[e] = g0 * sigmoidf_(g0) * v0; o[e + 1] = g1 * sigmoidf_(g1) * v1; }
        }
        u32x4 ov; ov.x = cvt_pk_bf16(o[0], o[1]); ov.y = cvt_pk_bf16(o[2], o[3]); ov.z = cvt_pk_bf16(o[4], o[5]); ov.w = cvt_pk_bf16(o[6], o[7]);
        *(u32x4*)(ACT + ((size_t)bb * SEQ + s) * DFF + j0) = ov;
    }
}

#define XB_TMO      128
#define XB_XCNT(j)  (256  + 64 * (j))
#define XB_XSUB(j)  (1280 + 64 * (j))
#define XB_XGEN(j)  (2304 + 64 * (j))
#define XB_TOP      3328
#define XB_TOPGEN   3392
#define XCD_BAR_WORDS 3456
#define XB_SPIN_CAP (1u << 22)
__device__ __forceinline__ unsigned xb_ld(unsigned* p)              { return __hip_atomic_load(p, __ATOMIC_RELAXED, __HIP_MEMORY_SCOPE_AGENT); }
__device__ __forceinline__ unsigned xb_add(unsigned* p, unsigned v) { return __hip_atomic_fetch_add(p, v, __ATOMIC_RELAXED, __HIP_MEMORY_SCOPE_AGENT); }
__device__ __forceinline__ unsigned xb_xcc_id() { return (unsigned)__builtin_amdgcn_s_getreg((3 << 11) | 20) & 0xFu; }
#define XB_SPIN(cond, bar) do { unsigned _sp = 0; while (cond) { __builtin_amdgcn_s_sleep(1); \
    if ((++_sp & 255u) == 0u) { if (xb_ld(&(bar)[XB_TMO])) break; if (_sp > XB_SPIN_CAP) { atomicAdd(&(bar)[XB_TMO], 1u); break; } } } } while (0)
struct XcdBarrier { unsigned* bar; unsigned x; volatile LAS unsigned* st; };
__device__ __forceinline__ void xcd_barrier_complete(unsigned* bar, unsigned x, unsigned& nloc, unsigned& nx) {
    const unsigned G = gridDim.x * gridDim.y * gridDim.z;
    unsigned sum, cnt, mine, sp = 0u;
    for (;;) {
        sum = 0u; cnt = 0u; mine = 0u;
#pragma unroll
        for (unsigned j = 0; j < 16; ++j) { const unsigned c = xb_ld(&bar[XB_XCNT(j)]); sum += c; cnt += (c > 0u) ? 1u : 0u; mine = (j == x) ? c : mine; }
        if (sum == G) break;
        __builtin_amdgcn_s_sleep(1);
        if ((++sp & 255u) == 0u) { if (xb_ld(&bar[XB_TMO])) break; if (sp > XB_SPIN_CAP) { atomicAdd(&bar[XB_TMO], 1u); break; } }
    }
    nloc = mine > 0u ? mine : 1u; nx = cnt > 0u ? cnt : 1u;
}
__device__ __forceinline__ void xcd_barrier(const XcdBarrier& b) {
    asm volatile("s_waitcnt vmcnt(0)" ::: "memory");
    __syncthreads();
    if (threadIdx.x == 0) {
        unsigned* bar = b.bar;
        __builtin_amdgcn_s_waitcnt(0);
        unsigned nloc = b.st[0], nx = b.st[1];
        if (nloc == 0u) { xcd_barrier_complete(bar, b.x, nloc, nx); b.st[0] = nloc; b.st[1] = nx; }
        const unsigned old = xb_add(&bar[XB_XSUB(b.x)], 1u);
        const unsigned gen = old / nloc;
        if (old + 1u == (gen + 1u) * nloc) {
            __builtin_amdgcn_fence(__ATOMIC_RELEASE, "agent");
            asm volatile("s_waitcnt vmcnt(0)" ::: "memory");
            const unsigned og = xb_add(&bar[XB_TOP], 1u);
            const unsigned tg = og / nx;
            if (og + 1u == (tg + 1u) * nx) xb_add(&bar[XB_TOPGEN], 1u);
            else XB_SPIN(xb_ld(&bar[XB_TOPGEN]) == tg, bar);
            __builtin_amdgcn_fence(__ATOMIC_ACQUIRE, "agent");
            xb_add(&bar[XB_XGEN(b.x)], 1u);
            asm volatile("s_waitcnt vmcnt(0)" ::: "memory");
        } else {
            XB_SPIN(xb_ld(&bar[XB_XGEN(b.x)]) == gen, bar);
            __builtin_amdgcn_fence(__ATOMIC_ACQUIRE, "agent");
            asm volatile("s_waitcnt vmcnt(0)" ::: "memory");
        }
    }
    __syncthreads();
}

__global__ void __launch_bounds__(NTHR, 2) mega(Params P) {
    extern __shared__ __attribute__((aligned(16))) unsigned char lds_raw[];
    cg::grid_group grid = cg::this_grid();
    LAS unsigned char* lds = (LAS unsigned char*)lds_raw;
    const int G0 = gridDim.x, bx0 = blockIdx.x;
    float* xo = P.out;
    if (threadIdx.x < 2) ((volatile LAS unsigned*)(lds + LDS_BYTES - 64))[threadIdx.x] = 0u;
    if (P.out == nullptr) grid.sync();
    __syncthreads();
    XcdBarrier xbar; xbar.bar = (unsigned*)P.ws; xbar.x = xb_xcc_id(); xbar.st = (volatile LAS unsigned*)(lds + LDS_BYTES - 64);
    if (threadIdx.x == 0) (void)xb_add(&xbar.bar[XB_XCNT(xbar.x)], 1u);
#define GRID_BAR() xcd_barrier(xbar)
#define PH_INIT unsigned char* ws = P.ws; int tid = threadIdx.x; int L = l; int G = G0, bx = bx0; asm volatile("" : "+s"(ws), "+s"(L), "+s"(G), "+s"(bx)); asm volatile("" : "+v"(tid)); \
    const int vcu = (G % 8 == 0) ? (bx % 8) * (G / 8) + bx / 8 : bx; const int NGW = G * NWAVES; const long NGT = (long)G * NTHR; (void)NGW; (void)NGT; \
    const int lane = tid & 63, wave = __builtin_amdgcn_readfirstlane(tid >> 6); const int gw = vcu * NWAVES + wave; const long gtid = (long)vcu * NTHR + tid; (void)lane; (void)gw; (void)gtid; \
    float* MOD = (float*)(ws + WS_MOD); float* ROPE = (float*)(ws + WS_ROPE); f32x2* PW = (f32x2*)(ws + WS_PW); f32x2* BB = (f32x2*)(ws + WS_BB); float* KM = (float*)(ws + WS_KM); \
    bf16_t* WQKVU = (bf16_t*)(ws + WS_WQKVU); bf16_t* WG = (bf16_t*)(ws + WS_WG); bf16_t* WAO = (bf16_t*)(ws + WS_WAO); bf16_t* WGLU = (bf16_t*)(ws + WS_WGLU); \
    bf16_t* WOUT = (bf16_t*)(ws + WS_WOUT); bf16_t* WUP = (bf16_t*)(ws + WS_WUP); bf16_t* WDOWN = (bf16_t*)(ws + WS_WDOWN); \
    bf16_t* TMAT = (bf16_t*)(ws + WS_TMAT); bf16_t* EMAT = (bf16_t*)(ws + WS_EMAT); bf16_t* XN = (bf16_t*)(ws + WS_XN); \
    bf16_t* QB = (bf16_t*)(ws + WS_Q); bf16_t* KB = (bf16_t*)(ws + WS_K); bf16_t* VB = (bf16_t*)(ws + WS_V); bf16_t* UEXT = (bf16_t*)(ws + WS_UEXT); \
    float* XLOC = (float*)(ws + WS_XLOC); bf16_t* YB = (bf16_t*)(ws + WS_XLOC); float* SCR = (float*)(ws + WS_SCR); \
    bf16_t* TSB = (bf16_t*)(ws + WS_UP); bf16_t* ACT = (bf16_t*)(ws + WS_ACT); \
    (void)MOD; (void)ROPE; (void)PW; (void)BB; (void)KM; (void)WQKVU; (void)WG; (void)WAO; (void)WGLU; (void)WOUT; (void)WUP; (void)WDOWN; (void)TMAT; (void)EMAT; (void)XN; (void)QB; (void)KB; (void)VB; (void)UEXT; (void)XLOC; (void)YB; (void)SCR; (void)TSB; (void)ACT
#define MAKE_E pg8::Epi E{}; E.layer = L; E.Q = QB; E.Kb = KB; E.Vb = VB; E.Uext = UEXT; E.Y = YB; E.TS = TSB; E.RAWb = TSB; E.ACT = ACT; E.OS = (bf16_t*)(ws + WS_OS); E.xloc = XLOC; E.rope = ROPE; E.xout = xo

#define RUN_GEMM(A_, Bt_, lda_, ldb_, K_, nM_, nN_, ngrp_, epi_) do { pg8::Gemm g_{A_, Bt_, lda_, ldb_, K_, nM_, nN_, (ngrp_) & 0xff, (ngrp_) >> 8}; pg8::Order S_; S_.init(g_, G, bx); pg8::gemm_phase(lds, g_, S_, epi_); } while (0)

#pragma unroll 1
    for (int l = 0; l < 2; ++l) {
        const float lambda_init = (l == 0) ? 0.2f : 0.35550906759f;
        {
            PH_INIT;
            LAS float* scr = (LAS float*)(lds + wave * 16384);
            const int I1 = 16 * 112, I2 = 16 * 64, I3 = 16 * 32, I4 = 8 * 64, I5 = 16 * 32, I6 = 16 * 176, I7 = 44 * 32, NI = I1 + I2 + I3 + I4 + I5 + I6 + I7;
            const float* win = P.in[I_WIN] + (size_t)L * DM * 5632;
            for (int it = gw; it < NI; it += NGW) {
                int r = it;
                if (r < I1) { transpose_item(win, nullptr, 1024, 5632, 0, 1, 3584, WQKVU, scr, r, lane); continue; } r -= I1;
                if (r < I2) { transpose_item(win, nullptr, 1024, 5632, 3584, 0, 2048, WG, scr, r, lane); continue; } r -= I2;
                if (r < I3) { transpose_item(P.in[I_WAO] + (size_t)L * DM * DM, nullptr, 1024, 1024, 0, 0, 1024, WAO, scr, r, lane); continue; } r -= I3;
                if (r < I4) { transpose_item(P.in[I_WGA] + (size_t)L * 512 * DM, P.in[I_WGB] + (size_t)L * 512 * DM, 512, 1024, 0, 2, 2048, WGLU, scr, r, lane); continue; } r -= I4;
                if (r < I5) { transpose_item(P.in[I_WOUT] + (size_t)L * DM * DM, nullptr, 1024, 1024, 0, 0, 1024, WOUT, scr, r, lane); continue; } r -= I5;
                if (r < I6) { transpose_item(P.in[I_WUP] + (size_t)L * DM * NUP, nullptr, 1024, NUP, 0, 3, NUP, WUP, scr, r, lane); continue; } r -= I6;
                transpose_item(P.in[I_WDOWN] + (size_t)L * DFF * DM, nullptr, DFF, 1024, 0, 0, 1024, WDOWN, scr, r, lane);
            }
            for (long i = gtid; i < 2 * 32 * 33 * 64; i += NGT) {
                const int p = (int)(i & 63); const int tau = (int)((i >> 6) % 33); const int dg = (int)(i / (64 * 33));
                const size_t li = ((size_t)L * 64 + dg) * 64 + p; const float lr = P.in[I_SLRE][li], lim = P.in[I_SLIM][li]; const float dt = expf(P.in[I_SLDT][L * 64 + dg]);
                const float mag = expf(lr * dt * (float)tau), ang = (lim * dt) * (float)tau;
                PW[i] = (f32x2){mag * cosf(ang), mag * sinf(ang)};
            }
            for (long i = gtid; i < 2 * 32 * 64 * 16; i += NGT) {
                const int p = (int)((i >> 4) & 63); const int dg = (int)(i >> 10);
                const size_t li = ((size_t)L * 64 + dg) * 64 + p; const float lr = P.in[I_SLRE][li], lim = P.in[I_SLIM][li]; const float dt = expf(P.in[I_SLDT][L * 64 + dg]);
                const float mag = expf(lr * dt), ang = lim * dt; const float ar = mag * cosf(ang), ai = mag * sinf(ang);
                const float den = lr * lr + lim * lim, nr = ar - 1.0f, ni_ = ai;
                const float fre = (nr * lr + ni_ * lim) / den, fim = (ni_ * lr - nr * lim) / den;
                const size_t bi = (size_t)L * 2 * 32 * 64 * 16 + i; const float br = P.in[I_SBRE][bi], bim = P.in[I_SBIM][bi];
                BB[i] = (f32x2){fre * br - fim * bim, fre * bim + fim * br};
            }
            if (L == 0) {
                for (long i = gtid; i < SEQ * 32; i += NGT) { const int s = (int)(i >> 5), f = (int)(i & 31);
                    const float inv = powf(10000.0f, -(float)f / 32.0f); const float ang = (float)s * inv; ROPE[2 * i] = cosf(ang); ROPE[2 * i + 1] = sinf(ang); }
                LAS float* cact = (LAS float*)lds; LAS float* red = (LAS float*)(lds + 32768);
                __syncthreads();
                for (int it = bx; it < 192; it += G) {
                    const int ll = it / 96, j0 = (it % 96) * 64;
                    for (int i = tid; i < NB * DM; i += NTHR) { const float cv = P.in[I_C][i]; cact[i] = cv / (1.0f + expf(-cv)); }
                    __syncthreads();
                    float a[NB];
#pragma unroll
                    for (int b = 0; b < NB; ++b) a[b] = 0.f;
                    const float* aw = P.in[I_ADAW] + (size_t)ll * DM * 6144 + j0 + lane;
                    for (int k = wave * 128; k < wave * 128 + 128; ++k) { const float wv = aw[(size_t)k * 6144];
#pragma unroll
                        for (int b = 0; b < NB; ++b) a[b] += cact[b * DM + k] * wv; }
#pragma unroll
                    for (int b = 0; b < NB; ++b) red[(wave * NB + b) * 64 + lane] = a[b];
                    __syncthreads();
                    { const int b = tid >> 6; float s = P.in[I_ADAB][ll * 6144 + j0 + lane];
#pragma unroll
                      for (int w = 0; w < NWAVES; ++w) s += red[(w * NB + b) * 64 + lane];
                      MOD[((size_t)ll * NB + b) * 6144 + j0 + lane] = s; }
                    __syncthreads();
                }
            }
        }
        GRID_BAR();
        {
            PH_INIT;
            const float* xin = (L == 0) ? P.in[I_X] : xo; const float* nw = P.in[I_N1W] + L * DM;
            if (L == 0 || G != 256) norm_rows(xin, nw, MOD + (size_t)L * NB * 6144, 0, XN, nullptr, gw, NGW, lane);
            if (gtid < 128) ((unsigned*)(ws + WS_KMAX))[gtid] = 0u;
            for (long i = gtid; i < 2 * 32 * 32 * 256; i += NGT) {
                const int ni = (int)(i & 15), no = (int)((i >> 4) & 15), tau = (int)((i >> 8) & 31), dg = (int)(i >> 13);
                const float* cre = P.in[I_SCRE] + (((size_t)L * 64 + dg) * 16 + no) * 64; const float* cim = P.in[I_SCIM] + (((size_t)L * 64 + dg) * 16 + no) * 64;
                const f32x2* pw = PW + ((size_t)dg * 33 + tau) * 64; const f32x2* bb = BB + (size_t)dg * 1024 + ni; float acc = 0.f;
                for (int p = 0; p < 64; ++p) { const f32x2 w = pw[p], bv = bb[p * 16]; const float cr = cre[p], ci = cim[p]; const float zr = cr * w.x - ci * w.y, zi = cr * w.y + ci * w.x; acc += zr * bv.x - zi * bv.y; }
                KM[i] = acc;
            }
            for (long i = gtid; i < 32 * 256 * 64; i += NGT) {
                const int k8 = (int)(i & 63), n = (int)((i >> 6) & 255), g = (int)(i >> 14); const int dir = n >> 7, ri = (n >> 6) & 1, p = n & 63; const int s = k8 >> 1, ni0 = (k8 & 1) * 8;
                const int e = dir == 0 ? (CH - 1 - s) : s; const f32x2 w = PW[((size_t)(dir * 32 + g) * 33 + e) * 64 + p]; const f32x2* bb = BB + ((size_t)(dir * 32 + g) * 64 + p) * 16 + ni0;
                float o[8];
#pragma unroll
                for (int q = 0; q < 8; ++q) { const f32x2 bv = bb[q]; o[q] = ri == 0 ? (w.x * bv.x - w.y * bv.y) : (w.x * bv.y + w.y * bv.x); }
                u32x4 ov; ov.x = cvt_pk_bf16(o[0], o[1]); ov.y = cvt_pk_bf16(o[2], o[3]); ov.z = cvt_pk_bf16(o[4], o[5]); ov.w = cvt_pk_bf16(o[6], o[7]);
                *(u32x4*)(EMAT + ((size_t)g * 256 + n) * 512 + k8 * 8) = ov;
            }
            for (long i = gtid; i < 32 * 512 * 32; i += NGT) {
                const int c8 = (int)(i & 31), n = (int)((i >> 5) & 511), g = (int)(i >> 14); const int t = n >> 4, no = n & 15; const int dir = c8 >> 4, ri = (c8 >> 3) & 1, p0 = (c8 & 7) * 8;
                const int e = dir == 0 ? (t + 1) : (CH - t); const f32x2* pw = PW + ((size_t)(dir * 32 + g) * 33 + e) * 64 + p0;
                const float* cre = P.in[I_SCRE] + ((((size_t)L * 2 + dir) * 32 + g) * 16 + no) * 64 + p0; const float* cim = P.in[I_SCIM] + ((((size_t)L * 2 + dir) * 32 + g) * 16 + no) * 64 + p0;
                float o[8];
#pragma unroll
                for (int q = 0; q < 8; ++q) { const f32x2 w = pw[q]; const float cr = cre[q], ci = cim[q]; o[q] = ri == 0 ? (cr * w.x - ci * w.y) : -(cr * w.y + ci * w.x); }
                u32x4 ov; ov.x = cvt_pk_bf16(o[0], o[1]); ov.y = cvt_pk_bf16(o[2], o[3]); ov.z = cvt_pk_bf16(o[4], o[5]); ov.w = cvt_pk_bf16(o[6], o[7]);
                *(u32x4*)(TMAT + ((size_t)g * 512 + n) * KX + 512 + c8 * 8) = ov;
            }
        }
        GRID_BAR();
        { PH_INIT; MAKE_E; E.mode = 1; RUN_GEMM(XN, WQKVU, 1024, 1024, 1024, 128, 14, 1, E); }
        GRID_BAR();
        { PH_INIT; MAKE_E; E.mode = 2; RUN_GEMM(UEXT, EMAT, KX, 512, 512, 4, 1, 32, E); }
        {
            PH_INIT;
            __builtin_amdgcn_fence(__ATOMIC_ACQUIRE, "agent");
            if (bx < 128 && tid < 256) {
                const int g = bx >> 2, pm = bx & 3; const int p = tid & 63, dir = (tid >> 6) & 1, b = 2 * pm + (tid >> 7);
                const f32x2 al = PW[((size_t)(dir * 32 + g) * 33 + CH) * 64 + p];
                float xr = 0.f, xi = 0.f;
                const float* xl = XLOC + ((size_t)g * (NB * NCH) + b * NCH) * 256 + dir * 128 + p;
                bf16_t* ue = UEXT + ((size_t)g * (NB * NCH) + b * NCH) * KX + 512 + dir * 128 + p;
#pragma unroll 1
                for (int cb0 = 0; cb0 < NCH; cb0 += 16) {
                    float lr[16], li[16];
#pragma unroll
                    for (int q = 0; q < 16; ++q) { const int c = dir == 0 ? cb0 + q : NCH - 1 - cb0 - q; lr[q] = xl[(size_t)c * 256]; li[q] = xl[(size_t)c * 256 + 64]; }
#pragma unroll
                    for (int q = 0; q < 16; ++q) { const int c = dir == 0 ? cb0 + q : NCH - 1 - cb0 - q;
                        ue[(size_t)c * KX] = (bf16_t)(cvt_pk_bf16(xr, 0.f) & 0xffffu); ue[(size_t)c * KX + 64] = (bf16_t)(cvt_pk_bf16(xi, 0.f) & 0xffffu);
                        const float nr = al.x * xr - al.y * xi + lr[q], nim = al.x * xi + al.y * xr + li[q]; xr = nr; xi = nim; }
                }
            }
        }
        {
            PH_INIT;
            const float* dsk = P.in[I_SD] + L * 512;
            { LAS float* red = (LAS float*)lds; unsigned* kmx = (unsigned*)(ws + WS_KMAX);
              for (int blk = vcu; blk < T / 128; blk += G) {
                  float mx = 0.f;
#pragma unroll 4
                  for (int k = 0; k < 16; ++k) { const int m = blk * 128 + wave * 16 + k; const u32x4* kp = (const u32x4*)(KB + (size_t)m * DM + lane * 16); const u32x4 a = kp[0], b2 = kp[1]; float ss = 0.f;
#pragma unroll
                      for (int q = 0; q < 4; ++q) { ss += bf_lo(a[q]) * bf_lo(a[q]) + bf_hi(a[q]) * bf_hi(a[q]) + bf_lo(b2[q]) * bf_lo(b2[q]) + bf_hi(b2[q]) * bf_hi(b2[q]); }
                      ss += shfl_xor_l(ss, 1, lane); ss += shfl_xor_l(ss, 2, lane); mx = fmaxf(mx, ss); }
                  __syncthreads();
                  if ((lane & 3) == 0) red[wave * 16 + (lane >> 2)] = mx;
                  __syncthreads();
                  if (tid < 16) { float m2 = red[tid];
#pragma unroll
                      for (int w = 1; w < NWAVES; ++w) m2 = fmaxf(m2, red[w * 16 + tid]);
                      __hip_atomic_fetch_max(kmx + (blk >> 5) * 16 + tid, __float_as_uint(m2), __ATOMIC_RELAXED, __HIP_MEMORY_SCOPE_AGENT); }
              }
              __syncthreads(); }
            for (long i = gtid; i < 32 * 512 * 64; i += NGT) {
                const int k8 = (int)(i & 63), n = (int)((i >> 6) & 511), g = (int)(i >> 15); const int t = n >> 4, no = n & 15, s = k8 >> 1, ni0 = (k8 & 1) * 8;
                float o[8];
                if (t != s) { const int dir = t > s ? 0 : 1, tau = t > s ? t - s : s - t; const float* km = KM + ((((size_t)(dir * 32 + g)) * 32 + tau) * 16 + no) * 16 + ni0;
#pragma unroll
                    for (int q = 0; q < 8; ++q) o[q] = km[q];
                } else { const float* k0 = KM + (((size_t)(g) * 32) * 16 + no) * 16 + ni0; const float* k1 = KM + (((size_t)(32 + g) * 32) * 16 + no) * 16 + ni0;
#pragma unroll
                    for (int q = 0; q < 8; ++q) o[q] = k0[q] + k1[q] + ((ni0 + q) == no ? dsk[g * 16 + no] : 0.f);
                }
                u32x4 ov; ov.x = cvt_pk_bf16(o[0], o[1]); ov.y = cvt_pk_bf16(o[2], o[3]); ov.z = cvt_pk_bf16(o[4], o[5]); ov.w = cvt_pk_bf16(o[6], o[7]);
                *(u32x4*)(TMAT + ((size_t)g * 512 + n) * KX + k8 * 8) = ov;
            }
        }
        GRID_BAR();
        {
            PH_INIT;
            float s1 = wave_sum(P.in[I_LQ1][L * 64 + lane] * P.in[I_LK1][L * 64 + lane], lane), s2 = wave_sum(P.in[I_LQ2][L * 64 + lane] * P.in[I_LK2][L * 64 + lane], lane);
            const float lam = expf(s1) - expf(s2) + lambda_init;
            for (int i = 0; i < 4; ++i) { const int u = i * G + vcu; if (u >= 1024) break; const int bh = u >> 4, qb = u & 15;
                att::attn_unit(bh >> 3, bh & 7, qb, QB, KB, VB, QB, SCR + (size_t)bx * 32768, (const unsigned*)(ws + WS_KMAX), lam, 1.0f - lambda_init, P.in[I_SUBW] + L * 128, (char*)lds_raw); }
            __syncthreads();
        }
        { PH_INIT; MAKE_E; E.mode = 3; RUN_GEMM(UEXT, TMAT, KX, KX, KX, 4, 2, 32, E); }
        GRID_BAR();
        { PH_INIT; MAKE_E; E.mode = 4; RUN_GEMM(XN, WG, 1024, 1024, 1024, 128, 8, 1, E); }
        { PH_INIT; MAKE_E; E.mode = 5; RUN_GEMM(YB, WGLU, 512, 512, 512, 128, 8, 1, E); }
        GRID_BAR();
        { PH_INIT; MAKE_E; E.mode = 6; RUN_GEMM(QB, WAO, 1024, 1024, 1024, 128, 4, 1, E); }
        if (G0 != 256) GRID_BAR();
        else {
            PH_INIT;
            unsigned* apan = (unsigned*)(ws + WS_APAN) + (size_t)L * 128 * 64;
            pg8::Gemm gq_{KB, WOUT, 1024, 1024, 1024, 128, 4, 1, 0}; pg8::Order Sq_; Sq_.init(gq_, G, bx);
            pg8::Unit ua_, ub_; const bool ha_ = Sq_.next(0, ua_), hb_ = Sq_.next(1, ub_);
            const int pa_ = __builtin_amdgcn_readfirstlane(ha_ ? ua_.pm : -1), pb_ = __builtin_amdgcn_readfirstlane(hb_ ? ub_.pm : -1);
            if (tid == 0) {
                __builtin_amdgcn_fence(__ATOMIC_RELEASE, "agent"); asm volatile("s_waitcnt vmcnt(0)" ::: "memory");
                if (pa_ >= 0) __hip_atomic_fetch_add(apan + 64 * pa_, 1u, __ATOMIC_RELAXED, __HIP_MEMORY_SCOPE_AGENT);
                if (pb_ >= 0) __hip_atomic_fetch_add(apan + 64 * pb_, 1u, __ATOMIC_RELAXED, __HIP_MEMORY_SCOPE_AGENT);
                unsigned sp = 0;
                if (pa_ >= 0) while (__hip_atomic_load(apan + 64 * pa_, __ATOMIC_RELAXED, __HIP_MEMORY_SCOPE_AGENT) < 4u) { __builtin_amdgcn_s_sleep(2); if (++sp > (1u << 22)) break; }
                if (pb_ >= 0) while (__hip_atomic_load(apan + 64 * pb_, __ATOMIC_RELAXED, __HIP_MEMORY_SCOPE_AGENT) < 4u) { __builtin_amdgcn_s_sleep(2); if (++sp > (1u << 22)) break; }
                __builtin_amdgcn_fence(__ATOMIC_ACQUIRE, "agent"); asm volatile("s_waitcnt vmcnt(0)" ::: "memory");
            }
            __syncthreads();
        }
        { PH_INIT; MAKE_E; E.mode = 7; E.gate = MOD + (size_t)L * NB * 6144 + 2048; E.base = (L == 0) ? P.in[I_X] : xo;
          E.nw = P.in[I_N2W] + L * DM; E.nmod = MOD + (size_t)L * NB * 6144 + 3072; E.XNo = XN; E.xs = (float*)(ws + WS_XS); E.cnt = (unsigned*)(ws + WS_CNT) + (size_t)(2 * L) * 128 * 64;
          if (G == 256) { E.nf = 1; RUN_GEMM(KB, WOUT, 1024, 1024, 1024, 128, 4, 1, E); } else { E.nf = 0; RUN_GEMM(KB, WOUT, 1024, 1024, 1024, 128, 4, 1, E); } }
        GRID_BAR();
        if (G0 != 256) {
            {
                PH_INIT;
                const float* nw = P.in[I_N2W] + L * DM;
                norm_rows(xo, nw, MOD + (size_t)L * NB * 6144, 3072, XN, nullptr, gw, NGW, lane);
            }
            GRID_BAR();
        }
        { PH_INIT; MAKE_E; E.mode = 8; E.cw = P.in[I_CONVW] + (size_t)L * 3 * NUP; E.cb = P.in[I_CONVB] + (size_t)L * NUP;
          pg8::Gemm g_{XN, WUP, 1024, 1024, 1024, 128, 22, 1, 1}; pg8::Order S_; S_.init(g_, G, bx);
#pragma unroll 1
          for (int i = 0; ; ++i) { pg8::Unit uu; if (!S_.next(i, uu)) break; pg8::Order S1 = S_; S1.single = 1; S1.one = uu; pg8::gemm_phase(lds, g_, S1, E); } }
        GRID_BAR();
        { PH_INIT;
          pg8::Gemm gd_{ACT, WDOWN, DFF, DFF, DFF, 128, 4, 1, 0}; pg8::Order Sd_; Sd_.init(gd_, G, bx);
#pragma unroll 1
          for (int i = 0; ; ++i) { pg8::Unit uu; if (!Sd_.next(i, uu)) break; conv_fix(uu.pm, TSB, ACT, P.in[I_CONVW] + (size_t)L * 3 * NUP, P.in[I_CONVB] + (size_t)L * NUP, tid); }
          asm volatile("s_waitcnt vmcnt(0)" ::: "memory"); __syncthreads(); }
        { PH_INIT; MAKE_E; E.mode = 7; E.gate = MOD + (size_t)L * NB * 6144 + 5120; E.base = xo;
          E.nw = P.in[I_N1W] + (L + 1) * DM; E.nmod = MOD + (size_t)(L + 1) * NB * 6144; E.XNo = XN; E.xs = (float*)(ws + WS_XS); E.cnt = (unsigned*)(ws + WS_CNT) + (size_t)1 * 128 * 64;
          if (G == 256 && L == 0) { E.nf = 1; RUN_GEMM(ACT, WDOWN, DFF, DFF, DFF, 128, 4, 1, E); }
          else if (G == 256) { E.nf = 2; E.nw = P.in[I_FINW]; E.cnt = (unsigned*)(ws + WS_CNT) + (size_t)3 * 128 * 64; RUN_GEMM(ACT, WDOWN, DFF, DFF, DFF, 128, 4, 1, E); }
          else { E.nf = 0; RUN_GEMM(ACT, WDOWN, DFF, DFF, DFF, 128, 4, 1, E); } }
        if (l == 0 || G0 != 256) GRID_BAR();
    }
    if (G0 != 256) {
        const int l = 2;
        PH_INIT;
        const float* nw = P.in[I_FINW];
        norm_rows(xo, nw, nullptr, 0, nullptr, xo, gw, NGW, lane);
    }
}

extern "C" void kernel_launch(void* const* d_in, const int* in_sizes, int n_in, void* d_out, int out_size, void* d_ws, size_t ws_size, hipStream_t stream) {
    static int grid = 0;
    if (grid == 0) {
        if (n_in != 29 || out_size != T * DM || ws_size < WS_END) { fprintf(stderr, "kernel_launch: unexpected shapes n_in %d out %d ws %zu (need %zu)\n", n_in, out_size, ws_size, (size_t)WS_END); grid = -1; return; }
        int dev = 0, cus = 0, per_cu = 0;
        (void)hipGetDevice(&dev); (void)hipDeviceGetAttribute(&cus, hipDeviceAttributeMultiprocessorCount, dev);
        if (hipFuncSetAttribute((const void*)mega, hipFuncAttributeMaxDynamicSharedMemorySize, LDS_BYTES) != hipSuccess) { fprintf(stderr, "kernel_launch: hipFuncSetAttribute failed\n"); grid = -1; return; }
        (void)hipOccupancyMaxActiveBlocksPerMultiprocessor(&per_cu, (const void*)mega, NTHR, LDS_BYTES);
        if (per_cu < 1) { fprintf(stderr, "kernel_launch: occupancy query says %d blocks per CU\n", per_cu); per_cu = 1; }
        (void)hipGetLastError();
        grid = cus;
    }
    if (grid < 0) return;
    Params p{};
    for (int i = 0; i < 29; ++i) p.in[i] = (const float*)d_in[i];
    p.out = (float*)d_out; p.ws = (unsigned char*)d_ws;
    void* args[] = {&p};
    if (hipMemsetAsync(d_ws, 0, 832 * 1024, stream) != hipSuccess) { fprintf(stderr, "kernel_launch: hipMemsetAsync of the control words failed\n"); return; }
    hipError_t e = hipLaunchCooperativeKernel((const void*)mega, dim3(grid), dim3(NTHR), args, LDS_BYTES, stream);
    if (e != hipSuccess) fprintf(stderr, "cooperative launch failed: %s (grid %d)\n", hipGetErrorString(e), grid);
}
```

```cpp
#include <hip/hip_runtime.h>
#include <hip/hip_cooperative_groups.h>
#include <cstdio>
#include <cstdint>
namespace cg = cooperative_groups;

#define LAS __attribute__((address_space(3)))
#define GAS __attribute__((address_space(1)))
typedef unsigned short bf16_t;
typedef short bf16x8 __attribute__((ext_vector_type(8)));
typedef short s16x4 __attribute__((ext_vector_type(4)));
typedef float f32x2 __attribute__((ext_vector_type(2)));
typedef float f32x4 __attribute__((ext_vector_type(4)));
typedef float f32x16 __attribute__((ext_vector_type(16)));
typedef unsigned u32x2 __attribute__((ext_vector_type(2)));
typedef unsigned u32x4 __attribute__((ext_vector_type(4)));

constexpr int NB = 8, SEQ = 4096, DM = 1024, T = NB * SEQ, DFF = 2816, NUP = 2 * DFF, NWAVES = 8, NTHR = 512;
constexpr int CH = 32, NCH = SEQ / CH, KX = 768;
constexpr size_t MiB = 1u << 20;
constexpr size_t WS_CNT = 128 * 1024, WS_XS = 256 * 1024;
constexpr size_t WS_KMAX = 64 * 1024, WS_MOD = 1 * MiB, WS_ROPE = 2 * MiB, WS_PW = 3 * MiB, WS_BB = 5 * MiB, WS_KM = 6 * MiB;
constexpr size_t WS_WQKVU = 8 * MiB, WS_WG = 15 * MiB, WS_WAO = 19 * MiB, WS_WGLU = 21 * MiB, WS_WOUT = 23 * MiB, WS_WUP = 25 * MiB, WS_WDOWN = 36 * MiB;
constexpr size_t WS_TMAT = 42 * MiB, WS_EMAT = 66 * MiB, WS_XN = 74 * MiB;
constexpr size_t WS_Q = 138 * MiB, WS_K = 202 * MiB, WS_V = 266 * MiB, WS_UEXT = 330 * MiB, WS_XLOC = 378 * MiB, WS_SCR = 410 * MiB;
constexpr size_t WS_OS = 442 * MiB;
constexpr size_t WS_UP = 138 * MiB, WS_ACT = 314 * MiB, WS_END = 506 * MiB;
constexpr int LDS_BYTES = 147456;

struct Params {
    const float* in[29];
    float* out;
    unsigned char* ws;
};
enum { I_X = 0, I_C, I_N1W, I_N2W, I_ADAW, I_ADAB, I_WIN, I_LQ1, I_LK1, I_LQ2, I_LK2, I_SUBW, I_WAO, I_SLRE, I_SLIM, I_SLDT, I_SBRE, I_SBIM, I_SCRE, I_SCIM, I_SD,
       I_WGA, I_WGB, I_WOUT, I_WUP, I_CONVW, I_CONVB, I_WDOWN, I_FINW };

__device__ __forceinline__ unsigned cvt_pk_bf16(float lo, float hi) { unsigned r; asm volatile("v_cvt_pk_bf16_f32 %0, %1, %2" : "=v"(r) : "v"(lo), "v"(hi)); return r; }
typedef __bf16 bf16x2_t __attribute__((ext_vector_type(2)));
__device__ __forceinline__ unsigned cvt_pk_bf16_b(float lo, float hi) { f32x2 v = {lo, hi}; bf16x2_t b = __builtin_convertvector(v, bf16x2_t); return __builtin_bit_cast(unsigned, b); }
__device__ __forceinline__ float bf_lo(unsigned w) { return __uint_as_float(w << 16); }
__device__ __forceinline__ float bf_hi(unsigned w) { return __uint_as_float(w & 0xffff0000u); }
__device__ __forceinline__ float sigmoidf_(float x) { return __builtin_amdgcn_rcpf(1.0f + __expf(-x)); }
__device__ __forceinline__ float gelu_tanh(float x) { const float z = 0.7978845608028654f * (x + 0.044715f * x * x * x); return x * __builtin_amdgcn_rcpf(1.0f + __expf(-2.0f * z)); }
__device__ __forceinline__ float shfl_xor_l(float v, int x, int lane) { return __uint_as_float((unsigned)__builtin_amdgcn_ds_bpermute((lane ^ x) << 2, (int)__float_as_uint(v))); }
__device__ __forceinline__ float wave_sum(float v, int lane) {
#pragma unroll
    for (int o = 1; o < 64; o <<= 1) v += shfl_xor_l(v, o, lane);
    return v;
}

namespace pg8 {
constexpr int BM = 256, BK = 64, HALF = 128, HTB = HALF * BK * 2, NXCD = 8, WGM = 8;
__host__ __device__ __forceinline__ int lds_byte(int r, int c) { const int st = (r >> 4) * 2 + (c >> 5), rr = r & 15, cc = c & 31, ob = rr * 64 + cc * 2; return st * 1024 + (ob ^ (((ob >> 9) & 1) << 5)); }
__host__ __device__ __forceinline__ void stage_rc(int b, int& R, int& C) { const int st = b / 1024, sb = b % 1024, swz = sb ^ (((sb >> 9) & 1) << 5); R = (st >> 1) * 16 + swz / 64; C = (st & 1) * 32 + (swz % 64) / 2; }

__host__ __device__ __forceinline__ int perm32(int rho) { const int n = rho >> 4, i = rho & 15; return 8 * (i >> 2) + 4 * n + (i & 3); }
struct Unit { int pm, pn, grp; };
struct Gemm { const bf16_t* A; const bf16_t* Bt; int lda, ldb, K, nM, nN, ngrp, ovl; };
struct Order {
    int nM, nN, ngrp, nwg, G, c, single; Unit one;
    __device__ __forceinline__ void init(const Gemm& g, int G_, int c_) { nM = g.nM; nN = g.nN; ngrp = g.ngrp; nwg = nM * nN * ngrp; G = G_; c = c_; single = 0; one.pm = 0; one.pn = 0; one.grp = 0; }
    __device__ __forceinline__ bool next(int i, Unit& u) const {
        if (single) { if (i) return false; u = one; return true; }
        const long L = (long)i * G + c; if (L >= nwg) return false;
        if (ngrp == 1) {
            int wgid = (int)L; { const int q = nwg / NXCD, r = nwg % NXCD, xcd = wgid % NXCD, off = wgid / NXCD; wgid = (xcd < r ? xcd * (q + 1) : r * (q + 1) + (xcd - r) * q) + off; }
            const int nig = WGM * nN, gid = wgid / nig, fm = gid * WGM, gsz = (nM - fm) < WGM ? (nM - fm) : WGM;
            u.pm = fm + ((wgid % nig) % gsz); u.pn = (wgid % nig) / gsz; u.grp = 0;
        } else {
            const int per = nM * nN; const int w = (int)(L % per); u.grp = (int)(L / per); u.pm = w % nM; u.pn = w / nM;
        }
        return true;
    }
};

struct Epi {
    int mode, layer;
    bf16_t *Q, *Kb, *Vb, *Uext, *Y, *TS, *ACT, *OS, *RAWb; const float *cw, *cb;
    int nf; const float *nw, *nmod; bf16_t* XNo; float* xs; unsigned* cnt;
    float* xloc; const float* rope; const float* gate; const float* base; float* xout;
    static __device__ __forceinline__ u32x4 pack8(const f32x4 a, const f32x4 b) { u32x4 w; w.x = cvt_pk_bf16_b(a[0], a[1]); w.y = cvt_pk_bf16_b(a[2], a[3]); w.z = cvt_pk_bf16_b(b[0], b[1]); w.w = cvt_pk_bf16_b(b[2], b[3]); return w; }
    __device__ __forceinline__ void fused(const f32x4 (&acc)[2][2][4][2], const Unit& u, int wr, int wc, int fr, int fq, LAS unsigned char* lds) const {
        constexpr int RS = 528;
        LAS unsigned char* tb = lds + RS;
#pragma unroll
        for (int ai = 0; ai < 2; ++ai)
#pragma unroll
            for (int m = 0; m < 4; ++m)
#pragma unroll
                for (int bj = 0; bj < 2; ++bj) *(LAS u32x4*)(tb + (ai * HALF + wr * 64 + m * 16 + fr) * RS + (bj * HALF + wc * 32 + fq * 8) * 2) = pack8(acc[ai][bj][m][0], acc[ai][bj][m][1]);
        asm volatile("s_waitcnt lgkmcnt(0)" ::: "memory"); __builtin_amdgcn_s_barrier(); asm volatile("" ::: "memory");
        int tid2 = (wr * 4 + wc) * 64 + fq * 16 + fr; asm volatile("" : "+v"(tid2));
        const int cp = tid2 & 15, rg = tid2 >> 4;
        const int bb = u.pm >> 4, ti = u.pm & 15, s0 = 256 * ti; const int j0 = u.pn * 128 + cp * 8;
        u32x4 ra[10], rb[10];
        { const LAS unsigned char* p0 = tb + (8 * rg - 1) * RS + cp * 32;
#pragma unroll
          for (int q = 0; q < 10; ++q) { ra[q] = *(const LAS u32x4*)(p0 + q * RS); rb[q] = *(const LAS u32x4*)(p0 + q * RS + 16); } }
        float wv[3][8], wg[3][8], bv[8], bg[8];
#pragma unroll
        for (int k = 0; k < 3; ++k) { const f32x4 a0 = *(const GAS f32x4*)(cw + k * NUP + j0), a1 = *(const GAS f32x4*)(cw + k * NUP + j0 + 4), g0 = *(const GAS f32x4*)(cw + k * NUP + DFF + j0), g1 = *(const GAS f32x4*)(cw + k * NUP + DFF + j0 + 4);
#pragma unroll
            for (int q = 0; q < 4; ++q) { wv[k][q] = a0[q]; wv[k][q + 4] = a1[q]; wg[k][q] = g0[q]; wg[k][q + 4] = g1[q]; } }
        { const f32x4 a0 = *(const GAS f32x4*)(cb + j0), a1 = *(const GAS f32x4*)(cb + j0 + 4), g0 = *(const GAS f32x4*)(cb + DFF + j0), g1 = *(const GAS f32x4*)(cb + DFF + j0 + 4);
#pragma unroll
          for (int q = 0; q < 4; ++q) { bv[q] = a0[q]; bv[q + 4] = a1[q]; bg[q] = g0[q]; bg[q + 4] = g1[q]; } }
        asm volatile("s_waitcnt lgkmcnt(0)" ::: "memory"); __builtin_amdgcn_s_barrier(); asm volatile("" ::: "memory");
        if (rg == 0) { bf16_t* rp = RAWb + ((size_t)u.pm * 4) * NUP + u.pn * 256 + cp * 16; *(GAS u32x4*)rp = ra[1]; *(GAS u32x4*)(rp + 8) = rb[1]; *(GAS u32x4*)(rp + NUP) = ra[2]; *(GAS u32x4*)(rp + NUP + 8) = rb[2]; }
        if (rg == 31) { bf16_t* rp = RAWb + ((size_t)u.pm * 4 + 2) * NUP + u.pn * 256 + cp * 16; *(GAS u32x4*)rp = ra[7]; *(GAS u32x4*)(rp + 8) = rb[7]; *(GAS u32x4*)(rp + NUP) = ra[8]; *(GAS u32x4*)(rp + NUP + 8) = rb[8]; }
#pragma unroll
        for (int r = 0; r < 8; ++r) {
            const int tl = 8 * rg + r, s = s0 + tl;
            if ((tl >= 1 && tl <= 254) || (tl == 0 && ti == 0) || (tl == 255 && ti == 15)) {
                const bool pz = (s == 0), nz = (s == SEQ - 1); const u32x4 z4 = (u32x4){0u, 0u, 0u, 0u};
                float o[8];
#pragma unroll
                for (int h = 0; h < 2; ++h) {
                    const u32x4 p = pz ? z4 : (h ? rb[r] : ra[r]), c = h ? rb[r + 1] : ra[r + 1], n = nz ? z4 : (h ? rb[r + 2] : ra[r + 2]);
#pragma unroll
                    for (int q2 = 0; q2 < 2; ++q2) { const int e = 4 * h + 2 * q2;
                        const float v0 = wv[0][e] * bf_lo(p[q2]) + wv[1][e] * bf_lo(c[q2]) + wv[2][e] * bf_lo(n[q2]) + bv[e];
                        const float v1 = wv[0][e + 1] * bf_hi(p[q2]) + wv[1][e + 1] * bf_hi(c[q2]) + wv[2][e + 1] * bf_hi(n[q2]) + bv[e + 1];
                        const float g0 = wg[0][e] * bf_lo(p[2 + q2]) + wg[1][e] * bf_lo(c[2 + q2]) + wg[2][e] * bf_lo(n[2 + q2]) + bg[e];
                        const float g1 = wg[0][e + 1] * bf_hi(p[2 + q2]) + wg[1][e + 1] * bf_hi(c[2 + q2]) + wg[2][e + 1] * bf_hi(n[2 + q2]) + bg[e + 1];
                        o[e] = g0 * sigmoidf_(g0) * v0; o[e + 1] = g1 * sigmoidf_(g1) * v1; }
                }
                u32x4 ov; ov.x = cvt_pk_bf16_b(o[0], o[1]); ov.y = cvt_pk_bf16_b(o[2], o[3]); ov.z = cvt_pk_bf16_b(o[4], o[5]); ov.w = cvt_pk_bf16_b(o[6], o[7]);
                *(GAS u32x4*)(ACT + ((size_t)bb * SEQ + s) * DFF + j0) = ov;
            }
        }
    }
    __device__ __forceinline__ void resnorm(f32x4 (&acc)[2][2][4][2], const Unit& u, int wr, int wc, int fr, int fq, LAS unsigned char* lds) const {
        LAS float* Pt = (LAS float*)(lds + 131072); LAS float* St = (LAS float*)(lds + 131072 + 4096);
        const int colt = u.pn * BM; const int cc0 = colt + wc * 32 + fq * 8; const int bb = (u.pm * BM) >> 12;
        int lane_ = fq * 16 + fr; asm volatile("" : "+v"(lane_));
        f32x4 gv[2][2];
#pragma unroll
        for (int bj = 0; bj < 2; ++bj) { const float* gp = gate + (size_t)bb * 6144 + cc0 + bj * HALF; gv[bj][0] = *(const f32x4*)gp; gv[bj][1] = *(const GAS f32x4*)(gp + 4); }
#pragma unroll
        for (int ai = 0; ai < 2; ++ai)
#pragma unroll
            for (int m = 0; m < 4; ++m) {
                float s = 0.f;
#pragma unroll
                for (int bj = 0; bj < 2; ++bj) { const size_t off = (size_t)(u.pm * BM + ai * HALF + wr * 64 + m * 16 + fr) * DM + cc0 + bj * HALF;
                    const f32x4 x0 = *(const GAS f32x4*)(base + off) + gv[bj][0] * acc[ai][bj][m][0], x1 = *(const GAS f32x4*)(base + off + 4) + gv[bj][1] * acc[ai][bj][m][1];
                    if (nf != 2) { *(GAS f32x4*)(xout + off) = x0; *(GAS f32x4*)(xout + off + 4) = x1; } acc[ai][bj][m][0] = x0; acc[ai][bj][m][1] = x1;
                    s += (x0[0] * x0[0] + x0[1] * x0[1]) + (x0[2] * x0[2] + x0[3] * x0[3]) + (x1[0] * x1[0] + x1[1] * x1[1]) + (x1[2] * x1[2] + x1[3] * x1[3]); }
                s += shfl_xor_l(s, 16, lane_); s += shfl_xor_l(s, 32, lane_);
                if (fq == 0) Pt[(ai * HALF + wr * 64 + m * 16 + fr) * 4 + wc] = s;
            }
        asm volatile("s_waitcnt lgkmcnt(0)" ::: "memory"); __builtin_amdgcn_s_barrier(); asm volatile("" ::: "memory");
        int tid_ = (wr * 4 + wc) * 64 + lane_; asm volatile("" : "+v"(tid_));
        unsigned* cw_ = cnt + 64 * u.pm;
        if (tid_ < 256) { const float tot = (Pt[tid_ * 4 + 0] + Pt[tid_ * 4 + 1]) + (Pt[tid_ * 4 + 2] + Pt[tid_ * 4 + 3]);
            __hip_atomic_store(xs + ((size_t)(u.pm * BM + tid_) * 4 + u.pn), tot, __ATOMIC_RELAXED, __HIP_MEMORY_SCOPE_AGENT);
            asm volatile("s_waitcnt vmcnt(0)" ::: "memory");
            if (lane_ == 0) __hip_atomic_fetch_add(cw_, 1u, __ATOMIC_RELAXED, __HIP_MEMORY_SCOPE_AGENT); }
        if (tid_ < 64) {
            unsigned sp = 0;
            while ((unsigned)__builtin_amdgcn_readfirstlane((int)__hip_atomic_load(cw_, __ATOMIC_RELAXED, __HIP_MEMORY_SCOPE_AGENT)) < 16u) { __builtin_amdgcn_s_sleep(2); if (++sp > (1u << 22)) break; }
            __builtin_amdgcn_fence(__ATOMIC_ACQUIRE, "agent");
        }
        asm volatile("s_waitcnt vmcnt(0) lgkmcnt(0)" ::: "memory"); __builtin_amdgcn_s_barrier(); asm volatile("" ::: "memory");
        if (tid_ < 256) { const float* sl = xs + (size_t)(u.pm * BM + tid_) * 4;
            const float t0 = __hip_atomic_load(sl + 0, __ATOMIC_RELAXED, __HIP_MEMORY_SCOPE_AGENT), t1 = __hip_atomic_load(sl + 1, __ATOMIC_RELAXED, __HIP_MEMORY_SCOPE_AGENT),
                        t2 = __hip_atomic_load(sl + 2, __ATOMIC_RELAXED, __HIP_MEMORY_SCOPE_AGENT), t3 = __hip_atomic_load(sl + 3, __ATOMIC_RELAXED, __HIP_MEMORY_SCOPE_AGENT);
            St[tid_] = rsqrtf(((t0 + t1) + (t2 + t3)) * (1.0f / DM) + 1e-6f); }
        asm volatile("s_waitcnt lgkmcnt(0)" ::: "memory"); __builtin_amdgcn_s_barrier(); asm volatile("" ::: "memory");
        if (nf == 2) {
#pragma unroll
            for (int bj = 0; bj < 2; ++bj) { const int cc = cc0 + bj * HALF; const f32x4 w0 = *(const GAS f32x4*)(nw + cc), w1 = *(const GAS f32x4*)(nw + cc + 4);
#pragma unroll
                for (int ai = 0; ai < 2; ++ai)
#pragma unroll
                    for (int m = 0; m < 4; ++m) { const int rl = ai * HALF + wr * 64 + m * 16 + fr; const float r = St[rl]; float* o = xout + (size_t)(u.pm * BM + rl) * DM + cc;
                        *(GAS f32x4*)o = acc[ai][bj][m][0] * r * w0; *(GAS f32x4*)(o + 4) = acc[ai][bj][m][1] * r * w1; } }
            return;
        }
        const float* md = nmod + (size_t)bb * 6144;
#pragma unroll
        for (int bj = 0; bj < 2; ++bj) {
            const int cc = cc0 + bj * HALF;
            const f32x4 w0 = *(const GAS f32x4*)(nw + cc), w1 = *(const GAS f32x4*)(nw + cc + 4), sh0 = *(const GAS f32x4*)(md + cc), sh1 = *(const GAS f32x4*)(md + cc + 4), sc0 = *(const GAS f32x4*)(md + 1024 + cc), sc1 = *(const GAS f32x4*)(md + 1024 + cc + 4);
            const f32x4 a0 = w0 * (sc0 + 1.0f), a1 = w1 * (sc1 + 1.0f);
#pragma unroll
            for (int ai = 0; ai < 2; ++ai)
#pragma unroll
                for (int m = 0; m < 4; ++m) { const int rl = ai * HALF + wr * 64 + m * 16 + fr; const float r = St[rl];
                    *(GAS u32x4*)(XNo + (size_t)(u.pm * BM + rl) * DM + cc) = pack8(acc[ai][bj][m][0] * r * a0 + sh0, acc[ai][bj][m][1] * r * a1 + sh1); }
        }
    }
    __device__ __forceinline__ void operator()(const f32x4 (&acc)[2][2][4][2], const Unit& u, int wr, int wc, int fr, int fq) const {
        const int colt = u.pn * BM;
#pragma unroll
        for (int ai = 0; ai < 2; ++ai)
#pragma unroll
            for (int m = 0; m < 4; ++m) {
                const int rl = ai * HALF + wr * 64 + m * 16 + fr;
                const int row = u.pm * BM + rl;
#pragma unroll
                for (int bj = 0; bj < 2; ++bj) {
                    const int cl = bj * HALF + wc * 32 + fq * 8;
                    const f32x4 v0 = acc[ai][bj][m][0], v1 = acc[ai][bj][m][1];
                    if (mode == 1) {
                        if (colt < 2048) {
                            bf16_t* dst = colt < 1024 ? Q : Kb; const int cc = (colt & 1023) + cl; const int s = row & (SEQ - 1); const int i = (cc & 63) >> 1;
                            const f32x4 c0 = *(const GAS f32x4*)(rope + ((size_t)s * 32 + i) * 2), c1 = *(const GAS f32x4*)(rope + ((size_t)s * 32 + i) * 2 + 4);
                            const f32x4 o0 = {v0[0] * c0[0] - v0[1] * c0[1], v0[1] * c0[0] + v0[0] * c0[1], v0[2] * c0[2] - v0[3] * c0[3], v0[3] * c0[2] + v0[2] * c0[3]};
                            const f32x4 o1 = {v1[0] * c1[0] - v1[1] * c1[1], v1[1] * c1[0] + v1[0] * c1[1], v1[2] * c1[2] - v1[3] * c1[3], v1[3] * c1[2] + v1[2] * c1[3]};
                            const float qsc = colt < 1024 ? 0.18033688011112042f : 1.0f;
                            *(GAS u32x4*)(dst + (size_t)row * DM + cc) = pack8(o0 * qsc, o1 * qsc);
                        } else if (colt < 3072) {
                            *(GAS u32x4*)(Vb + (size_t)row * DM + (colt - 2048) + cl) = pack8(v0, v1);
                        } else {
                            const int uc = colt - 3072 + cl, g = uc >> 4, ni = uc & 15; const int b = row >> 12, s = row & (SEQ - 1), ch = s >> 5, sl = s & 31;
                            *(GAS u32x4*)(Uext + ((size_t)(g * (NB * NCH) + b * NCH + ch)) * KX + sl * 16 + ni) = pack8(v0, v1);
                        }
                    } else if (mode == 2) {
                        float* p = xloc + ((size_t)(u.grp * (NB * NCH) + row)) * 256 + cl; *(GAS f32x4*)p = v0; *(GAS f32x4*)(p + 4) = v1;
                    } else if (mode == 3) {
                        const int b = row >> 7, ch = row & 127; const int nn = colt + cl, t = nn >> 4, no = nn & 15; const size_t tok = (size_t)b * SEQ + ch * CH + t;
                        const f32x4 g0 = {gelu_tanh(v0[0]), gelu_tanh(v0[1]), gelu_tanh(v0[2]), gelu_tanh(v0[3])}, g1 = {gelu_tanh(v1[0]), gelu_tanh(v1[1]), gelu_tanh(v1[2]), gelu_tanh(v1[3])};
                        *(GAS u32x4*)(Y + tok * 512 + u.grp * 16 + no) = pack8(g0, g1);
                    } else if (mode == 4) {
                        bf16_t* dst = colt < 1024 ? Kb : Vb; const int cc = (colt & 1023) + cl;
                        const f32x4 g0 = {sigmoidf_(v0[0]), sigmoidf_(v0[1]), sigmoidf_(v0[2]), sigmoidf_(v0[3])}, g1 = {sigmoidf_(v1[0]), sigmoidf_(v1[1]), sigmoidf_(v1[2]), sigmoidf_(v1[3])};
                        *(GAS u32x4*)(dst + (size_t)row * DM + cc) = pack8(g0, g1);
                    } else if (mode == 5) {
                        const int cc = u.pn * 128 + bj * 64 + wc * 16 + fq * 4;
                        u32x2 w; w.x = cvt_pk_bf16_b(v0[0] * sigmoidf_(v1[0]), v0[1] * sigmoidf_(v1[1])); w.y = cvt_pk_bf16_b(v0[2] * sigmoidf_(v1[2]), v0[3] * sigmoidf_(v1[3]));
                        *(GAS u32x2*)(OS + (size_t)row * DM + cc) = w;
                    } else if (mode == 6) {
                        const int cc = colt + cl; bf16_t* p = Kb + (size_t)row * DM + cc; const u32x4 sg = *(const GAS u32x4*)p; const u32x4 ss = *(const GAS u32x4*)(Vb + (size_t)row * DM + cc); const u32x4 os = *(const GAS u32x4*)(OS + (size_t)row * DM + cc);
                        const f32x4 o0 = {bf_lo(sg.x) * v0[0] + bf_lo(ss.x) * bf_lo(os.x), bf_hi(sg.x) * v0[1] + bf_hi(ss.x) * bf_hi(os.x), bf_lo(sg.y) * v0[2] + bf_lo(ss.y) * bf_lo(os.y), bf_hi(sg.y) * v0[3] + bf_hi(ss.y) * bf_hi(os.y)};
                        const f32x4 o1 = {bf_lo(sg.z) * v1[0] + bf_lo(ss.z) * bf_lo(os.z), bf_hi(sg.z) * v1[1] + bf_hi(ss.z) * bf_hi(os.z), bf_lo(sg.w) * v1[2] + bf_lo(ss.w) * bf_lo(os.w), bf_hi(sg.w) * v1[3] + bf_hi(ss.w) * bf_hi(os.w)};
                        *(GAS u32x4*)p = pack8(o0, o1);
                    } else if (mode == 7) {
                        const int cc = colt + cl; const int b = row >> 12; const float* gp = gate + (size_t)b * 6144 + cc; const f32x4 g0 = *(const f32x4*)gp, g1 = *(const GAS f32x4*)(gp + 4); const size_t off = (size_t)row * DM + cc;
                        const f32x4 b0 = *(const GAS f32x4*)(base + off), b1 = *(const GAS f32x4*)(base + off + 4); *(GAS f32x4*)(xout + off) = b0 + g0 * v0; *(GAS f32x4*)(xout + off + 4) = b1 + g1 * v1;
                    }
                }
            }
    }
};

__device__ __forceinline__ void gemm_phase(LAS unsigned char* lds, const Gemm g, const Order& S, const Epi& E) {
    int tid = threadIdx.x; asm volatile("" : "+v"(tid));
    const int wid = __builtin_amdgcn_readfirstlane(tid >> 6), lane = tid & 63, wr = wid >> 2, wc = wid & 3, fr = lane & 15, fq = lane >> 4;
    const int K = g.K, nt = K / BK;
    unsigned voffA[2], voffB[2];
#pragma unroll
    for (int i = 0; i < 2; ++i) { int R, C; stage_rc(tid * 16 + i * 8192, R, C); const int Rb = (R & ~31) + perm32(R & 31); voffA[i] = (unsigned)(R * g.lda + C) * 2u; voffB[i] = (unsigned)(Rb * g.ldb + C) * 2u; }
    const size_t kstep = (size_t)(BK * 2);
    const size_t hstepA = (size_t)HALF * g.lda * 2, hstepB = (size_t)HALF * g.ldb * 2;
    const size_t tstepA = 2 * hstepA, tstepB = 2 * hstepB;
    const unsigned ldsw = (unsigned)wid * 1024u;
    const int aoff = lds_byte(wr * 64 + fr, fq * 8), boff = lds_byte(wc * 32 + fr, fq * 8);
#define PG8_SA(b, h) (((b) * 2 + (h)) * HTB)
#define PG8_SB(b, h) ((4 + (b) * 2 + (h)) * HTB)
#define PG8_STAGE(bufoff, gbase, voff) do { _Pragma("unroll") for (int _i = 0; _i < 2; ++_i) \
        __builtin_amdgcn_global_load_lds((const unsigned*)((const char*)(gbase) + (voff)[_i]), (LAS unsigned*)(lds + (bufoff) + ldsw + _i * 8192), 16, 0, 0); } while (0)
#define PG8_LDA(dst, b, h) do { _Pragma("unroll") for (int m = 0; m < 4; ++m) _Pragma("unroll") for (int k = 0; k < 2; ++k) dst[m][k] = *(const LAS bf16x8*)(lds + PG8_SA(b, h) + aoff + m * 2048 + k * 1024); } while (0)
#define PG8_LDB(dst, b, h) do { _Pragma("unroll") for (int n = 0; n < 2; ++n) _Pragma("unroll") for (int k = 0; k < 2; ++k) dst[n][k] = *(const LAS bf16x8*)(lds + PG8_SB(b, h) + boff + n * 2048 + k * 1024); } while (0)
#define PG8_MMA(ai, bj, At, Bt) do { __builtin_amdgcn_s_setprio(1); _Pragma("unroll") for (int m = 0; m < 4; ++m) _Pragma("unroll") for (int n = 0; n < 2; ++n) _Pragma("unroll") for (int k = 0; k < 2; ++k) \
        acc[ai][bj][m][n] = __builtin_amdgcn_mfma_f32_16x16x32_bf16(Bt[n][k], At[m][k], acc[ai][bj][m][n], 0, 0, 0); __builtin_amdgcn_s_setprio(0); } while (0)
#define PG8_WAIT_V(n) asm volatile("s_waitcnt vmcnt(" #n ")" ::: "memory")
#define PG8_WAIT_L(n) asm volatile("s_waitcnt lgkmcnt(" #n ")" ::: "memory")
#define PG8_BAR __builtin_amdgcn_s_barrier()
#define PG8_SCHED __builtin_amdgcn_sched_barrier(0)
    Unit cur, nxt; int ui = 0;
    if (!S.next(0, cur)) return;
    f32x4 acc[2][2][4][2];
#pragma unroll
    for (int a = 0; a < 2; ++a)
#pragma unroll
        for (int b = 0; b < 2; ++b)
#pragma unroll
            for (int m = 0; m < 4; ++m)
#pragma unroll
                for (int n = 0; n < 2; ++n) acc[a][b][m][n] = (f32x4){0.f, 0.f, 0.f, 0.f};
    bf16x8 At[4][2], B0[2][2], B1[2][2];
#define PG8_AOFF(u_) ((long)((u_).grp * g.nM + (u_).pm) * (long)tstepA)
    const char* cA = (const char*)g.A + PG8_AOFF(cur); const char* cB = (const char*)g.Bt + (size_t)(cur.grp * g.nN + cur.pn) * tstepB;
    PG8_STAGE(PG8_SB(0, 0), cB, voffB); PG8_STAGE(PG8_SB(0, 1), cB + hstepB, voffB); PG8_STAGE(PG8_SA(0, 0), cA, voffA); PG8_STAGE(PG8_SA(0, 1), cA + hstepA, voffA);
    if (wr == 1) PG8_BAR;
    PG8_WAIT_V(2); PG8_BAR;
    PG8_STAGE(PG8_SB(1, 0), cB + kstep, voffB); PG8_STAGE(PG8_SA(1, 0), cA + kstep, voffA); PG8_STAGE(PG8_SB(1, 1), cB + hstepB + kstep, voffB);
    PG8_WAIT_V(6); PG8_BAR;
    for (;;) {
        const bool has_next = S.next(ui + 1, nxt);
        const char* nA = has_next ? (const char*)g.A + PG8_AOFF(nxt) : cA; const char* nB = has_next ? (const char*)g.Bt + (size_t)(nxt.grp * g.nN + nxt.pn) * tstepB : cB;
        for (int t = 0; t < nt; t += 2) {
            const bool last = (t == nt - 2);
            const char* a1 = cA + (size_t)(t + 1) * kstep;
            const char* a2 = last ? nA : cA + (size_t)(t + 2) * kstep; const char* b2 = last ? nB : cB + (size_t)(t + 2) * kstep;
            const char* a3 = a2 + kstep; const char* b3 = b2 + kstep;
            PG8_LDB(B0, 0, 0); PG8_LDB(B1, 0, 1); PG8_SCHED; PG8_LDA(At, 0, 0); PG8_STAGE(PG8_SA(1, 1), a1 + hstepA, voffA);
            PG8_WAIT_V(8); PG8_WAIT_L(0); PG8_BAR; PG8_MMA(0, 0, At, B0); PG8_MMA(0, 1, At, B1); PG8_BAR; PG8_SCHED;
            PG8_LDA(At, 0, 1); PG8_STAGE(PG8_SB(0, 0), b2, voffB); PG8_STAGE(PG8_SB(0, 1), b2 + hstepB, voffB); PG8_STAGE(PG8_SA(0, 0), a2, voffA);
            PG8_WAIT_V(8); PG8_WAIT_L(0); PG8_BAR; PG8_MMA(1, 0, At, B0); PG8_MMA(1, 1, At, B1); PG8_BAR; PG8_SCHED;
            PG8_LDB(B0, 1, 0); PG8_LDB(B1, 1, 1); PG8_SCHED; PG8_LDA(At, 1, 0); PG8_STAGE(PG8_SA(0, 1), a2 + hstepA, voffA);
            PG8_WAIT_V(8); PG8_WAIT_L(0); PG8_BAR; PG8_MMA(0, 0, At, B0); PG8_MMA(0, 1, At, B1); PG8_BAR; PG8_SCHED;
            PG8_LDA(At, 1, 1); PG8_STAGE(PG8_SB(1, 0), b3, voffB); PG8_STAGE(PG8_SB(1, 1), b3 + hstepB, voffB); PG8_STAGE(PG8_SA(1, 0), a3, voffA);
            PG8_WAIT_V(8); PG8_WAIT_L(0); PG8_BAR; PG8_MMA(1, 0, At, B0); PG8_MMA(1, 1, At, B1); PG8_BAR; PG8_SCHED;
        }
        if (wr == 0) PG8_BAR;
        if (!g.ovl) { if (E.mode == 7 && E.nf) E.resnorm(acc, cur, wr, wc, fr, fq, lds); else E(acc, cur, wr, wc, fr, fq); }
        if (!has_next) break;
#pragma unroll
        for (int a = 0; a < 2; ++a)
#pragma unroll
            for (int b = 0; b < 2; ++b)
#pragma unroll
                for (int m = 0; m < 4; ++m)
#pragma unroll
                    for (int n = 0; n < 2; ++n) acc[a][b][m][n] = (f32x4){0.f, 0.f, 0.f, 0.f};
        cur = nxt; cA = nA; cB = nB; ++ui;
        if (wr == 1) PG8_BAR;
    }
    PG8_WAIT_V(0);
    PG8_BAR;
    if (g.ovl) E.fused(acc, cur, wr, wc, fr, fq, lds);
#undef PG8_AOFF
#undef PG8_SA
#undef PG8_SB
#undef PG8_STAGE
#undef PG8_LDA
#undef PG8_LDB
#undef PG8_MMA
#undef PG8_WAIT_V
#undef PG8_WAIT_L
#undef PG8_BAR
#undef PG8_SCHED
}
}

namespace att {
constexpr int D = 128, NW = 8, QBLK = 32, KVBLK = 64, LD = DM;
constexpr float SCALE = 0.125f, THR = 8.f;
constexpr size_t SHM_V = KVBLK * D * 2, SHM_K = KVBLK * 64 * 2;
#define KSWZ(row, colB) ((row) * 128 + ((colB) ^ ((((row) >> 1) & 7) << 4)))
#define SBAR() __builtin_amdgcn_sched_barrier(0)
__device__ __forceinline__ int crow(int r, int hi) { return (r & 3) + 8 * (r >> 2) + 4 * hi; }
__device__ __forceinline__ void partialSM(f32x16& p0, f32x16& p1) {
#pragma unroll
    for (int r = 0; r < 16; ++r) p0[r] = __builtin_amdgcn_exp2f(p0[r]);
    (void)p1;
}
__device__ __forceinline__ void finishSM(f32x16& p0, f32x16& p1, float& l_reg, bf16x8& pa0, bf16x8& pa1, bf16x8& pa2, bf16x8& pa3) {
#pragma unroll
    for (int r = 0; r < 16; ++r) p1[r] = __builtin_amdgcn_exp2f(p1[r]);
    float ps = 0;
#pragma unroll
    for (int r = 0; r < 16; ++r) ps += p0[r];
#pragma unroll
    for (int r = 0; r < 16; ++r) ps += p1[r];
    l_reg += ps;
#define PK4(P, BASE, OUT) do { u32x4 w = {cvt_pk_bf16(P[BASE + 0], P[BASE + 1]), cvt_pk_bf16(P[BASE + 2], P[BASE + 3]), cvt_pk_bf16(P[BASE + 4], P[BASE + 5]), cvt_pk_bf16(P[BASE + 6], P[BASE + 7])}; \
    OUT = *reinterpret_cast<bf16x8*>(&w); } while (0)
    PK4(p0, 0, pa0); PK4(p0, 8, pa1); PK4(p1, 0, pa2); PK4(p1, 8, pa3);
#undef PK4
}
__device__ __forceinline__ void qkt(f32x16& p0, f32x16& p1, const char* Ks, const bf16x8* qr, const f32x16& negm, int r32, int hi) {
#pragma unroll
    for (int d0 = 0; d0 < 4; ++d0) { const int cb = (d0 * 16 + hi * 8) * 2;
        const bf16x8 b0 = *reinterpret_cast<const bf16x8*>(Ks + KSWZ(r32, cb));
        const bf16x8 b1 = *reinterpret_cast<const bf16x8*>(Ks + KSWZ(32 + r32, cb));
        if (d0 == 0) { p0 = __builtin_amdgcn_mfma_f32_32x32x16_bf16(b0, qr[0], negm, 0, 0, 0); p1 = __builtin_amdgcn_mfma_f32_32x32x16_bf16(b1, qr[0], negm, 0, 0, 0); }
        else { p0 = __builtin_amdgcn_mfma_f32_32x32x16_bf16(b0, qr[d0], p0, 0, 0, 0); p1 = __builtin_amdgcn_mfma_f32_32x32x16_bf16(b1, qr[d0], p1, 0, 0, 0); } }
}
__device__ __forceinline__ int v_st(int k, int c) { const int kk = k; return ((kk >> 3) * 4 + (c >> 5)) * 512 + ((kk & 7) * 32 + (c & 31)) * 2; }
__device__ __forceinline__ int v_rd_base(int lane) { return ((lane & 3) << 3) | (((lane >> 2) & 3) << 6) | (((lane >> 4) & 1) << 5) | (((lane >> 5) & 1) << 8); }
constexpr int v_rd_off(int d0, int ks, int half) { return d0 * 512 + ks * 4096 + half * 2048; }
template <int OFF> __device__ __forceinline__ s16x4 tr_read(int vb) {
    s16x4 r; asm volatile("ds_read_b64_tr_b16 %0, %1 offset:%2" : "=&v"(r) : "v"(vb), "i"(OFF) : "memory"); return r;
}
template <int D0> __device__ __forceinline__ void pv_one(f32x16& od, int vb, bf16x8 pa0, bf16x8 pa1, bf16x8 pa2, bf16x8 pa3) {
    const s16x4 l0 = tr_read<v_rd_off(D0, 0, 0)>(vb), h0 = tr_read<v_rd_off(D0, 0, 1)>(vb), l1 = tr_read<v_rd_off(D0, 1, 0)>(vb), h1 = tr_read<v_rd_off(D0, 1, 1)>(vb);
    const s16x4 l2 = tr_read<v_rd_off(D0, 2, 0)>(vb), h2 = tr_read<v_rd_off(D0, 2, 1)>(vb), l3 = tr_read<v_rd_off(D0, 3, 0)>(vb), h3 = tr_read<v_rd_off(D0, 3, 1)>(vb);
    asm volatile("s_waitcnt lgkmcnt(0)" ::: "memory"); SBAR();
#define PK(L, H) (bf16x8){L[0], L[1], L[2], L[3], H[0], H[1], H[2], H[3]}
    od = __builtin_amdgcn_mfma_f32_32x32x16_bf16(pa0, PK(l0, h0), od, 0, 0, 0);
    od = __builtin_amdgcn_mfma_f32_32x32x16_bf16(pa1, PK(l1, h1), od, 0, 0, 0);
    od = __builtin_amdgcn_mfma_f32_32x32x16_bf16(pa2, PK(l2, h2), od, 0, 0, 0);
    od = __builtin_amdgcn_mfma_f32_32x32x16_bf16(pa3, PK(l3, h3), od, 0, 0, 0);
#undef PK
}
__device__ __forceinline__ void pv_d0(f32x16* o, int vb, bf16x8 pa0, bf16x8 pa1, bf16x8 pa2, bf16x8 pa3) {
    pv_one<0>(o[0], vb, pa0, pa1, pa2, pa3); pv_one<1>(o[1], vb, pa0, pa1, pa2, pa3); pv_one<2>(o[2], vb, pa0, pa1, pa2, pa3); pv_one<3>(o[3], vb, pa0, pa1, pa2, pa3);
}

__device__ __forceinline__ void attn_pass(const bf16_t* __restrict__ Qb, const bf16_t* __restrict__ Kh, const bf16_t* __restrict__ Vh, float kmax2, f32x16 (&o)[4], float (&rli)[16], char* lds) {
    int tid = threadIdx.x; asm volatile("" : "+v"(tid));
    const int wid = tid >> 6, lane = tid & 63, r32 = lane & 31, hi = lane >> 5;
    char* V_lds = lds; char* K_lds = lds + 3 * SHM_V;
    float* ws = (float*)(lds + 3 * SHM_V + 3 * SHM_K) + wid * 64; float* li_l = ws;
    float l_reg = 0; bf16x8 qr[4];
#pragma unroll
    for (int d = 0; d < 4; ++d) o[d] = f32x16{};
    const GAS bf16_t* Qw = (const GAS bf16_t*)Qb + (long)(wid * QBLK + r32) * LD + hi * 8; const GAS bf16_t* Kg = (const GAS bf16_t*)Kh; const GAS bf16_t* Vg = (const GAS bf16_t*)Vh;
#pragma unroll
    for (int d0 = 0; d0 < 4; ++d0) qr[d0] = *(const GAS bf16x8*)(Qw + d0 * 16);
    float mnC;
    { float qs = 0.f;
#pragma unroll
      for (int d0 = 0; d0 < 4; ++d0)
#pragma unroll
          for (int e = 0; e < 8; ++e) { const float qv = __uint_as_float(((unsigned)(unsigned short)qr[d0][e]) << 16); qs += qv * qv; }
      auto rr = __builtin_amdgcn_permlane32_swap(__float_as_uint(qs), __float_as_uint(qs), false, false);
      qs = __uint_as_float(rr[0]) + __uint_as_float(rr[1]);
      mnC = -fminf(sqrtf(qs * kmax2), 60.0f * 1.4426950408889634f); }
    f32x16 negm;
#pragma unroll
    for (int r = 0; r < 16; ++r) negm[r] = mnC;
    asm volatile("" : "+v"(negm));
    const int sr = tid >> 4, sc = (tid & 15) * 8, vst0 = v_st(sr, sc), vst1 = v_st(32 + sr, sc);
    const int kr = tid >> 3, kc = (tid & 7) * 8, kst = KSWZ(kr, kc * 2);
    const int vb0 = (int)(uintptr_t)V_lds + v_rd_base(lane);
    struct { bf16x8 vs0, vs1, ks0; } sr_[2];
#define SLOAD(i, k0) do { sr_[i].vs0 = *(const GAS bf16x8*)(&Vg[(long)((k0) + sr) * LD + sc]); sr_[i].vs1 = *(const GAS bf16x8*)(&Vg[(long)((k0) + 32 + sr) * LD + sc]); \
    sr_[i].ks0 = *(const GAS bf16x8*)(&Kg[(long)((k0) + kr) * LD + kc]); } while (0)
#define SWRITE(b, i) do { *(bf16x8*)(V_lds + (b) * SHM_V + vst0) = sr_[i].vs0; *(bf16x8*)(V_lds + (b) * SHM_V + vst1) = sr_[i].vs1; *(bf16x8*)(K_lds + (b) * SHM_K + kst) = sr_[i].ks0; } while (0)
#define SWAIT() asm volatile("s_waitcnt vmcnt(3)" ::: "memory")
    f32x16 pA0, pA1, pB0, pB1; bf16x8 pa0, pa1, pa2, pa3; const int NT = SEQ / KVBLK;
    SLOAD(0, 0); asm volatile("s_waitcnt vmcnt(0)" ::: "memory"); SWRITE(0, 0);
    SLOAD(1, KVBLK); SLOAD(0, 2 * KVBLK);
    __syncthreads();
    qkt(pA0, pA1, K_lds, qr, negm, r32, hi); partialSM(pA0, pA1);
    int rc = 1, rp = 0;
#define RING_NEXT() do { rp = rc; rc = (rc == 2) ? 0 : rc + 1; } while (0)
    for (int j = 1; j + 1 < NT; j += 2) {
        SWAIT(); SWRITE(rc, 1); if (j + 2 < NT) SLOAD(1, (j + 2) * KVBLK);
        __syncthreads();
        SBAR(); qkt(pB0, pB1, K_lds + rc * SHM_K, qr, negm, r32, hi);
        finishSM(pA0, pA1, l_reg, pa0, pa1, pa2, pa3); SBAR();
        pv_d0(o, vb0 + rp * (int)SHM_V, pa0, pa1, pa2, pa3); partialSM(pB0, pB1);
        RING_NEXT();
        SWAIT(); SWRITE(rc, 0); if (j + 3 < NT) SLOAD(0, (j + 3) * KVBLK);
        __syncthreads();
        SBAR(); qkt(pA0, pA1, K_lds + rc * SHM_K, qr, negm, r32, hi);
        finishSM(pB0, pB1, l_reg, pa0, pa1, pa2, pa3); SBAR();
        pv_d0(o, vb0 + rp * (int)SHM_V, pa0, pa1, pa2, pa3); partialSM(pA0, pA1);
        RING_NEXT();
    }
    asm volatile("s_waitcnt vmcnt(0)" ::: "memory"); SWRITE(rc, 1);
    __syncthreads();
    SBAR(); qkt(pB0, pB1, K_lds + rc * SHM_K, qr, negm, r32, hi);
    finishSM(pA0, pA1, l_reg, pa0, pa1, pa2, pa3); SBAR();
    pv_d0(o, vb0 + rp * (int)SHM_V, pa0, pa1, pa2, pa3); partialSM(pB0, pB1);
    finishSM(pB0, pB1, l_reg, pa0, pa1, pa2, pa3); SBAR();
    pv_d0(o, vb0 + rc * (int)SHM_V, pa0, pa1, pa2, pa3);
#undef RING_NEXT
    { auto rr = __builtin_amdgcn_permlane32_swap(__float_as_uint(l_reg), __float_as_uint(l_reg), false, false); l_reg = __uint_as_float(rr[0]) + __uint_as_float(rr[1]); }
    if (hi == 0) li_l[r32] = l_reg; asm volatile("s_waitcnt lgkmcnt(0)" ::: "memory");
#pragma unroll
    for (int r = 0; r < 16; ++r) rli[r] = __builtin_amdgcn_rcpf(li_l[crow(r, hi)]);
    __syncthreads();
#undef SLOAD
#undef SWRITE
#undef SWAIT
}

__device__ __forceinline__ void attn_unit(int b, int h, int qb, const bf16_t* Q, const bf16_t* K, const bf16_t* V, bf16_t* O, float* scr, const unsigned* kmax2, float lam, float onem, const float* subw, char* lds) {
    int tid = threadIdx.x; asm volatile("" : "+v"(tid));
    const int wid = tid >> 6, lane = tid & 63, r32 = lane & 31, hi = lane >> 5;
    asm volatile("" : "+s"(Q), "+s"(K), "+s"(V), "+s"(O), "+s"(scr), "+s"(kmax2), "+s"(subw));
    const size_t rowbase = (size_t)b * SEQ;
    f32x16 o[4]; float rli[16];
#pragma unroll 1
    for (int pass = 0; pass < 2; ++pass) {
        const int sub = 2 * h + pass;
        attn_pass(Q + (rowbase + (size_t)qb * 256) * LD + sub * 64, K + rowbase * LD + sub * 64, V + rowbase * LD + h * 128, __uint_as_float(kmax2[b * 16 + sub]), o, rli, lds);
        int t2 = tid; asm volatile("" : "+v"(t2));
        const int lane2 = t2 & 63, r32b = lane2 & 31, hib = lane2 >> 5, wid2 = t2 >> 6;
        float* sp = scr + (size_t)t2 * 64;
        if (pass == 0) {
#pragma unroll
            for (int d0 = 0; d0 < 4; ++d0)
#pragma unroll
                for (int r4 = 0; r4 < 4; ++r4) *(f32x4*)(sp + d0 * 16 + r4 * 4) = (f32x4){o[d0][4 * r4] * rli[4 * r4], o[d0][4 * r4 + 1] * rli[4 * r4 + 1], o[d0][4 * r4 + 2] * rli[4 * r4 + 2], o[d0][4 * r4 + 3] * rli[4 * r4 + 3]};
        } else {
            float ss[16];
#pragma unroll
            for (int r = 0; r < 16; ++r) ss[r] = 0.f;
#pragma unroll
            for (int d0 = 0; d0 < 4; ++d0)
#pragma unroll
                for (int r4 = 0; r4 < 4; ++r4) { const f32x4 o1 = *(const f32x4*)(sp + d0 * 16 + r4 * 4);
#pragma unroll
                    for (int q = 0; q < 4; ++q) { const int r = 4 * r4 + q; const float v = o1[q] - lam * (o[d0][r] * rli[r]); o[d0][r] = v; ss[r] += v * v; } }
#pragma unroll
            for (int r = 0; r < 16; ++r) {
#pragma unroll
                for (int x = 1; x < 32; x <<= 1) ss[r] += shfl_xor_l(ss[r], x, lane2);
                ss[r] = rsqrtf(ss[r] * (1.0f / 128.0f) + 1e-5f) * onem; }
            bf16_t* Ow = O + (rowbase + (size_t)qb * 256 + wid2 * QBLK + 4 * hib) * LD + h * 128 + r32b;
#pragma unroll
            for (int d0 = 0; d0 < 4; ++d0) { const float sw = subw[d0 * 32 + r32b];
#pragma unroll
                for (int r = 0; r < 16; ++r) { const unsigned w = cvt_pk_bf16(o[d0][r] * ss[r] * sw, 0.f); Ow[(size_t)((r & 3) + 8 * (r >> 2)) * LD + d0 * 32] = (bf16_t)(w & 0xffffu); } }
        }
    }
}
#undef SBAR
}

__device__ __forceinline__ void transpose_item(const float* W, const float* W2, int K, int ldw, int coff, int sel, int ndst, bf16_t* WT, LAS float* scr, int item, int lane) {
    const int nblk = ndst / 32, kb = item / nblk, nb = item % nblk, k0 = 64 * kb, n0 = 32 * nb;
    const int nd = n0 + (lane & 31); int sc = nd + coff; const float* Wp = W;
    if (sel == 1 && nd < 2048) { const int j = nd & 63; sc = (nd & ~63) + (j & 1) * 32 + (j >> 1); }
    if (sel == 2) { sc = (nd >> 3) * 4 + (nd & 3); if ((nd >> 2) & 1) Wp = W2; }
    if (sel == 3) { sc = (nd >> 3) * 4 + (nd & 3) + ((nd >> 2) & 1) * DFF; }
#pragma unroll 8
    for (int i = 0; i < 32; ++i) { const int kk = 2 * i + (lane >> 5); scr[kk * 33 + (lane & 31)] = Wp[(size_t)(k0 + kk) * ldw + sc]; }
    asm volatile("s_waitcnt lgkmcnt(0)" ::: "memory");
    const int c = lane & 7;
#pragma unroll
    for (int j = 0; j < 4; ++j) { const int n = (lane >> 3) + 8 * j; const LAS float* s = scr + (8 * c) * 33 + n;
        u32x4 o; o.x = cvt_pk_bf16(s[0 * 33], s[1 * 33]); o.y = cvt_pk_bf16(s[2 * 33], s[3 * 33]); o.z = cvt_pk_bf16(s[4 * 33], s[5 * 33]); o.w = cvt_pk_bf16(s[6 * 33], s[7 * 33]);
        *(u32x4*)(WT + (size_t)(n0 + n) * K + k0 + 8 * c) = o; }
    asm volatile("s_waitcnt lgkmcnt(0)" ::: "memory");
}

__device__ __forceinline__ void norm_rows(const float* xin, const float* nw, const float* mod_l, int mod_off, bf16_t* XN, float* fout, int gw, int NGW, int lane) {
    for (int m0 = gw; m0 < T; m0 += 2 * NGW) {
        const int m1 = m0 + NGW;
        const bool has1 = m1 < T; const int m1c = has1 ? m1 : m0;
        const f32x4* x0 = (const f32x4*)(xin + (size_t)m0 * DM) + lane; const f32x4* x1 = (const f32x4*)(xin + (size_t)m1c * DM) + lane;
        f32x4 v[2][4]; float s0 = 0.f, s1 = 0.f;
#pragma unroll
        for (int j = 0; j < 4; ++j) { v[0][j] = x0[64 * j]; v[1][j] = x1[64 * j]; }
#pragma unroll
        for (int j = 0; j < 4; ++j) { s0 += (v[0][j][0] * v[0][j][0] + v[0][j][1] * v[0][j][1]) + (v[0][j][2] * v[0][j][2] + v[0][j][3] * v[0][j][3]);
                                      s1 += (v[1][j][0] * v[1][j][0] + v[1][j][1] * v[1][j][1]) + (v[1][j][2] * v[1][j][2] + v[1][j][3] * v[1][j][3]); }
        const float r0 = rsqrtf(wave_sum(s0, lane) * (1.0f / DM) + 1e-6f), r1 = rsqrtf(wave_sum(s1, lane) * (1.0f / DM) + 1e-6f);
#pragma unroll
        for (int k = 0; k < 2; ++k) {
            if (k == 1 && !has1) break;
            const int m = k == 0 ? m0 : m1; const float r = k == 0 ? r0 : r1;
#pragma unroll
            for (int j = 0; j < 4; ++j) { const int col = lane * 4 + 256 * j; const f32x4 w4 = *(const f32x4*)(nw + col);
                if (mod_l) { const float* md = mod_l + (size_t)(m >> 12) * 6144 + mod_off; const f32x4 sh = *(const f32x4*)(md + col), sc = *(const f32x4*)(md + 1024 + col);
                    const f32x4 hv = v[k][j] * r * w4 * (sc + 1.0f) + sh; u32x2 w; w.x = cvt_pk_bf16(hv[0], hv[1]); w.y = cvt_pk_bf16(hv[2], hv[3]); *(u32x2*)(XN + (size_t)m * DM + col) = w; }
                else *(f32x4*)(fout + (size_t)m * DM + col) = v[k][j] * r * w4; }
        }
    }
}

__device__ __forceinline__ void conv_fix(int pm, const bf16_t* RAWb, bf16_t* ACT, const float* cw, const float* cb, int tid) {
    const int bb = pm >> 4, ti = pm & 15;
    for (int t = tid; t < 704; t += NTHR) {
        const int rowsel = t / 352, c = t % 352, j0 = c * 8; const int ioff = (j0 >> 7) * 256 + ((j0 & 127) >> 3) * 16;
        if ((rowsel == 0 && ti == 0) || (rowsel == 1 && ti == 15)) continue;
        const bf16_t* pp = rowsel == 0 ? RAWb + ((size_t)(pm - 1) * 4 + 3) * NUP : RAWb + ((size_t)pm * 4 + 2) * NUP;
        const bf16_t* pc = rowsel == 0 ? RAWb + ((size_t)pm * 4 + 0) * NUP : RAWb + ((size_t)pm * 4 + 3) * NUP;
        const bf16_t* pn = rowsel == 0 ? RAWb + ((size_t)pm * 4 + 1) * NUP : RAWb + ((size_t)(pm + 1) * 4 + 0) * NUP;
        const int s = 256 * ti + (rowsel == 0 ? 0 : 255);
        float o[8];
#pragma unroll
        for (int h = 0; h < 2; ++h) {
            const u32x4 p = *(const u32x4*)(pp + ioff + 8 * h), cc = *(const u32x4*)(pc + ioff + 8 * h), n = *(const u32x4*)(pn + ioff + 8 * h);
#pragma unroll
            for (int q2 = 0; q2 < 2; ++q2) { const int e = 4 * h + 2 * q2; const int jv = j0 + e, jg = DFF + j0 + e;
                const float v0 = cw[jv] * bf_lo(p[q2]) + cw[NUP + jv] * bf_lo(cc[q2]) + cw[2 * NUP + jv] * bf_lo(n[q2]) + cb[jv];
                const float v1 = cw[jv + 1] * bf_hi(p[q2]) + cw[NUP + jv + 1] * bf_hi(cc[q2]) + cw[2 * NUP + jv + 1] * bf_hi(n[q2]) + cb[jv + 1];
                const float g0 = cw[jg] * bf_lo(p[2 + q2]) + cw[NUP + jg] * bf_lo(cc[2 + q2]) + cw[2 * NUP + jg] * bf_lo(n[2 + q2]) + cb[jg];
                const float g1 = cw[jg + 1] * bf_hi(p[2 + q2]) + cw[NUP + jg + 1] * bf_hi(cc[2 + q2]) + cw[2 * NUP + jg + 1] * bf_hi(n[2 + q2]) + cb[jg + 1];
                o[e] = g0 * sigmoidf_(g0) * v0; o[e + 1] = g1 * sigmoidf_(g1) * v1; }
        }
        u32x4 ov; ov.x = cvt_pk_bf16_b(o[0], o[1]); ov.y = cvt_pk_bf16_b(o[2], o[3]); ov.z = cvt_pk_bf16_b(o[4], o[5]); ov.w = cvt_pk_bf16_b(o[6], o[7]);
        *(u32x4*)(ACT + ((size_t)bb * SEQ + s) * DFF + j0) = ov;
    }
}

#define XB_TMO      128
#define XB_XCNT(j)  (256  + 64 * (j))
#define XB_XSUB(j)  (1280 + 64 * (j))
#define XB_XGEN(j)  (2304 + 64 * (j))
#define XB_TOP      3328
#define XB_TOPGEN   3392
#define XCD_BAR_WORDS 3456
#define XB_SPIN_CAP (1u << 22)
__device__ __forceinline__ unsigned xb_ld(unsigned* p)              { return __hip_atomic_load(p, __ATOMIC_RELAXED, __HIP_MEMORY_SCOPE_AGENT); }
__device__ __forceinline__ unsigned xb_add(unsigned* p, unsigned v) { return __hip_atomic_fetch_add(p, v, __ATOMIC_RELAXED, __HIP_MEMORY_SCOPE_AGENT); }
__device__ __forceinline__ unsigned xb_xcc_id() { return (unsigned)__builtin_amdgcn_s_getreg((3 << 11) | 20) & 0xFu; }
#define XB_SPIN(cond, bar) do { unsigned _sp = 0; while (cond) { __builtin_amdgcn_s_sleep(1); \
    if ((++_sp & 255u) == 0u) { if (xb_ld(&(bar)[XB_TMO])) break; if (_sp > XB_SPIN_CAP) { atomicAdd(&(bar)[XB_TMO], 1u); break; } } } } while (0)
struct XcdBarrier { unsigned* bar; unsigned x; volatile LAS unsigned* st; };
__device__ __forceinline__ void xcd_barrier_complete(unsigned* bar, unsigned x, unsigned& nloc, unsigned& nx) {
    const unsigned G = gridDim.x * gridDim.y * gridDim.z;
    unsigned sum, cnt, mine, sp = 0u;
    for (;;) {
        sum = 0u; cnt = 0u; mine = 0u;
#pragma unroll
        for (unsigned j = 0; j < 16; ++j) { const unsigned c = xb_ld(&bar[XB_XCNT(j)]); sum += c; cnt += (c > 0u) ? 1u : 0u; mine = (j == x) ? c : mine; }
        if (sum == G) break;
        __builtin_amdgcn_s_sleep(1);
        if ((++sp & 255u) == 0u) { if (xb_ld(&bar[XB_TMO])) break; if (sp > XB_SPIN_CAP) { atomicAdd(&bar[XB_TMO], 1u); break; } }
    }
    nloc = mine > 0u ? mine : 1u; nx = cnt > 0u ? cnt : 1u;
}
__device__ __forceinline__ void xcd_barrier(const XcdBarrier& b) {
    asm volatile("s_waitcnt vmcnt(0)" ::: "memory");
    __syncthreads();
    if (threadIdx.x == 0) {
        unsigned* bar = b.bar;
        __builtin_amdgcn_s_waitcnt(0);
        unsigned nloc = b.st[0], nx = b.st[1];
        if (nloc == 0u) { xcd_barrier_complete(bar, b.x, nloc, nx); b.st[0] = nloc; b.st[1] = nx; }
        const unsigned old = xb_add(&bar[XB_XSUB(b.x)], 1u);
        const unsigned gen = old / nloc;
        if (old + 1u == (gen + 1u) * nloc) {
            __builtin_amdgcn_fence(__ATOMIC_RELEASE, "agent");
            asm volatile("s_waitcnt vmcnt(0)" ::: "memory");
            const unsigned og = xb_add(&bar[XB_TOP], 1u);
            const unsigned tg = og / nx;
            if (og + 1u == (tg + 1u) * nx) xb_add(&bar[XB_TOPGEN], 1u);
            else XB_SPIN(xb_ld(&bar[XB_TOPGEN]) == tg, bar);
            __builtin_amdgcn_fence(__ATOMIC_ACQUIRE, "agent");
            xb_add(&bar[XB_XGEN(b.x)], 1u);
            asm volatile("s_waitcnt vmcnt(0)" ::: "memory");
        } else {
            XB_SPIN(xb_ld(&bar[XB_XGEN(b.x)]) == gen, bar);
            __builtin_amdgcn_fence(__ATOMIC_ACQUIRE, "agent");
            asm volatile("s_waitcnt vmcnt(0)" ::: "memory");
        }
    }
    __syncthreads();
}

__global__ void __launch_bounds__(NTHR, 2) mega(Params P) {
    extern __shared__ __attribute__((aligned(16))) unsigned char lds_raw[];
    cg::grid_group grid = cg::this_grid();
    LAS unsigned char* lds = (LAS unsigned char*)lds_raw;
    const int G0 = gridDim.x, bx0 = blockIdx.x;
    float* xo = P.out;
    if (threadIdx.x < 2) ((volatile LAS unsigned*)(lds + LDS_BYTES - 64))[threadIdx.x] = 0u;
    if (P.out == nullptr) grid.sync();
    __syncthreads();
    XcdBarrier xbar; xbar.bar = (unsigned*)P.ws; xbar.x = xb_xcc_id(); xbar.st = (volatile LAS unsigned*)(lds + LDS_BYTES - 64);
    if (threadIdx.x == 0) (void)xb_add(&xbar.bar[XB_XCNT(xbar.x)], 1u);
#define GRID_BAR() xcd_barrier(xbar)
#define PH_INIT unsigned char* ws = P.ws; int tid = threadIdx.x; int L = l; int G = G0, bx = bx0; asm volatile("" : "+s"(ws), "+s"(L), "+s"(G), "+s"(bx)); asm volatile("" : "+v"(tid)); \
    const int vcu = (G % 8 == 0) ? (bx % 8) * (G / 8) + bx / 8 : bx; const int NGW = G * NWAVES; const long NGT = (long)G * NTHR; (void)NGW; (void)NGT; \
    const int lane = tid & 63, wave = __builtin_amdgcn_readfirstlane(tid >> 6); const int gw = vcu * NWAVES + wave; const long gtid = (long)vcu * NTHR + tid; (void)lane; (void)gw; (void)gtid; \
    float* MOD = (float*)(ws + WS_MOD); float* ROPE = (float*)(ws + WS_ROPE); f32x2* PW = (f32x2*)(ws + WS_PW); f32x2* BB = (f32x2*)(ws + WS_BB); float* KM = (float*)(ws + WS_KM); \
    bf16_t* WQKVU = (bf16_t*)(ws + WS_WQKVU); bf16_t* WG = (bf16_t*)(ws + WS_WG); bf16_t* WAO = (bf16_t*)(ws + WS_WAO); bf16_t* WGLU = (bf16_t*)(ws + WS_WGLU); \
    bf16_t* WOUT = (bf16_t*)(ws + WS_WOUT); bf16_t* WUP = (bf16_t*)(ws + WS_WUP); bf16_t* WDOWN = (bf16_t*)(ws + WS_WDOWN); \
    bf16_t* TMAT = (bf16_t*)(ws + WS_TMAT); bf16_t* EMAT = (bf16_t*)(ws + WS_EMAT); bf16_t* XN = (bf16_t*)(ws + WS_XN); \
    bf16_t* QB = (bf16_t*)(ws + WS_Q); bf16_t* KB = (bf16_t*)(ws + WS_K); bf16_t* VB = (bf16_t*)(ws + WS_V); bf16_t* UEXT = (bf16_t*)(ws + WS_UEXT); \
    float* XLOC = (float*)(ws + WS_XLOC); bf16_t* YB = (bf16_t*)(ws + WS_XLOC); float* SCR = (float*)(ws + WS_SCR); \
    bf16_t* TSB = (bf16_t*)(ws + WS_UP); bf16_t* ACT = (bf16_t*)(ws + WS_ACT); \
    (void)MOD; (void)ROPE; (void)PW; (void)BB; (void)KM; (void)WQKVU; (void)WG; (void)WAO; (void)WGLU; (void)WOUT; (void)WUP; (void)WDOWN; (void)TMAT; (void)EMAT; (void)XN; (void)QB; (void)KB; (void)VB; (void)UEXT; (void)XLOC; (void)YB; (void)SCR; (void)TSB; (void)ACT
#define MAKE_E pg8::Epi E{}; E.layer = L; E.Q = QB; E.Kb = KB; E.Vb = VB; E.Uext = UEXT; E.Y = YB; E.TS = TSB; E.RAWb = TSB; E.ACT = ACT; E.OS = (bf16_t*)(ws + WS_OS); E.xloc = XLOC; E.rope = ROPE; E.xout = xo

#define RUN_GEMM(A_, Bt_, lda_, ldb_, K_, nM_, nN_, ngrp_, epi_) do { pg8::Gemm g_{A_, Bt_, lda_, ldb_, K_, nM_, nN_, (ngrp_) & 0xff, (ngrp_) >> 8}; pg8::Order S_; S_.init(g_, G, bx); pg8::gemm_phase(lds, g_, S_, epi_); } while (0)

#pragma unroll 1
    for (int l = 0; l < 2; ++l) {
        const float lambda_init = (l == 0) ? 0.2f : 0.35550906759f;
        {
            PH_INIT;
            LAS float* scr = (LAS float*)(lds + wave * 16384);
            const int I1 = 16 * 112, I2 = 16 * 64, I3 = 16 * 32, I4 = 8 * 64, I5 = 16 * 32, I6 = 16 * 176, I7 = 44 * 32, NI = I1 + I2 + I3 + I4 + I5 + I6 + I7;
            const float* win = P.in[I_WIN] + (size_t)L * DM * 5632;
            for (int it = gw; it < NI; it += NGW) {
                int r = it;
                if (r < I1) { transpose_item(win, nullptr, 1024, 5632, 0, 1, 3584, WQKVU, scr, r, lane); continue; } r -= I1;
                if (r < I2) { transpose_item(win, nullptr, 1024, 5632, 3584, 0, 2048, WG, scr, r, lane); continue; } r -= I2;
                if (r < I3) { transpose_item(P.in[I_WAO] + (size_t)L * DM * DM, nullptr, 1024, 1024, 0, 0, 1024, WAO, scr, r, lane); continue; } r -= I3;
                if (r < I4) { transpose_item(P.in[I_WGA] + (size_t)L * 512 * DM, P.in[I_WGB] + (size_t)L * 512 * DM, 512, 1024, 0, 2, 2048, WGLU, scr, r, lane); continue; } r -= I4;
                if (r < I5) { transpose_item(P.in[I_WOUT] + (size_t)L * DM * DM, nullptr, 1024, 1024, 0, 0, 1024, WOUT, scr, r, lane); continue; } r -= I5;
                if (r < I6) { transpose_item(P.in[I_WUP] + (size_t)L * DM * NUP, nullptr, 1024, NUP, 0, 3, NUP, WUP, scr, r, lane); continue; } r -= I6;
                transpose_item(P.in[I_WDOWN] + (size_t)L * DFF * DM, nullptr, DFF, 1024, 0, 0, 1024, WDOWN, scr, r, lane);
            }
            for (long i = gtid; i < 2 * 32 * 33 * 64; i += NGT) {
                const int p = (int)(i & 63); const int tau = (int)((i >> 6) % 33); const int dg = (int)(i / (64 * 33));
                const size_t li = ((size_t)L * 64 + dg) * 64 + p; const float lr = P.in[I_SLRE][li], lim = P.in[I_SLIM][li]; const float dt = expf(P.in[I_SLDT][L * 64 + dg]);
                const float mag = expf(lr * dt * (float)tau), ang = (lim * dt) * (float)tau;
                PW[i] = (f32x2){mag * cosf(ang), mag * sinf(ang)};
            }
            for (long i = gtid; i < 2 * 32 * 64 * 16; i += NGT) {
                const int p = (int)((i >> 4) & 63); const int dg = (int)(i >> 10);
                const size_t li = ((size_t)L * 64 + dg) * 64 + p; const float lr = P.in[I_SLRE][li], lim = P.in[I_SLIM][li]; const float dt = expf(P.in[I_SLDT][L * 64 + dg]);
                const float mag = expf(lr * dt), ang = lim * dt; const float ar = mag * cosf(ang), ai = mag * sinf(ang);
                const float den = lr * lr + lim * lim, nr = ar - 1.0f, ni_ = ai;
                const float fre = (nr * lr + ni_ * lim) / den, fim = (ni_ * lr - nr * lim) / den;
                const size_t bi = (size_t)L * 2 * 32 * 64 * 16 + i; const float br = P.in[I_SBRE][bi], bim = P.in[I_SBIM][bi];
                BB[i] = (f32x2){fre * br - fim * bim, fre * bim + fim * br};
            }
            if (L == 0) {
                for (long i = gtid; i < SEQ * 32; i += NGT) { const int s = (int)(i >> 5), f = (int)(i & 31);
                    const float inv = powf(10000.0f, -(float)f / 32.0f); const float ang = (float)s * inv; ROPE[2 * i] = cosf(ang); ROPE[2 * i + 1] = sinf(ang); }
                LAS float* cact = (LAS float*)lds; LAS float* red = (LAS float*)(lds + 32768);
                __syncthreads();
                for (int it = bx; it < 192; it += G) {
                    const int ll = it / 96, j0 = (it % 96) * 64;
                    for (int i = tid; i < NB * DM; i += NTHR) { const float cv = P.in[I_C][i]; cact[i] = cv / (1.0f + expf(-cv)); }
                    __syncthreads();
                    float a[NB];
#pragma unroll
                    for (int b = 0; b < NB; ++b) a[b] = 0.f;
                    const float* aw = P.in[I_ADAW] + (size_t)ll * DM * 6144 + j0 + lane;
                    for (int k = wave * 128; k < wave * 128 + 128; ++k) { const float wv = aw[(size_t)k * 6144];
#pragma unroll
                        for (int b = 0; b < NB; ++b) a[b] += cact[b * DM + k] * wv; }
#pragma unroll
                    for (int b = 0; b < NB; ++b) red[(wave * NB + b) * 64 + lane] = a[b];
                    __syncthreads();
                    { const int b = tid >> 6; float s = P.in[I_ADAB][ll * 6144 + j0 + lane];
#pragma unroll
                      for (int w = 0; w < NWAVES; ++w) s += red[(w * NB + b) * 64 + lane];
                      MOD[((size_t)ll * NB + b) * 6144 + j0 + lane] = s; }
                    __syncthreads();
                }
            }
        }
        GRID_BAR();
        {
            PH_INIT;
            const float* xin = (L == 0) ? P.in[I_X] : xo; const float* nw = P.in[I_N1W] + L * DM;
            if (L == 0 || G != 256) norm_rows(xin, nw, MOD + (size_t)L * NB * 6144, 0, XN, nullptr, gw, NGW, lane);
            if (gtid < 128) ((unsigned*)(ws + WS_KMAX))[gtid] = 0u;
            for (long i = gtid; i < 2 * 32 * 32 * 256; i += NGT) {
                const int ni = (int)(i & 15), no = (int)((i >> 4) & 15), tau = (int)((i >> 8) & 31), dg = (int)(i >> 13);
                const float* cre = P.in[I_SCRE] + (((size_t)L * 64 + dg) * 16 + no) * 64; const float* cim = P.in[I_SCIM] + (((size_t)L * 64 + dg) * 16 + no) * 64;
                const f32x2* pw = PW + ((size_t)dg * 33 + tau) * 64; const f32x2* bb = BB + (size_t)dg * 1024 + ni; float acc = 0.f;
                for (int p = 0; p < 64; ++p) { const f32x2 w = pw[p], bv = bb[p * 16]; const float cr = cre[p], ci = cim[p]; const float zr = cr * w.x - ci * w.y, zi = cr * w.y + ci * w.x; acc += zr * bv.x - zi * bv.y; }
                KM[i] = acc;
            }
            for (long i = gtid; i < 32 * 256 * 64; i += NGT) {
                const int k8 = (int)(i & 63), n = (int)((i >> 6) & 255), g = (int)(i >> 14); const int dir = n >> 7, ri = (n >> 6) & 1, p = n & 63; const int s = k8 >> 1, ni0 = (k8 & 1) * 8;
                const int e = dir == 0 ? (CH - 1 - s) : s; const f32x2 w = PW[((size_t)(dir * 32 + g) * 33 + e) * 64 + p]; const f32x2* bb = BB + ((size_t)(dir * 32 + g) * 64 + p) * 16 + ni0;
                float o[8];
#pragma unroll
                for (int q = 0; q < 8; ++q) { const f32x2 bv = bb[q]; o[q] = ri == 0 ? (w.x * bv.x - w.y * bv.y) : (w.x * bv.y + w.y * bv.x); }
                u32x4 ov; ov.x = cvt_pk_bf16(o[0], o[1]); ov.y = cvt_pk_bf16(o[2], o[3]); ov.z = cvt_pk_bf16(o[4], o[5]); ov.w = cvt_pk_bf16(o[6], o[7]);
                *(u32x4*)(EMAT + ((size_t)g * 256 + n) * 512 + k8 * 8) = ov;
            }
            for (long i = gtid; i < 32 * 512 * 32; i += NGT) {
                const int c8 = (int)(i & 31), n = (int)((i >> 5) & 511), g = (int)(i >> 14); const int t = n >> 4, no = n & 15; const int dir = c8 >> 4, ri = (c8 >> 3) & 1, p0 = (c8 & 7) * 8;
                const int e = dir == 0 ? (t + 1) : (CH - t); const f32x2* pw = PW + ((size_t)(dir * 32 + g) * 33 + e) * 64 + p0;
                const float* cre = P.in[I_SCRE] + ((((size_t)L * 2 + dir) * 32 + g) * 16 + no) * 64 + p0; const float* cim = P.in[I_SCIM] + ((((size_t)L * 2 + dir) * 32 + g) * 16 + no) * 64 + p0;
                float o[8];
#pragma unroll
                for (int q = 0; q < 8; ++q) { const f32x2 w = pw[q]; const float cr = cre[q], ci = cim[q]; o[q] = ri == 0 ? (cr * w.x - ci * w.y) : -(cr * w.y + ci * w.x); }
                u32x4 ov; ov.x = cvt_pk_bf16(o[0], o[1]); ov.y = cvt_pk_bf16(o[2], o[3]); ov.z = cvt_pk_bf16(o[4], o[5]); ov.w = cvt_pk_bf16(o[6], o[7]);
                *(u32x4*)(TMAT + ((size_t)g * 512 + n) * KX + 512 + c8 * 8) = ov;
            }
        }
        GRID_BAR();
        { PH_INIT; MAKE_E; E.mode = 1; RUN_GEMM(XN, WQKVU, 1024, 1024, 1024, 128, 14, 1, E); }
        GRID_BAR();
        { PH_INIT; MAKE_E; E.mode = 2; RUN_GEMM(UEXT, EMAT, KX, 512, 512, 4, 1, 32, E); }
        {
            PH_INIT;
            __builtin_amdgcn_fence(__ATOMIC_ACQUIRE, "agent");
            if (bx < 128 && tid < 256) {
                const int g = bx >> 2, pm = bx & 3; const int p = tid & 63, dir = (tid >> 6) & 1, b = 2 * pm + (tid >> 7);
                const f32x2 al = PW[((size_t)(dir * 32 + g) * 33 + CH) * 64 + p];
                float xr = 0.f, xi = 0.f;
                const float* xl = XLOC + ((size_t)g * (NB * NCH) + b * NCH) * 256 + dir * 128 + p;
                bf16_t* ue = UEXT + ((size_t)g * (NB * NCH) + b * NCH) * KX + 512 + dir * 128 + p;
#pragma unroll 1
                for (int cb0 = 0; cb0 < NCH; cb0 += 16) {
                    float lr[16], li[16];
#pragma unroll
                    for (int q = 0; q < 16; ++q) { const int c = dir == 0 ? cb0 + q : NCH - 1 - cb0 - q; lr[q] = xl[(size_t)c * 256]; li[q] = xl[(size_t)c * 256 + 64]; }
#pragma unroll
                    for (int q = 0; q < 16; ++q) { const int c = dir == 0 ? cb0 + q : NCH - 1 - cb0 - q;
                        ue[(size_t)c * KX] = (bf16_t)(cvt_pk_bf16(xr, 0.f) & 0xffffu); ue[(size_t)c * KX + 64] = (bf16_t)(cvt_pk_bf16(xi, 0.f) & 0xffffu);
                        const float nr = al.x * xr - al.y * xi + lr[q], nim = al.x * xi + al.y * xr + li[q]; xr = nr; xi = nim; }
                }
            }
        }
        {
            PH_INIT;
            const float* dsk = P.in[I_SD] + L * 512;
            { LAS float* red = (LAS float*)lds; unsigned* kmx = (unsigned*)(ws + WS_KMAX);
              for (int blk = vcu; blk < T / 128; blk += G) {
                  float mx = 0.f;
#pragma unroll 4
                  for (int k = 0; k < 16; ++k) { const int m = blk * 128 + wave * 16 + k; const u32x4* kp = (const u32x4*)(KB + (size_t)m * DM + lane * 16); const u32x4 a = kp[0], b2 = kp[1]; float ss = 0.f;
#pragma unroll
                      for (int q = 0; q < 4; ++q) { ss += bf_lo(a[q]) * bf_lo(a[q]) + bf_hi(a[q]) * bf_hi(a[q]) + bf_lo(b2[q]) * bf_lo(b2[q]) + bf_hi(b2[q]) * bf_hi(b2[q]); }
                      ss += shfl_xor_l(ss, 1, lane); ss += shfl_xor_l(ss, 2, lane); mx = fmaxf(mx, ss); }
                  __syncthreads();
                  if ((lane & 3) == 0) red[wave * 16 + (lane >> 2)] = mx;
                  __syncthreads();
                  if (tid < 16) { float m2 = red[tid];
#pragma unroll
                      for (int w = 1; w < NWAVES; ++w) m2 = fmaxf(m2, red[w * 16 + tid]);
                      __hip_atomic_fetch_max(kmx + (blk >> 5) * 16 + tid, __float_as_uint(m2), __ATOMIC_RELAXED, __HIP_MEMORY_SCOPE_AGENT); }
              }
              __syncthreads(); }
            for (long i = gtid; i < 32 * 512 * 64; i += NGT) {
                const int k8 = (int)(i & 63), n = (int)((i >> 6) & 511), g = (int)(i >> 15); const int t = n >> 4, no = n & 15, s = k8 >> 1, ni0 = (k8 & 1) * 8;
                float o[8];
                if (t != s) { const int dir = t > s ? 0 : 1, tau = t > s ? t - s : s - t; const float* km = KM + ((((size_t)(dir * 32 + g)) * 32 + tau) * 16 + no) * 16 + ni0;
#pragma unroll
                    for (int q = 0; q < 8; ++q) o[q] = km[q];
                } else { const float* k0 = KM + (((size_t)(g) * 32) * 16 + no) * 16 + ni0; const float* k1 = KM + (((size_t)(32 + g) * 32) * 16 + no) * 16 + ni0;
#pragma unroll
                    for (int q = 0; q < 8; ++q) o[q] = k0[q] + k1[q] + ((ni0 + q) == no ? dsk[g * 16 + no] : 0.f);
                }
                u32x4 ov; ov.x = cvt_pk_bf16(o[0], o[1]); ov.y = cvt_pk_bf16(o[2], o[3]); ov.z = cvt_pk_bf16(o[4], o[5]); ov.w = cvt_pk_bf16(o[6], o[7]);
                *(u32x4*)(TMAT + ((size_t)g * 512 + n) * KX + k8 * 8) = ov;
            }
        }
        GRID_BAR();
        {
            PH_INIT;
            float s1 = wave_sum(P.in[I_LQ1][L * 64 + lane] * P.in[I_LK1][L * 64 + lane], lane), s2 = wave_sum(P.in[I_LQ2][L * 64 + lane] * P.in[I_LK2][L * 64 + lane], lane);
            const float lam = expf(s1) - expf(s2) + lambda_init;
            for (int i = 0; i < 4; ++i) { const int u = i * G + vcu; if (u >= 1024) break; const int bh = u >> 4, qb = u & 15;
                att::attn_unit(bh >> 3, bh & 7, qb, QB, KB, VB, QB, SCR + (size_t)bx * 32768, (const unsigned*)(ws + WS_KMAX), lam, 1.0f - lambda_init, P.in[I_SUBW] + L * 128, (char*)lds_raw); }
            __syncthreads();
        }
        { PH_INIT; MAKE_E; E.mode = 3; RUN_GEMM(UEXT, TMAT, KX, KX, KX, 4, 2, 32, E); }
        GRID_BAR();
        { PH_INIT; MAKE_E; E.mode = 4; RUN_GEMM(XN, WG, 1024, 1024, 1024, 128, 8, 1, E); }
        { PH_INIT; MAKE_E; E.mode = 5; RUN_GEMM(YB, WGLU, 512, 512, 512, 128, 8, 1, E); }
        GRID_BAR();
        { PH_INIT; MAKE_E; E.mode = 6; RUN_GEMM(QB, WAO, 1024, 1024, 1024, 128, 4, 1, E); }
        GRID_BAR();
        { PH_INIT; MAKE_E; E.mode = 7; E.gate = MOD + (size_t)L * NB * 6144 + 2048; E.base = (L == 0) ? P.in[I_X] : xo;
          E.nw = P.in[I_N2W] + L * DM; E.nmod = MOD + (size_t)L * NB * 6144 + 3072; E.XNo = XN; E.xs = (float*)(ws + WS_XS); E.cnt = (unsigned*)(ws + WS_CNT) + (size_t)(2 * L) * 128 * 64;
          if (G == 256) { E.nf = 1; RUN_GEMM(KB, WOUT, 1024, 1024, 1024, 128, 4, 1, E); } else { E.nf = 0; RUN_GEMM(KB, WOUT, 1024, 1024, 1024, 128, 4, 1, E); } }
        GRID_BAR();
        if (G0 != 256) {
            {
                PH_INIT;
                const float* nw = P.in[I_N2W] + L * DM;
                norm_rows(xo, nw, MOD + (size_t)L * NB * 6144, 3072, XN, nullptr, gw, NGW, lane);
            }
            GRID_BAR();
        }
        { PH_INIT; MAKE_E; E.mode = 8; E.cw = P.in[I_CONVW] + (size_t)L * 3 * NUP; E.cb = P.in[I_CONVB] + (size_t)L * NUP;
          pg8::Gemm g_{XN, WUP, 1024, 1024, 1024, 128, 22, 1, 1}; pg8::Order S_; S_.init(g_, G, bx);
#pragma unroll 1
          for (int i = 0; ; ++i) { pg8::Unit uu; if (!S_.next(i, uu)) break; pg8::Order S1 = S_; S1.single = 1; S1.one = uu; pg8::gemm_phase(lds, g_, S1, E); } }
        GRID_BAR();
        { PH_INIT;
          pg8::Gemm gd_{ACT, WDOWN, DFF, DFF, DFF, 128, 4, 1, 0}; pg8::Order Sd_; Sd_.init(gd_, G, bx);
#pragma unroll 1
          for (int i = 0; ; ++i) { pg8::Unit uu; if (!Sd_.next(i, uu)) break; conv_fix(uu.pm, TSB, ACT, P.in[I_CONVW] + (size_t)L * 3 * NUP, P.in[I_CONVB] + (size_t)L * NUP, tid); }
          asm volatile("s_waitcnt vmcnt(0)" ::: "memory"); __syncthreads(); }
        { PH_INIT; MAKE_E; E.mode = 7; E.gate = MOD + (size_t)L * NB * 6144 + 5120; E.base = xo;
          E.nw = P.in[I_N1W] + (L + 1) * DM; E.nmod = MOD + (size_t)(L + 1) * NB * 6144; E.XNo = XN; E.xs = (float*)(ws + WS_XS); E.cnt = (unsigned*)(ws + WS_CNT) + (size_t)1 * 128 * 64;
          if (G == 256 && L == 0) { E.nf = 1; RUN_GEMM(ACT, WDOWN, DFF, DFF, DFF, 128, 4, 1, E); }
          else if (G == 256) { E.nf = 2; E.nw = P.in[I_FINW]; E.cnt = (unsigned*)(ws + WS_CNT) + (size_t)3 * 128 * 64; RUN_GEMM(ACT, WDOWN, DFF, DFF, DFF, 128, 4, 1, E); }
          else { E.nf = 0; RUN_GEMM(ACT, WDOWN, DFF, DFF, DFF, 128, 4, 1, E); } }
        if (l == 0 || G0 != 256) GRID_BAR();
    }
    if (G0 != 256) {
        const int l = 2;
        PH_INIT;
        const float* nw = P.in[I_FINW];
        norm_rows(xo, nw, nullptr, 0, nullptr, xo, gw, NGW, lane);
    }
}

extern "C" void kernel_launch(void* const* d_in, const int* in_sizes, int n_in, void* d_out, int out_size, void* d_ws, size_t ws_size, hipStream_t stream) {
    static int grid = 0;
    if (grid == 0) {
        if (n_in != 29 || out_size != T * DM || ws_size < WS_END) { fprintf(stderr, "kernel_launch: unexpected shapes n_in %d out %d ws %zu (need %zu)\n", n_in, out_size, ws_size, (size_t)WS_END); grid = -1; return; }
        int dev = 0, cus = 0, per_cu = 0;
        (void)hipGetDevice(&dev); (void)hipDeviceGetAttribute(&cus, hipDeviceAttributeMultiprocessorCount, dev);
        if (hipFuncSetAttribute((const void*)mega, hipFuncAttributeMaxDynamicSharedMemorySize, LDS_BYTES) != hipSuccess) { fprintf(stderr, "kernel_launch: hipFuncSetAttribute failed\n"); grid = -1; return; }
        (void)hipOccupancyMaxActiveBlocksPerMultiprocessor(&per_cu, (const void*)mega, NTHR, LDS_BYTES);
        if (per_cu < 1) { fprintf(stderr, "kernel_launch: occupancy query says %d blocks per CU\n", per_cu); per_cu = 1; }
        (void)hipGetLastError();
        grid = cus;
    }
    if (grid < 0) return;
    Params p{};
    for (int i = 0; i < 29; ++i) p.in[i] = (const float*)d_in[i];
    p.out = (float*)d_out; p.ws = (unsigned char*)d_ws;
    void* args[] = {&p};
    if (hipMemsetAsync(d_ws, 0, 256 * 1024, stream) != hipSuccess) { fprintf(stderr, "kernel_launch: hipMemsetAsync of the control words failed\n"); return; }
    hipError_t e = hipLaunchCooperativeKernel((const void*)mega, dim3(grid), dim3(NTHR), args, LDS_BYTES, stream);
    if (e != hipSuccess) fprintf(stderr, "cooperative launch failed: %s (grid %d)\n", hipGetErrorString(e), grid);
}
```
